# Optimizing an MI355X kernel written in HIP

```python
import math
import jax, jax.numpy as jnp
from jax import lax
import numpy as np

D_MODEL = 2048
BATCH = 1
SEQ = 16384
DEPTH = 2

GRID_W = 64
CTX_LEN = 256

D_FOURIER = D_MODEL // 4
N_FOURIER_GROUPS = 4
FOURIER_GROUP = D_FOURIER // N_FOURIER_GROUPS
D_CONV = D_MODEL // 4
CONV_WIDTH = 31
CONV_PAD = CONV_WIDTH // 2
N_ATT_HEADS = 8
ATT_QK_DIM = 64
ATT_V_DIM = 2 * ATT_QK_DIM
D_ATT = N_ATT_HEADS * ATT_V_DIM
D_MIX = D_FOURIER + D_CONV + D_ATT
QK_COLS = N_ATT_HEADS * 2 * ATT_QK_DIM
ATT_SCALE = 1.0 / math.sqrt(ATT_QK_DIM)
Q_BLOCK = 128
ROPE_BASE = 10000.0
ROPE_PAIRS_PER_AXIS = ATT_QK_DIM // 4

OFF_CONV = D_FOURIER
OFF_Q = OFF_CONV + 2 * D_CONV
OFF_K = OFF_Q + QK_COLS
OFF_V = OFF_K + QK_COLS
D_IN_PROJ = OFF_V + D_ATT

N_GROUPS = 4
EXPERTS_PER_GROUP = 8
N_EXPERTS = N_GROUPS * EXPERTS_PER_GROUP
TOP_K = 2
D_EXPERT = D_MODEL // 4
MOE_BLOCK = 128

N_MOD = 6
LN_EPS = 1e-6
ALPHA = (2.0 * DEPTH) ** 0.25
BETA = (8.0 * DEPTH) ** -0.25

kernel_name = "hybrid_fourier_conv_diffattn_hmoe_dit"


def _layernorm(x):
    xf = x.astype(jnp.float32)
    mu = xf.mean(-1, keepdims=True)
    var = jnp.square(xf - mu).mean(-1, keepdims=True)
    return ((xf - mu) * lax.rsqrt(var + LN_EPS)).astype(x.dtype)


def _ln_affine(x, g, b):
    return _layernorm(x) * g + b


def _modulate(h, shift, scale):
    return h * (1.0 + scale[:, None, :]) + shift[:, None, :]


def _axial_rope_tables(n_tokens, dtype):
    rows = n_tokens // GRID_W
    row = jnp.repeat(jnp.arange(rows), GRID_W).astype(jnp.float32)
    col = jnp.tile(jnp.arange(GRID_W), rows).astype(jnp.float32)
    inv = 1.0 / (ROPE_BASE ** (jnp.arange(ROPE_PAIRS_PER_AXIS, dtype=jnp.float32) / ROPE_PAIRS_PER_AXIS))
    ang = jnp.concatenate([row[:, None] * inv, col[:, None] * inv], -1)
    return jnp.cos(ang).astype(dtype), jnp.sin(ang).astype(dtype)


def _apply_rope(x, cos, sin):
    x1, x2 = jnp.split(x, 2, axis=-1)
    return jnp.concatenate([x1 * cos - x2 * sin, x1 * sin + x2 * cos], -1)


def _qk_heads(p):
    B, L, _ = p.shape
    return p.reshape(B, L, N_ATT_HEADS, 2, ATT_QK_DIM).transpose(0, 2, 3, 1, 4)


def _v_heads(p):
    B, L, _ = p.shape
    return p.reshape(B, L, N_ATT_HEADS, ATT_V_DIM).transpose(0, 2, 1, 3)


def _diff_attend(q, k, v, lam):
    s = jnp.einsum('bhmqd,bhmkd->bhmqk', q, k).astype(jnp.float32) * ATT_SCALE
    p = jax.nn.softmax(s, axis=-1)
    a = p[:, :, 0] - lam * p[:, :, 1]
    return jnp.einsum('bhqk,bhkd->bhqd', a.astype(v.dtype), v)


def _diff_attention_blocks(q, k, v, lam):
    B, H, M, S, d = q.shape
    nb = S // Q_BLOCK
    qb = q.reshape(B, H, M, nb, Q_BLOCK, d).transpose(3, 0, 1, 2, 4, 5)
    ob = lax.map(lambda qi: _diff_attend(qi, k, v, lam), qb)
    return ob.transpose(1, 2, 0, 3, 4).reshape(B, H, S, ATT_V_DIM)


def _diff_head_out(o, g, lam_init):
    B, H, L, Dv = o.shape
    of = o.astype(jnp.float32)
    of = of * lax.rsqrt(jnp.mean(of * of, -1, keepdims=True) + LN_EPS) * g * (1.0 - lam_init)
    return of.astype(o.dtype).transpose(0, 2, 1, 3).reshape(B, L, H * Dv)


def _fourier_mix(u, w):
    B, L, _ = u.shape
    ug = u.astype(jnp.float32).reshape(B, L, N_FOURIER_GROUPS, FOURIER_GROUP)
    y = jnp.fft.fft2(ug, axes=(1, 3), norm='ortho').real
    return y.astype(u.dtype).reshape(B, L, D_FOURIER) @ w


def _conformer_conv(a, gt, conv_w, conv_b, ln_g, ln_b, w_pw):
    u = a * jax.nn.sigmoid(gt)
    y = lax.conv_general_dilated(u, conv_w[:, None, :], window_strides=(1,),
                                 padding=((CONV_PAD, CONV_PAD),),
                                 dimension_numbers=('NWC', 'WIO', 'NWC'),
                                 feature_group_count=D_CONV) + conv_b
    y = _ln_affine(y, ln_g, ln_b)
    return jax.nn.silu(y) @ w_pw


def _split_groups(pr):
    return (pr[..., :OFF_CONV], pr[..., OFF_CONV:OFF_CONV + D_CONV], pr[..., OFF_CONV + D_CONV:OFF_Q],
            pr[..., OFF_Q:OFF_K], pr[..., OFF_K:OFF_V], pr[..., OFF_V:])


def _grouped_experts(h, expert, weight, w_gate, w_up, w_down):
    N, D = h.shape
    K = expert.shape[1]
    A = N * K
    n_blocks = -(-A // MOE_BLOCK) + N_EXPERTS
    cap = n_blocks * MOE_BLOCK
    flat_e = expert.reshape(A)
    order = jnp.argsort(flat_e)
    e_sorted = flat_e[order]
    tok_sorted = (order // K).astype(jnp.int32)
    w_sorted = weight.reshape(A)[order]
    counts = jnp.bincount(flat_e, length=N_EXPERTS)
    padded = (counts + MOE_BLOCK - 1) // MOE_BLOCK * MOE_BLOCK
    pad_end = jnp.cumsum(padded)
    pad_start = pad_end - padded
    start = jnp.cumsum(counts) - counts
    dest = pad_start[e_sorted] + jnp.arange(A) - start[e_sorted]
    row_tok = jnp.full((cap,), N, jnp.int32).at[dest].set(tok_sorted)
    block_e = jnp.minimum(jnp.searchsorted(pad_end, jnp.arange(n_blocks) * MOE_BLOCK, side='right'),
                          N_EXPERTS - 1)
    h_pad = jnp.concatenate([h, jnp.zeros((1, D), h.dtype)], 0)
    xb = h_pad[row_tok].reshape(n_blocks, MOE_BLOCK, D)

    def expert_block(args):
        xblk, e = args
        return (jax.nn.silu(xblk @ w_gate[e]) * (xblk @ w_up[e])) @ w_down[e]

    yb = lax.map(expert_block, (xb, block_e)).reshape(cap, D)
    return jnp.zeros((N, D), h.dtype).at[tok_sorted].add(yb[dest] * w_sorted[:, None])


def _hier_moe(h, w_rg, b_rg, w_re, b_re, w_gate, w_up, w_down):
    N = h.shape[0]
    p_g = jax.nn.softmax((h @ w_rg).astype(jnp.float32) + b_rg, axis=-1)
    wg, gidx = lax.top_k(p_g, 1)
    logit_e = ((h @ w_re).astype(jnp.float32) + b_re).reshape(N, N_GROUPS, EXPERTS_PER_GROUP)
    logit_in = logit_e[jnp.arange(N), gidx[:, 0]]
    we, eidx = lax.top_k(jax.nn.softmax(logit_in, axis=-1), TOP_K)
    we = we / we.sum(-1, keepdims=True)
    weights = (wg * we).astype(h.dtype)
    expert = gidx * EXPERTS_PER_GROUP + eidx
    return _grouped_experts(h, expert, weights, w_gate, w_up, w_down)


def setup_inputs(seed: int = 0) -> dict:
    key = jax.random.key(seed)
    ks = iter(jax.random.split(key, 40))

    def nrm(shape, scale):
        return jax.random.normal(next(ks), shape, jnp.float32) * scale

    L = DEPTH
    w_in = nrm((L, D_MODEL, D_IN_PROJ), D_MODEL ** -0.5)
    w_in = w_in.at[:, :, OFF_V:].multiply(BETA)
    return {
        "x": nrm((BATCH, SEQ, D_MODEL), 1.0),
        "c": nrm((BATCH, D_MODEL), 1.0),
        "ctx": nrm((BATCH, CTX_LEN, D_MODEL), 1.0),
        "c_ctx": nrm((D_MODEL,), 1.0),
        "w_mod": nrm((L, D_MODEL, N_MOD * D_MODEL), 0.5 * D_MODEL ** -0.5),
        "b_mod": nrm((L, N_MOD * D_MODEL), 0.01),
        "w_in": w_in,
        "b_in": nrm((L, D_IN_PROJ), 0.01),
        "w_fourier": nrm((L, D_FOURIER, D_FOURIER), BETA * D_FOURIER ** -0.5),
        "conv_w": nrm((L, CONV_WIDTH, D_CONV), CONV_WIDTH ** -0.5),
        "conv_b": nrm((L, D_CONV), 0.01),
        "conv_ln_g": 1.0 + nrm((L, D_CONV), 0.01),
        "conv_ln_b": nrm((L, D_CONV), 0.01),
        "w_pw": nrm((L, D_CONV, D_CONV), BETA * D_CONV ** -0.5),
        "lam_q1": nrm((L, ATT_QK_DIM), 0.1),
        "lam_k1": nrm((L, ATT_QK_DIM), 0.1),
        "lam_q2": nrm((L, ATT_QK_DIM), 0.1),
        "lam_k2": nrm((L, ATT_QK_DIM), 0.1),
        "subln_g": 1.0 + nrm((L, ATT_V_DIM), 0.01),
        "w_out": nrm((L, D_MIX, D_MODEL), BETA * D_MIX ** -0.5),
        "ln_a_g": 1.0 + nrm((L, D_MODEL), 0.01),
        "ln_a_b": nrm((L, D_MODEL), 0.01),
        "w_rg": nrm((L, D_MODEL, N_GROUPS), D_MODEL ** -0.5),
        "b_rg": nrm((L, N_GROUPS), 0.01),
        "w_re": nrm((L, D_MODEL, N_EXPERTS), D_MODEL ** -0.5),
        "b_re": nrm((L, N_EXPERTS), 0.01),
        "w_gate": nrm((L, N_EXPERTS, D_MODEL, D_EXPERT), D_MODEL ** -0.5),
        "w_up": nrm((L, N_EXPERTS, D_MODEL, D_EXPERT), D_MODEL ** -0.5),
        "w_down": nrm((L, N_EXPERTS, D_EXPERT, D_MODEL), BETA * D_EXPERT ** -0.5),
        "ln_f_g": 1.0 + nrm((L, D_MODEL), 0.01),
        "ln_f_b": nrm((L, D_MODEL), 0.01),
    }


def reference(x, c, ctx, c_ctx, w_mod, b_mod, w_in, b_in, w_fourier, conv_w, conv_b, conv_ln_g, conv_ln_b,
              w_pw, lam_q1, lam_k1, lam_q2, lam_k2, subln_g, w_out, ln_a_g, ln_a_b, w_rg, b_rg, w_re, b_re,
              w_gate, w_up, w_down, ln_f_g, ln_f_b):
    B, S, D = x.shape
    cos, sin = _axial_rope_tables(S, x.dtype)
    sc_l = jax.nn.silu(c)
    sc_c = jax.nn.silu(c_ctx)[None, :]
    xl, xc = x, ctx
    for i in range(DEPTH):
        last = i == DEPTH - 1
        mod_l = jnp.split(sc_l @ w_mod[i] + b_mod[i], N_MOD, axis=-1)
        mod_c = jnp.split(sc_c @ w_mod[i] + b_mod[i], N_MOD, axis=-1)
        lam_init = 0.8 - 0.6 * math.exp(-0.3 * i)
        lam = (jnp.exp(jnp.sum(lam_q1[i].astype(jnp.float32) * lam_k1[i].astype(jnp.float32)))
               - jnp.exp(jnp.sum(lam_q2[i].astype(jnp.float32) * lam_k2[i].astype(jnp.float32)))
               + lam_init)

        hl = _modulate(_layernorm(xl), mod_l[0], mod_l[1])
        hc = _modulate(_layernorm(xc), mod_c[0], mod_c[1])
        fl, al, gl, ql, kl, vl = _split_groups(hl @ w_in[i] + b_in[i])
        if last:
            pkv = hc @ w_in[i][:, OFF_K:] + b_in[i][OFF_K:]
            kc, vc = pkv[..., :OFF_V - OFF_K], pkv[..., OFF_V - OFF_K:]
        else:
            fc, ac, gc, qc, kc, vc = _split_groups(hc @ w_in[i] + b_in[i])
        Kc, Vc = _qk_heads(kc), _v_heads(vc)
        Ql = _apply_rope(_qk_heads(ql), cos, sin)
        Kl = _apply_rope(_qk_heads(kl), cos, sin)
        K_all = jnp.concatenate([Kc, Kl], axis=3)
        V_all = jnp.concatenate([Vc, _v_heads(vl)], axis=2)
        att_l = _diff_head_out(_diff_attention_blocks(Ql, K_all, V_all, lam), subln_g[i], lam_init)
        mix_l = jnp.concatenate([
            _fourier_mix(fl, w_fourier[i]),
            _conformer_conv(al, gl, conv_w[i], conv_b[i], conv_ln_g[i], conv_ln_b[i], w_pw[i]),
            att_l], axis=-1) @ w_out[i]
        if not last:
            att_c = _diff_head_out(_diff_attend(_qk_heads(qc), Kc, Vc, lam), subln_g[i], lam_init)
            mix_c = jnp.concatenate([
                _fourier_mix(fc, w_fourier[i]),
                _conformer_conv(ac, gc, conv_w[i], conv_b[i], conv_ln_g[i], conv_ln_b[i], w_pw[i]),
                att_c], axis=-1) @ w_out[i]
            xc = _ln_affine(ALPHA * xc + mod_c[2][:, None, :] * mix_c, ln_a_g[i], ln_a_b[i])
        xl = _ln_affine(ALPHA * xl + mod_l[2][:, None, :] * mix_l, ln_a_g[i], ln_a_b[i])

        hl = _modulate(_layernorm(xl), mod_l[3], mod_l[4])
        moe = functools_partial_moe = (w_rg[i], b_rg[i], w_re[i], b_re[i], w_gate[i], w_up[i], w_down[i])
        if last:
            y_l = _hier_moe(hl.reshape(-1, D), *moe).reshape(hl.shape)
        else:
            hc = _modulate(_layernorm(xc), mod_c[3], mod_c[4])
            n_c = hc.shape[0] * hc.shape[1]
            y = _hier_moe(jnp.concatenate([hc.reshape(-1, D), hl.reshape(-1, D)], 0), *moe)
            y_c = y[:n_c].reshape(hc.shape)
            y_l = y[n_c:].reshape(hl.shape)
            xc = _ln_affine(ALPHA * xc + mod_c[5][:, None, :] * y_c, ln_f_g[i], ln_f_b[i])
        xl = _ln_affine(ALPHA * xl + mod_l[5][:, None, :] * y_l, ln_f_g[i], ln_f_b[i])
    return xl
```

```cpp
#include <hip/hip_runtime.h>
#include <cstdio>
#include <cstdint>
#include <cmath>
#ifndef MK_ONE_LAUNCH
#define MK_ONE_LAUNCH 0
#endif
namespace pg8 {
#define PG8_LAS __attribute__((address_space(3)))
typedef unsigned short bf16_t;
typedef short bf16x8 __attribute__((ext_vector_type(8)));
typedef float f32x4 __attribute__((ext_vector_type(4)));
typedef float f32x2 __attribute__((ext_vector_type(2)));
typedef unsigned u32x4 __attribute__((ext_vector_type(4)));
typedef unsigned u32x2 __attribute__((ext_vector_type(2)));
constexpr int BM = 256, BK = 64, HALF = 128, HTB = HALF * BK * 2  , STAGE_BYTES = 8 * HTB, NXCD = 8, WGM = 8;

__host__ __device__ __forceinline__ int lds_byte(int r, int c) { const int st = (r >> 4) * 2 + (c >> 5), rr = r & 15, cc = c & 31, ob = rr * 64 + cc * 2; return st * 1024 + (ob ^ (((ob >> 9) & 1) << 5)); }
__host__ __device__ __forceinline__ void stage_rc(int b, int& R, int& C) { const int st = b / 1024, sb = b % 1024, swz = sb ^ (((sb >> 9) & 1) << 5); R = (st >> 1) * 16 + swz / 64; C = (st & 1) * 32 + (swz % 64) / 2; }
__host__ __device__ __forceinline__ int perm32(int rho) { const int n = rho >> 4, i = rho & 15; return 8 * (i >> 2) + 4 * n + (i & 3); }

struct Unit { int pm, pn, e, rt; };
struct Gemm { const bf16_t* A; const bf16_t* Bt; int K, lda; };

struct GridOrder {
    int nM, nN, nwg, G, c;
    __device__ void init(int nM_, int nN_, int G_, int c_) { nM = nM_; nN = nN_; nwg = nM * nN; G = G_; c = c_; }
    __device__ bool next(int i, Unit& u) const {
        const long L = (long)i * G + c; if (L >= nwg) return false;
        int wgid = (int)L; { const int q = nwg / NXCD, r = nwg % NXCD, xcd = wgid % NXCD, off = wgid / NXCD; wgid = (xcd < r ? xcd * (q + 1) : r * (q + 1) + (xcd - r) * q) + off; }
        const int nig = WGM * nN, gid = wgid / nig, fm = gid * WGM, gsz = (nM - fm) < WGM ? (nM - fm) : WGM;
        u.pm = fm + ((wgid % nig) % gsz); u.pn = (wgid % nig) / gsz; u.e = 0; u.rt = 0; return true;
    }
};

__device__ __forceinline__ unsigned cvt_pk_bf16(float lo, float hi) { unsigned r; asm volatile("v_cvt_pk_bf16_f32 %0, %1, %2" : "=v"(r) : "v"(lo), "v"(hi)); return r; }

template <class Epi, class Sched>
__device__ __forceinline__ void gemm_phase(PG8_LAS unsigned char* lds, const Gemm g, const Sched& S, const Epi& E) {
    int tid_ = threadIdx.x; asm volatile("" : "+v"(tid_));
    const int tid = tid_, wid = __builtin_amdgcn_readfirstlane(tid >> 6), lane = tid & 63, wr = wid >> 2, wc = wid & 3, fr = lane & 15, fq = lane >> 4;
    int K_ = g.K; asm volatile("" : "+s"(K_));
    const int K = K_, nt = K / BK;
    int Rl[2]; unsigned Cb[2], voffB[2];
#pragma unroll
    for (int i = 0; i < 2; ++i) { int R, C; stage_rc(tid * 16 + i * 8192, R, C); const int Rb = Epi::PERM ? ((R & ~31) + perm32(R & 31)) : R;
        Rl[i] = R; Cb[i] = (unsigned)C * 2u; voffB[i] = (unsigned)(Rb * K + C) * 2u; }
    const size_t kstep = (size_t)(BK * 2);
    const size_t hstepB = (size_t)HALF * K * 2;
    const unsigned pitchA = (unsigned)g.lda * 2u;
    const unsigned ldsw = (unsigned)wid * 1024u;
    const int aoff = lds_byte(wr * 64 + fr, fq * 8), boff = lds_byte(wc * 32 + fr, fq * 8);
    const char* gA = (const char*)g.A;
#define PG8_SA(b, h) (((b) * 2 + (h)) * HTB)
#define PG8_SB(b, h) ((4 + (b) * 2 + (h)) * HTB)
#define PG8_STAGEB(bufoff, gbase) do { _Pragma("unroll") for (int _i = 0; _i < 2; ++_i) \
        __builtin_amdgcn_global_load_lds((const unsigned*)((const char*)(gbase) + voffB[_i]), (PG8_LAS unsigned*)(lds + (bufoff) + ldsw + _i * 8192), 16, 0, 0); } while (0)
#define PG8_STAGEA(bufoff, koff, vo) do { _Pragma("unroll") for (int _i = 0; _i < 2; ++_i) \
        __builtin_amdgcn_global_load_lds((const unsigned*)(gA + (koff) + (vo)[_i]), (PG8_LAS unsigned*)(lds + (bufoff) + ldsw + _i * 8192), 16, 0, 0); } while (0)
#define PG8_MKA(dst, u) do { _Pragma("unroll") for (int _h = 0; _h < 2; ++_h) _Pragma("unroll") for (int _i = 0; _i < 2; ++_i) \
        dst[_h][_i] = (unsigned)S.arow(u, _h * HALF + Rl[_i]) * pitchA + Cb[_i]; } while (0)
#define PG8_LDA(dst, b, h) do { _Pragma("unroll") for (int m = 0; m < 4; ++m) _Pragma("unroll") for (int k = 0; k < 2; ++k) dst[m][k] = *(const PG8_LAS bf16x8*)(lds + PG8_SA(b, h) + aoff + m * 2048 + k * 1024); } while (0)
#define PG8_LDB(dst, b, h) do { _Pragma("unroll") for (int n = 0; n < 2; ++n) _Pragma("unroll") for (int k = 0; k < 2; ++k) dst[n][k] = *(const PG8_LAS bf16x8*)(lds + PG8_SB(b, h) + boff + n * 2048 + k * 1024); } while (0)
#define PG8_MMA(ai, bj, At, Bt) do { __builtin_amdgcn_s_setprio(1); _Pragma("unroll") for (int m = 0; m < 4; ++m) _Pragma("unroll") for (int n = 0; n < 2; ++n) _Pragma("unroll") for (int k = 0; k < 2; ++k) \
        acc[ai][bj][m][n] = __builtin_amdgcn_mfma_f32_16x16x32_bf16(Bt[n][k], At[m][k], acc[ai][bj][m][n], 0, 0, 0); __builtin_amdgcn_s_setprio(0); } while (0)
#define PG8_WAIT_V(n) asm volatile("s_waitcnt vmcnt(" #n ")" ::: "memory")
#define PG8_WAIT_L(n) asm volatile("s_waitcnt lgkmcnt(" #n ")" ::: "memory")
#define PG8_BAR __builtin_amdgcn_s_barrier()
#define PG8_SCHED __builtin_amdgcn_sched_barrier(0)
    Unit cur, nxt; int ui = 0;
    if (!S.next(0, cur)) return;
    f32x4 acc[2][2][4][2];
#pragma unroll
    for (int a = 0; a < 2; ++a)
#pragma unroll
        for (int b = 0; b < 2; ++b)
#pragma unroll
            for (int m = 0; m < 4; ++m)
#pragma unroll
                for (int n = 0; n < 2; ++n) acc[a][b][m][n] = (f32x4){0.f, 0.f, 0.f, 0.f};
    bf16x8 At[4][2], B0[2][2], B1[2][2];
    unsigned cvA[2][2], nvA[2][2];
    PG8_MKA(cvA, cur);
    const char* cB = (const char*)g.Bt + (size_t)S.brow(cur) * K * 2;
    PG8_STAGEB(PG8_SB(0, 0), cB); PG8_STAGEB(PG8_SB(0, 1), cB + hstepB); PG8_STAGEA(PG8_SA(0, 0), 0, cvA[0]); PG8_STAGEA(PG8_SA(0, 1), 0, cvA[1]);
    if (wr == 1) PG8_BAR;
    PG8_WAIT_V(2); PG8_BAR;
    PG8_STAGEB(PG8_SB(1, 0), cB + kstep); PG8_STAGEA(PG8_SA(1, 0), kstep, cvA[0]); PG8_STAGEB(PG8_SB(1, 1), cB + hstepB + kstep);
    PG8_WAIT_V(6); PG8_BAR;
    for (;;) {
        const bool has_next = S.next(ui + 1, nxt);
        const char* nB = cB;
        if (has_next) { PG8_MKA(nvA, nxt); nB = (const char*)g.Bt + (size_t)S.brow(nxt) * K * 2; }
        else {
#pragma unroll
            for (int h = 0; h < 2; ++h)
#pragma unroll
                for (int i = 0; i < 2; ++i) nvA[h][i] = cvA[h][i]; }
        for (int t = 0; t < nt; t += 2) {
            const bool last = (t == nt - 2);
            const size_t ka1 = (size_t)(t + 1) * kstep;
            const size_t ka2 = last ? (size_t)0 : (size_t)(t + 2) * kstep; const char* b2 = last ? nB : cB + (size_t)(t + 2) * kstep;
            const size_t ka3 = ka2 + kstep; const char* b3 = b2 + kstep;
            unsigned a2v[2][2];
#pragma unroll
            for (int h = 0; h < 2; ++h)
#pragma unroll
                for (int i = 0; i < 2; ++i) a2v[h][i] = last ? nvA[h][i] : cvA[h][i];
            PG8_LDB(B0, 0, 0); PG8_LDB(B1, 0, 1); PG8_SCHED; PG8_LDA(At, 0, 0); PG8_STAGEA(PG8_SA(1, 1), ka1, cvA[1]);
            PG8_WAIT_V(8); PG8_WAIT_L(0); PG8_BAR; PG8_MMA(0, 0, At, B0); PG8_MMA(0, 1, At, B1); PG8_BAR; PG8_SCHED;
            PG8_LDA(At, 0, 1); PG8_STAGEB(PG8_SB(0, 0), b2); PG8_STAGEB(PG8_SB(0, 1), b2 + hstepB); PG8_STAGEA(PG8_SA(0, 0), ka2, a2v[0]);
            PG8_WAIT_V(8); PG8_WAIT_L(0); PG8_BAR; PG8_MMA(1, 0, At, B0); PG8_MMA(1, 1, At, B1); PG8_BAR; PG8_SCHED;
            PG8_LDB(B0, 1, 0); PG8_LDB(B1, 1, 1); PG8_SCHED; PG8_LDA(At, 1, 0); PG8_STAGEA(PG8_SA(0, 1), ka2, a2v[1]);
            PG8_WAIT_V(8); PG8_WAIT_L(0); PG8_BAR; PG8_MMA(0, 0, At, B0); PG8_MMA(0, 1, At, B1); PG8_BAR; PG8_SCHED;
            PG8_LDA(At, 1, 1); PG8_STAGEB(PG8_SB(1, 0), b3); PG8_STAGEB(PG8_SB(1, 1), b3 + hstepB); PG8_STAGEA(PG8_SA(1, 0), ka3, a2v[0]);
            PG8_WAIT_V(8); PG8_WAIT_L(0); PG8_BAR; PG8_MMA(1, 0, At, B0); PG8_MMA(1, 1, At, B1); PG8_BAR; PG8_SCHED;
        }
        if (wr == 0) PG8_BAR;
        E(acc, cur, wr, wc, fr, fq);
        if (!has_next) break;
#pragma unroll
        for (int a = 0; a < 2; ++a)
#pragma unroll
            for (int b = 0; b < 2; ++b)
#pragma unroll
                for (int m = 0; m < 4; ++m)
#pragma unroll
                    for (int n = 0; n < 2; ++n) acc[a][b][m][n] = (f32x4){0.f, 0.f, 0.f, 0.f};
        cur = nxt; cB = nB; ++ui;
#pragma unroll
        for (int h = 0; h < 2; ++h)
#pragma unroll
            for (int i = 0; i < 2; ++i) cvA[h][i] = nvA[h][i];
        if (wr == 1) PG8_BAR;
    }
    PG8_WAIT_V(0);
    PG8_BAR;
#undef PG8_SA
#undef PG8_SB
#undef PG8_STAGEA
#undef PG8_STAGEB
#undef PG8_MKA
#undef PG8_LDA
#undef PG8_LDB
#undef PG8_MMA
#undef PG8_WAIT_V
#undef PG8_WAIT_L
#undef PG8_BAR
#undef PG8_SCHED
}
}
namespace attn {
using bf16x8 = __attribute__((ext_vector_type(8))) short;
using s16x4  = __attribute__((ext_vector_type(4))) short;
using f32x16 = __attribute__((ext_vector_type(16))) float;
using u32x4  = __attribute__((ext_vector_type(4))) unsigned;
typedef unsigned short bf16_t;
constexpr int NW = 8, QBLK = 32, KVBLK = 64, PITCH = 1024;
constexpr float THR2 = 11.5f;
constexpr size_t SHM_V = KVBLK * 128 * 2, SHM_K = KVBLK * 64 * 2, SHM_ATTN = 2 * SHM_V + 2 * SHM_K + NW * 64 * 4;
#define KSWZ64(row, colB) ((row) * 128 + ((colB) ^ ((((row) >> 1) & 7) << 4)))
#define SBAR() __builtin_amdgcn_sched_barrier(0)
__device__ __forceinline__ int crow(int r, int hi) { return (r & 3) + 8 * (r >> 2) + 4 * hi; }
__device__ __forceinline__ unsigned cvtpk(float lo, float hi) { unsigned r; asm volatile("v_cvt_pk_bf16_f32 %0, %1, %2" : "=v"(r) : "v"(lo), "v"(hi)); return r; }

__device__ __forceinline__ void partialSM(f32x16& p0, f32x16& p1, float& m_reg, float& mn, float& alpha) {
  float pmax = p0[0];
#pragma unroll
  for (int r = 1; r < 16; ++r) pmax = fmaxf(pmax, p0[r]);
#pragma unroll
  for (int r = 0; r < 16; ++r) pmax = fmaxf(pmax, p1[r]);
  { auto rr = __builtin_amdgcn_permlane32_swap(__float_as_uint(pmax), __float_as_uint(pmax), false, false);
    pmax = fmaxf(__uint_as_float(rr[0]), __uint_as_float(rr[1])); }
  if (__builtin_expect(__all(pmax - m_reg <= THR2), 1)) { mn = m_reg; alpha = 1.f; }
  else { mn = fmaxf(m_reg, pmax); alpha = __builtin_amdgcn_exp2f(m_reg - mn); m_reg = mn; }
#pragma unroll
  for (int r = 0; r < 16; ++r) p0[r] = p0[r] - mn;
#pragma unroll
  for (int r = 0; r < 16; ++r) p1[r] = p1[r] - mn;
#pragma unroll
  for (int r = 0; r < 16; ++r) p0[r] = __builtin_amdgcn_exp2f(p0[r]);
}
__device__ __forceinline__ void finishSM(f32x16& p0, f32x16& p1, float alpha, float& l_reg, bf16x8& pa0, bf16x8& pa1, bf16x8& pa2, bf16x8& pa3) {
#pragma unroll
  for (int r = 0; r < 16; ++r) p1[r] = __builtin_amdgcn_exp2f(p1[r]);
  float ps = 0;
#pragma unroll
  for (int r = 0; r < 16; ++r) ps += p0[r];
#pragma unroll
  for (int r = 0; r < 16; ++r) ps += p1[r];
  { auto rr = __builtin_amdgcn_permlane32_swap(__float_as_uint(ps), __float_as_uint(ps), false, false);
    ps = __uint_as_float(rr[0]) + __uint_as_float(rr[1]); }
  l_reg = l_reg * alpha + ps;
#define PK4(P, BASE, OUT) do { unsigned a0 = cvtpk(P[BASE + 0], P[BASE + 1]), a1 = cvtpk(P[BASE + 2], P[BASE + 3]);   \
    unsigned b0 = cvtpk(P[BASE + 4], P[BASE + 5]), b1 = cvtpk(P[BASE + 6], P[BASE + 7]);                              \
    auto r0 = __builtin_amdgcn_permlane32_swap(a0, b0, false, false); auto r1 = __builtin_amdgcn_permlane32_swap(a1, b1, false, false); \
    u32x4 w = {r0[0], r1[0], r0[1], r1[1]}; OUT = *reinterpret_cast<bf16x8*>(&w); } while (0)
  PK4(p0, 0, pa0); PK4(p0, 8, pa1); PK4(p1, 0, pa2); PK4(p1, 8, pa3);
#undef PK4
}
__device__ __forceinline__ void qkt(f32x16& p0, f32x16& p1, const char* Ks, const bf16x8* qr, int r32, int hi) {
  p0 = f32x16{}; p1 = f32x16{};
#pragma unroll
  for (int d0 = 0; d0 < 4; ++d0) { const int cb = (d0 * 16 + hi * 8) * 2;
    bf16x8 b0 = *reinterpret_cast<const bf16x8*>(Ks + KSWZ64(r32, cb));
    bf16x8 b1 = *reinterpret_cast<const bf16x8*>(Ks + KSWZ64(32 + r32, cb));
    p0 = __builtin_amdgcn_mfma_f32_32x32x16_bf16(b0, qr[d0], p0, 0, 0, 0);
    p1 = __builtin_amdgcn_mfma_f32_32x32x16_bf16(b1, qr[d0], p1, 0, 0, 0); }
}
__device__ __forceinline__ int v_st(int k, int c) { const int kk = (k & ~0xC) | ((k & 4) << 1) | ((k & 8) >> 1); return ((kk >> 3) * 4 + (c >> 5)) * 512 + ((kk & 7) * 32 + (c & 31)) * 2; }
__device__ __forceinline__ int v_rd_base(int lane) { return ((lane & 3) << 3) | (((lane >> 2) & 3) << 6) | (((lane >> 4) & 1) << 5) | (((lane >> 5) & 1) << 8); }
constexpr int v_rd_off(int d0, int ks, int half) { return d0 * 512 + ks * 4096 + half * 2048; }
template <int OFF> __device__ __forceinline__ s16x4 tr_read(int vb) {
  s16x4 r; asm volatile("ds_read_b64_tr_b16 %0, %1 offset:%2" : "=&v"(r) : "v"(vb), "i"(OFF) : "memory"); return r;
}
template <int D0> __device__ __forceinline__ void pv_one(f32x16& od, int vb, bf16x8 pa0, bf16x8 pa1, bf16x8 pa2, bf16x8 pa3) {
  const s16x4 l0 = tr_read<v_rd_off(D0, 0, 0)>(vb), h0 = tr_read<v_rd_off(D0, 0, 1)>(vb), l1 = tr_read<v_rd_off(D0, 1, 0)>(vb), h1 = tr_read<v_rd_off(D0, 1, 1)>(vb);
  const s16x4 l2 = tr_read<v_rd_off(D0, 2, 0)>(vb), h2 = tr_read<v_rd_off(D0, 2, 1)>(vb), l3 = tr_read<v_rd_off(D0, 3, 0)>(vb), h3 = tr_read<v_rd_off(D0, 3, 1)>(vb);
  asm volatile("s_waitcnt lgkmcnt(0)" ::: "memory"); SBAR();
#define PK(L, H) (bf16x8){L[0], L[1], L[2], L[3], H[0], H[1], H[2], H[3]}
  od = __builtin_amdgcn_mfma_f32_32x32x16_bf16(pa0, PK(l0, h0), od, 0, 0, 0);
  od = __builtin_amdgcn_mfma_f32_32x32x16_bf16(pa1, PK(l1, h1), od, 0, 0, 0);
  od = __builtin_amdgcn_mfma_f32_32x32x16_bf16(pa2, PK(l2, h2), od, 0, 0, 0);
  od = __builtin_amdgcn_mfma_f32_32x32x16_bf16(pa3, PK(l3, h3), od, 0, 0, 0);
#undef PK
}
__device__ __forceinline__ void pv_d0(f32x16* o, int vb, bf16x8 pa0, bf16x8 pa1, bf16x8 pa2, bf16x8 pa3) {
  pv_one<0>(o[0], vb, pa0, pa1, pa2, pa3); pv_one<1>(o[1], vb, pa0, pa1, pa2, pa3); pv_one<2>(o[2], vb, pa0, pa1, pa2, pa3); pv_one<3>(o[3], vb, pa0, pa1, pa2, pa3);
}

__device__ __forceinline__ void attn_pass(const bf16_t* __restrict__ Qb, const bf16_t* __restrict__ Kh, const bf16_t* __restrict__ Vh, int NT, char* lds, f32x16 (&o)[4], float& l_reg) {
  int tid_ = threadIdx.x; asm volatile("" : "+v"(tid_));
  const int tid = tid_, wid = tid >> 6, lane = tid & 63, r32 = lane & 31, hi = lane >> 5;
  char* V_lds = lds; char* K_lds = lds + 2 * SHM_V;
  float* ws = (float*)(lds + 2 * SHM_V + 2 * SHM_K) + wid * 64; float* al_l = ws + 32;
  float m_reg = -1e30f; l_reg = 0.f;
#pragma unroll
  for (int d = 0; d < 4; ++d) o[d] = f32x16{};
  bf16x8 qr[4];
  const bf16_t* Qw = Qb + (long)(wid * QBLK + r32) * PITCH + hi * 8;
#pragma unroll
  for (int d0 = 0; d0 < 4; ++d0) qr[d0] = *reinterpret_cast<const bf16x8*>(Qw + d0 * 16);
  const int sr = tid >> 4, sc = (tid & 15) * 8, vst0 = v_st(sr, sc), vst1 = v_st(32 + sr, sc);
  const int kr = tid >> 3, kc = (tid & 7) * 8, kst = KSWZ64(kr, kc * 2);
  const int vb0 = (int)(uintptr_t)V_lds + v_rd_base(lane);
  struct { bf16x8 vs0, vs1, ks0; } sr_[2];
#define SLOAD(i, k0) do { sr_[i].vs0 = *reinterpret_cast<const bf16x8*>(&Vh[(long)((k0) + sr) * PITCH + sc]); sr_[i].vs1 = *reinterpret_cast<const bf16x8*>(&Vh[(long)((k0) + 32 + sr) * PITCH + sc]); \
    sr_[i].ks0 = *reinterpret_cast<const bf16x8*>(&Kh[(long)((k0) + kr) * PITCH + kc]); } while (0)
#define SWRITE(b, i) do { *(bf16x8*)(V_lds + (b) * SHM_V + vst0) = sr_[i].vs0; *(bf16x8*)(V_lds + (b) * SHM_V + vst1) = sr_[i].vs1; \
    *(bf16x8*)(K_lds + (b) * SHM_K + kst) = sr_[i].ks0; } while (0)
#define SWAIT() asm volatile("s_waitcnt vmcnt(3)" ::: "memory")
#define RESC(a) do { if (__any((a) < 1.f)) { if (hi == 0) al_l[r32] = (a); asm volatile("s_waitcnt lgkmcnt(0)" ::: "memory"); \
    _Pragma("unroll") for (int d = 0; d < 4; ++d) _Pragma("unroll") for (int r = 0; r < 16; ++r) o[d][r] *= al_l[crow(r, hi)]; } } while (0)
  f32x16 pA0, pA1, pB0, pB1; float mnA, mnB, alA, alB; bf16x8 pa0, pa1, pa2, pa3;
  constexpr int SE = 0, SO = 1;
  SLOAD(SE, 0); asm volatile("s_waitcnt vmcnt(0)" ::: "memory"); SWRITE(0, SE); __syncthreads();
  qkt(pA0, pA1, K_lds, qr, r32, hi); partialSM(pA0, pA1, m_reg, mnA, alA);
  SLOAD(SO, KVBLK); if (2 < NT) SLOAD(SE, 2 * KVBLK);
  SWAIT(); SWRITE(1, SO); __syncthreads();
  for (int j = 1; j + 1 < NT; j += 2) {
    SBAR(); qkt(pB0, pB1, K_lds + SHM_K, qr, r32, hi);
    finishSM(pA0, pA1, alA, l_reg, pa0, pa1, pa2, pa3); SBAR();
    SLOAD(SO, (j + 2) * KVBLK); SBAR();
    pv_d0(o, vb0, pa0, pa1, pa2, pa3); partialSM(pB0, pB1, m_reg, mnB, alB);
    __syncthreads(); SWAIT(); SWRITE(0, SE);
    RESC(alB); __syncthreads();
    SBAR(); qkt(pA0, pA1, K_lds, qr, r32, hi);
    finishSM(pB0, pB1, alB, l_reg, pa0, pa1, pa2, pa3); SBAR();
    if (j + 3 < NT) SLOAD(SE, (j + 3) * KVBLK); SBAR();
    pv_d0(o, vb0 + (int)SHM_V, pa0, pa1, pa2, pa3); partialSM(pA0, pA1, m_reg, mnA, alA);
    __syncthreads(); SWAIT(); SWRITE(1, SO);
    RESC(alA); __syncthreads();
  }
  SBAR(); qkt(pB0, pB1, K_lds + SHM_K, qr, r32, hi);
  finishSM(pA0, pA1, alA, l_reg, pa0, pa1, pa2, pa3); SBAR();
  pv_d0(o, vb0, pa0, pa1, pa2, pa3); partialSM(pB0, pB1, m_reg, mnB, alB);
  __syncthreads(); RESC(alB);
  finishSM(pB0, pB1, alB, l_reg, pa0, pa1, pa2, pa3); SBAR();
  pv_d0(o, vb0 + (int)SHM_V, pa0, pa1, pa2, pa3);
  __syncthreads();
#undef SLOAD
#undef SWRITE
#undef SWAIT
#undef RESC
}

struct Tensors { const bf16_t* Q; const bf16_t* K; const bf16_t* V; bf16_t* MIX; float* scr; const float* g; float lam, oml; };
constexpr int MIXP = 2560, MIX_ATT = 1536;
__device__ __forceinline__ void attn_unit(int h, int q0, int NT, const Tensors& T, char* lds) {
  int tid_ = threadIdx.x; asm volatile("" : "+v"(tid_));
  const int tid = tid_, wid = tid >> 6, lane = tid & 63, r32 = lane & 31, hi = lane >> 5;
  float* li_l = (float*)(lds + 2 * SHM_V + 2 * SHM_K) + wid * 64;
  f32x16 o[4]; float l_reg;
  attn_pass(T.Q + (long)q0 * PITCH + h * 128 + 64, T.K + h * 128 + 64, T.V + h * 128, NT, lds, o, l_reg);
  if (hi == 0) li_l[r32] = l_reg; asm volatile("s_waitcnt lgkmcnt(0)" ::: "memory");
  {
    float rli[16];
#pragma unroll
    for (int r = 0; r < 16; ++r) rli[r] = __builtin_amdgcn_rcpf(li_l[crow(r, hi)]);
    typedef float f4 __attribute__((ext_vector_type(4)));
    f4* sp = (f4*)(T.scr + (size_t)tid * 64);
#pragma unroll
    for (int d0 = 0; d0 < 4; ++d0)
#pragma unroll
      for (int r4 = 0; r4 < 4; ++r4) sp[d0 * 4 + r4] = (f4){o[d0][4 * r4] * rli[4 * r4], o[d0][4 * r4 + 1] * rli[4 * r4 + 1], o[d0][4 * r4 + 2] * rli[4 * r4 + 2], o[d0][4 * r4 + 3] * rli[4 * r4 + 3]};
  }
  asm volatile("s_waitcnt vmcnt(0) lgkmcnt(0)" ::: "memory");
  attn_pass(T.Q + (long)q0 * PITCH + h * 128, T.K + h * 128, T.V + h * 128, NT, lds, o, l_reg);
  if (hi == 0) li_l[r32] = l_reg; asm volatile("s_waitcnt lgkmcnt(0)" ::: "memory");
  float ss[16];
#pragma unroll
  for (int r = 0; r < 16; ++r) ss[r] = 0.f;
  { typedef float f4 __attribute__((ext_vector_type(4)));
    const f4* sp = (const f4*)(T.scr + (size_t)tid * 64);
#pragma unroll
    for (int r4 = 0; r4 < 4; ++r4) { float rl[4];
#pragma unroll
      for (int q = 0; q < 4; ++q) rl[q] = __builtin_amdgcn_rcpf(li_l[crow(4 * r4 + q, hi)]);
#pragma unroll
      for (int d0 = 0; d0 < 4; ++d0) { const f4 p2 = sp[d0 * 4 + r4];
#pragma unroll
        for (int q = 0; q < 4; ++q) { const float v = o[d0][4 * r4 + q] * rl[q] - T.lam * p2[q]; o[d0][4 * r4 + q] = v; ss[4 * r4 + q] += v * v; } } } }
#pragma unroll
  for (int r = 0; r < 16; ++r) {
#pragma unroll
    for (int x = 1; x < 32; x <<= 1) ss[r] += __shfl_xor(ss[r], x);
    ss[r] = T.oml / sqrtf(ss[r] * (1.f / 128.f) + 1e-6f); }
  float gv[4];
#pragma unroll
  for (int d0 = 0; d0 < 4; ++d0) gv[d0] = T.g[d0 * 32 + r32];
  bf16_t* Ow = T.MIX + (long)(q0 + wid * QBLK) * MIXP + MIX_ATT + h * 128;
#pragma unroll
  for (int r = 0; r < 16; ++r) { const int orow = crow(r, hi);
#pragma unroll
    for (int d0 = 0; d0 < 4; ++d0) { const unsigned w = cvtpk(o[d0][r] * ss[r] * gv[d0], 0.f); Ow[(long)orow * MIXP + d0 * 32 + r32] = (bf16_t)(w & 0xffffu); } }
  asm volatile("s_waitcnt vmcnt(0) lgkmcnt(0)" ::: "memory");
  __syncthreads();
}
#undef SBAR
}
#define GAS __attribute__((address_space(1)))
#define LAS __attribute__((address_space(3)))
typedef unsigned short bf16;
typedef unsigned v4u __attribute__((ext_vector_type(4)));
typedef float f32x4 __attribute__((ext_vector_type(4)));
typedef short bf16x8 __attribute__((ext_vector_type(8)));
typedef GAS unsigned gu32;
typedef GAS unsigned long long gu64;
#define RLX_AGENT __ATOMIC_RELAXED, __HIP_MEMORY_SCOPE_AGENT
#define LDS_WAIT() asm volatile("s_waitcnt lgkmcnt(0)" ::: "memory")
#define VM_WAIT() asm volatile("s_waitcnt vmcnt(0)" ::: "memory")
__device__ __forceinline__ unsigned long long rt() { return __builtin_amdgcn_s_memrealtime(); }
__device__ __forceinline__ unsigned f2bf(float f) { unsigned u = __builtin_bit_cast(unsigned, f); return (u + 0x7fffu + ((u >> 16) & 1u)) >> 16; }
__device__ __forceinline__ unsigned pk2(float lo, float hi) { return f2bf(lo) | (f2bf(hi) << 16); }

#define XB_TMO      128
#define XB_XCNT(j)  (256  + 64 * (j))
#define XB_XSUB(j)  (1280 + 64 * (j))
#define XB_XGEN(j)  (2304 + 64 * (j))
#define XB_TOP      3328
#define XB_TOPGEN   3392
#define XCD_BAR_WORDS 3456
#define XB_SPIN_CAP (1u << 18)

__device__ __forceinline__ unsigned xb_ld(unsigned* p)              { return __hip_atomic_load(p, __ATOMIC_RELAXED, __HIP_MEMORY_SCOPE_AGENT); }
__device__ __forceinline__ unsigned xb_add(unsigned* p, unsigned v) { return __hip_atomic_fetch_add(p, v, __ATOMIC_RELAXED, __HIP_MEMORY_SCOPE_AGENT); }
__device__ __forceinline__ unsigned xb_xcc_id() { return (unsigned)__builtin_amdgcn_s_getreg((3 << 11) | 20) & 0xFu; }
#define XB_SPIN(cond, bar) do { unsigned _sp = 0; while (cond) { __builtin_amdgcn_s_sleep(1); \
    if ((++_sp & 255u) == 0u) { if (xb_ld(&(bar)[XB_TMO])) break; if (_sp > XB_SPIN_CAP) { atomicAdd(&(bar)[XB_TMO], 1u); break; } } } } while (0)

struct XcdBarrier {
    unsigned* bar; unsigned x;
    volatile LAS unsigned* st;
};

__device__ __forceinline__ XcdBarrier xcd_barrier_post(unsigned* bar, volatile LAS unsigned* st) {
    XcdBarrier b; b.bar = bar; b.x = xb_xcc_id(); b.st = st;
    if (threadIdx.x == 0) (void)xb_add(&bar[XB_XCNT(b.x)], 1u);
    return b;
}
__device__ __forceinline__ void xcd_barrier_complete(unsigned* bar, unsigned x, unsigned& nloc, unsigned& nx) {
    const unsigned G = gridDim.x * gridDim.y * gridDim.z;
    unsigned sum, cnt, mine, sp = 0u;
    for (;;) {
        sum = 0u; cnt = 0u; mine = 0u;
#pragma unroll
        for (unsigned j = 0; j < 16; ++j) { const unsigned c = xb_ld(&bar[XB_XCNT(j)]); sum += c; cnt += (c > 0u) ? 1u : 0u; mine = (j == x) ? c : mine; }
        if (sum == G) break;
        __builtin_amdgcn_s_sleep(1);
        if ((++sp & 255u) == 0u) { if (xb_ld(&bar[XB_TMO])) break; if (sp > XB_SPIN_CAP) { atomicAdd(&bar[XB_TMO], 1u); break; } }
    }
    nloc = mine > 0u ? mine : 1u; nx = cnt > 0u ? cnt : 1u;
}

__device__ __forceinline__ void xcd_barrier(const XcdBarrier& b) {
    asm volatile("s_waitcnt vmcnt(0)" ::: "memory");
    __syncthreads();
    if (threadIdx.x == 0) {
        unsigned* bar = b.bar;
        __builtin_amdgcn_s_waitcnt(0);
        unsigned nloc = b.st[0], nx = b.st[1];
        if (nloc == 0u) { xcd_barrier_complete(bar, b.x, nloc, nx); b.st[0] = nloc; b.st[1] = nx; }
        const unsigned old = xb_add(&bar[XB_XSUB(b.x)], 1u);
        const unsigned gen = old / nloc;
        if (old + 1u == (gen + 1u) * nloc) {
            __builtin_amdgcn_fence(__ATOMIC_RELEASE, "agent");
            asm volatile("s_waitcnt vmcnt(0)" ::: "memory");
            const unsigned og = xb_add(&bar[XB_TOP], 1u);
            const unsigned tg = og / nx;
            if (og + 1u == (tg + 1u) * nx) xb_add(&bar[XB_TOPGEN], 1u);
            else XB_SPIN(xb_ld(&bar[XB_TOPGEN]) == tg, bar);
            __builtin_amdgcn_fence(__ATOMIC_ACQUIRE, "agent");
            xb_add(&bar[XB_XGEN(b.x)], 1u);
            asm volatile("s_waitcnt vmcnt(0)" ::: "memory");
        } else {
            XB_SPIN(xb_ld(&bar[XB_XGEN(b.x)]) == gen, bar);
            __builtin_amdgcn_fence(__ATOMIC_ACQUIRE, "agent");
            asm volatile("s_waitcnt vmcnt(0)" ::: "memory");
        }
    }
    __syncthreads();
}
constexpr int DM = 2048, SEQ = 16384, CTXL = 256, ROWS = SEQ + CTXL, NMT = ROWS / 256;
constexpr int DIN = 4608, NMODV = 6 * DM, DEPTH = 2, NE = 32, DE = 512, NIN = 31;
constexpr int MIXP = 2560;
constexpr float LN_EPS = 1e-6f, ALPHA = 1.4142135623730951f;
constexpr float QSCALE = 0.125f * 1.4426950408889634f;
constexpr int LCAP = ROWS;
constexpr int NPH = 2 + 9 * DEPTH;

constexpr size_t MiB = 1u << 20, KiB = 1024;
constexpr size_t WS_CTL = 0, CTL_ZERO_BYTES = 1 * MiB;
constexpr size_t WS_MOD = 1 * MiB;
constexpr size_t WS_SMALL = 2 * MiB;
constexpr size_t WS_BINP = WS_SMALL, WS_ROPE = WS_SMALL + 64 * KiB, WS_BTA = WS_SMALL + 128 * KiB, WS_BTB = WS_SMALL + 192 * KiB, WS_F256 = WS_SMALL + 320 * KiB,
                 WS_LAMV = WS_SMALL + 576 * KiB, WS_CS128 = WS_SMALL + 640 * KiB  ;
constexpr size_t WS_WRT = 3 * MiB;
constexpr size_t WS_MODP = 4 * MiB;
constexpr size_t WS_WFO = 10 * MiB, WS_WPO = 18 * MiB;
constexpr size_t WS_WCAT = 26 * MiB;
constexpr size_t WS_WIN = 46 * MiB;
constexpr size_t WS_WGU = 82 * MiB;
constexpr size_t WS_WD = 210 * MiB;
constexpr size_t WS_XN = 274 * MiB;
constexpr size_t QKV_BYTES = (size_t)ROWS * 1024 * 2;
constexpr size_t WS_Q = 339 * MiB, WS_K = WS_Q + QKV_BYTES, WS_V = WS_K + QKV_BYTES, WS_AG = WS_V + QKV_BYTES;
constexpr size_t WS_YK = WS_Q;
constexpr size_t WS_UF = 469 * MiB, WS_UFC = 485 * MiB, WS_PF2 = 486 * MiB;
constexpr size_t WS_MIX = 518 * MiB;
constexpr size_t WS_T = 600 * MiB;
constexpr size_t WS_X2 = 730 * MiB;
constexpr size_t WS_ACT = 860 * MiB;
constexpr size_t WS_O2N = 902 * MiB;
constexpr size_t WS_LIST = 934 * MiB;
constexpr size_t WS_WTOK = 939 * MiB;
constexpr size_t WS_END = 940 * MiB;
static_assert(WS_AG + QKV_BYTES <= WS_UF && WS_XN + (size_t)ROWS * DM * 2 <= WS_Q && WS_MIX + (size_t)ROWS * MIXP * 2 <= WS_T && WS_T + (size_t)ROWS * DM * 4 <= WS_X2 && WS_X2 + (size_t)ROWS * DM * 4 <= WS_ACT, "ws map");
static_assert(WS_WIN + (size_t)2 * DIN * DM * 2 <= WS_WGU && WS_WGU + (size_t)NE * 1024 * DM * 2 <= WS_WD && WS_WD + (size_t)NE * DM * DE * 2 <= WS_XN && WS_WCAT + (size_t)2 * DM * MIXP * 2 <= WS_WIN, "ws map 2");
constexpr int CW_TMO = 0, CW_CODE = 1, CW_BAR = 4096, CW_CNT = 16384;

constexpr int RING_OFF = 0, RING_BYTES = 139264;
constexpr int LDSCTL_OFF = RING_BYTES, MISC_OFF = LDSCTL_OFF + 320;
constexpr int LDS_BYTES = 147456;
constexpr int NWAVES = 8;

typedef float f32x2v __attribute__((ext_vector_type(2)));
typedef unsigned u32x2v __attribute__((ext_vector_type(2)));
using pg8::Unit;

__device__ __forceinline__ unsigned cvtpk(float lo, float hi) { unsigned r; asm volatile("v_cvt_pk_bf16_f32 %0, %1, %2" : "=v"(r) : "v"(lo), "v"(hi)); return r; }
__device__ __forceinline__ bf16 bf1(float x) { return (bf16)(cvtpk(x, 0.f) & 0xffffu); }
__device__ __forceinline__ float bf2f(unsigned short b) { return __uint_as_float((unsigned)b << 16); }
__device__ __forceinline__ float wave_sum(float v) {
#pragma unroll
    for (int o = 1; o < 64; o <<= 1) v += __shfl_xor(v, o);
    return v;
}
__device__ __forceinline__ float silu_f(float x) { return x / (1.f + __expf(-x)); }

struct Frame {
    LAS unsigned char* lds;
    volatile LAS unsigned* MISC;
    gu32* ctl;
    int tid, lane, wave;
    int vcu, G;
    const float* const* in; float* out; unsigned char* ws;
};

struct SchedWin { pg8::GridOrder go;
    __device__ __forceinline__ bool next(int i, Unit& u) const { return go.next(i, u); }
    __device__ __forceinline__ int arow(const Unit& u, int R) const { return (u.pn < 2 && u.pm >= 1) ? CTXL + 128 * (R & 127) + 2 * (u.pm - 1) + (R >> 7) : u.pm * 256 + R; }
    __device__ __forceinline__ int brow(const Unit& u) const { return u.pn * 256; } };
struct SchedNat { pg8::GridOrder go;
    __device__ __forceinline__ bool next(int i, Unit& u) const { return go.next(i, u); }
    __device__ __forceinline__ int arow(const Unit& u, int R) const { return u.pm * 256 + R; }
    __device__ __forceinline__ int brow(const Unit& u) const { return u.pn * 256; } };
struct SchedFB { pg8::GridOrder go;
    __device__ __forceinline__ bool next(int i, Unit& u) const { return go.next(i, u); }
    __device__ __forceinline__ int arow(const Unit& u, int R) const { return (16 * (u.pm >> 3) + (R & 15)) * 128 + 16 * (u.pm & 7) + (R >> 4); }
    __device__ __forceinline__ int brow(const Unit&) const { return 0; } };
template <int WHICH> struct SchedMoe {
    const LAS int* tstart; const LAS int* cnt; const int* list; int G, c;
    static constexpr int NPN = WHICH == 1 ? 4 : 8;
    __device__ __forceinline__ bool next(int i, Unit& u) const {
        const int L = i * G + c, gt = L / NPN; if (gt >= tstart[NE]) return false;
        int e = 0; while (tstart[e + 1] <= gt) ++e;
        u.pm = gt; u.pn = L % NPN; u.e = e; u.rt = gt - tstart[e]; return true; }
    __device__ __forceinline__ int arow(const Unit& u, int R) const {
        if (WHICH == 2) return u.pm * 256 + R;
        const int slot = u.rt * 256 + R; return slot < cnt[u.e] ? (list[u.e * LCAP + slot] >> 1) : 0; }
    __device__ __forceinline__ int brow(const Unit& u) const { return WHICH == 1 ? u.e * 1024 + u.pn * 256 : u.e * DM + u.pn * 256; } };

struct EpiWin {
    static constexpr bool PERM = true;
    bf16 *Uf, *UfC, *AG, *Q, *Kb, *V; const float* bias; const f32x2v* rope;
    __device__ __forceinline__ void operator()(const f32x4 (&acc)[2][2][4][2], const Unit& u, int wr, int wc, int fr, int fq) const {
        const int pn = u.pn, pm = u.pm, c0 = wc * 32 + 8 * fq;
        f32x4 bv[2][2];
#pragma unroll
        for (int bj = 0; bj < 2; ++bj)
#pragma unroll
            for (int n = 0; n < 2; ++n) bv[bj][n] = *(const f32x4*)(bias + pn * 256 + bj * 128 + c0 + 4 * n);
        if (pn < 2) {
#pragma unroll
            for (int ai = 0; ai < 2; ++ai)
#pragma unroll
                for (int m = 0; m < 4; ++m)
#pragma unroll
                    for (int bj = 0; bj < 2; ++bj) {
                        const f32x4 v0 = acc[ai][bj][m][0] + bv[bj][0], v1 = acc[ai][bj][m][1] + bv[bj][1];
                        const int ch = pn * 256 + bj * 128 + c0, a = wr * 64 + m * 16 + fr;
                        bf16* dst; size_t st;
                        if (pm == 0) { dst = UfC + (size_t)ch * 256 + (ai * 128 + a); st = 256; }
                        else { dst = Uf + ((size_t)ch * 128 + (2 * (pm - 1) + ai)) * 128 + a; st = 128 * 128; }
                        dst[0] = bf1(v0[0]); dst[st] = bf1(v0[1]); dst[2 * st] = bf1(v0[2]); dst[3 * st] = bf1(v0[3]);
                        dst[4 * st] = bf1(v1[0]); dst[5 * st] = bf1(v1[1]); dst[6 * st] = bf1(v1[2]); dst[7 * st] = bf1(v1[3]);
                    }
        } else if (pn < 6 || pn >= 14) {
            bf16* base = pn < 6 ? AG : V; const int colt = (pn < 6 ? pn - 2 : pn - 14) * 256;
#pragma unroll
            for (int ai = 0; ai < 2; ++ai)
#pragma unroll
                for (int m = 0; m < 4; ++m) { bf16* rowp = base + (size_t)(pm * 256 + ai * 128 + wr * 64 + m * 16 + fr) * 1024 + colt + c0;
#pragma unroll
                    for (int bj = 0; bj < 2; ++bj) { const f32x4 v0 = acc[ai][bj][m][0] + bv[bj][0], v1 = acc[ai][bj][m][1] + bv[bj][1];
                        v4u w; w.x = cvtpk(v0[0], v0[1]); w.y = cvtpk(v0[2], v0[3]); w.z = cvtpk(v1[0], v1[1]); w.w = cvtpk(v1[2], v1[3]);
                        *(v4u*)(rowp + bj * 128) = w; } }
        } else {
            const bool isq = pn < 10; bf16* base = isq ? Q : Kb; const int colt = (pn - (isq ? 6 : 10)) * 256; const float sc = isq ? QSCALE : 1.f;
#pragma unroll
            for (int ai = 0; ai < 2; ++ai)
#pragma unroll
                for (int m = 0; m < 4; ++m) { const int row = pm * 256 + ai * 128 + wr * 64 + m * 16 + fr;
                    f32x4 cs0 = (f32x4){1.f, 0.f, 1.f, 0.f}, cs1 = cs0;
                    if (pm > 0) { const int pos = row - CTXL; const int t = (wc & 1) ? 256 + (pos & 63) : (pos >> 6);
                        const f32x4* rp = (const f32x4*)(rope + t * 16 + 4 * fq); cs0 = rp[0]; cs1 = rp[1]; }
                    bf16* rowp = base + (size_t)row * 1024 + colt + c0;
#pragma unroll
                    for (int bj = 0; bj < 2; ++bj) { const f32x4 v0 = acc[ai][bj][m][0] + bv[bj][0], v1 = acc[ai][bj][m][1] + bv[bj][1];
                        const float o0 = (v0[0] * cs0[0] - v0[1] * cs0[1]) * sc, o1 = (v0[0] * cs0[1] + v0[1] * cs0[0]) * sc;
                        const float o2 = (v0[2] * cs0[2] - v0[3] * cs0[3]) * sc, o3 = (v0[2] * cs0[3] + v0[3] * cs0[2]) * sc;
                        const float o4 = (v1[0] * cs1[0] - v1[1] * cs1[1]) * sc, o5 = (v1[0] * cs1[1] + v1[1] * cs1[0]) * sc;
                        const float o6 = (v1[2] * cs1[2] - v1[3] * cs1[3]) * sc, o7 = (v1[2] * cs1[3] + v1[3] * cs1[2]) * sc;
                        v4u w; w.x = cvtpk(o0, o1); w.y = cvtpk(o2, o3); w.z = cvtpk(o4, o5); w.w = cvtpk(o6, o7);
                        *(v4u*)(rowp + bj * 128) = w; } }
        }
    }
};
struct EpiFA {
    static constexpr bool PERM = false;
    bf16* Pf2;
    __device__ __forceinline__ void operator()(const f32x4 (&acc)[2][2][4][2], const Unit& u, int wr, int wc, int fr_, int fq) const {
        int fr = fr_; asm volatile("" : "+v"(fr));
#pragma unroll
        for (int m = 0; m < 4; ++m) { const int b = wr * 64 + m * 16 + fr;
#pragma unroll
            for (int n = 0; n < 2; ++n)
#pragma unroll
                for (int j = 0; j < 4; ++j) { const int klo = 32 * wc + 16 * n + 4 * fq + j;
                    const float f = (float)((b * klo) & 16383) * (1.f / 16384.f);
                    const float c = __builtin_amdgcn_cosf(f), s = __builtin_amdgcn_sinf(f);
#pragma unroll
                    for (int ai = 0; ai < 2; ++ai) { const float re = acc[ai][0][m][n][j], im = acc[ai][1][m][n][j];
                        bf16* d = Pf2 + (size_t)((2 * u.pm + ai) * 128 + klo) * 256 + b;
                        d[0] = bf1(re * c + im * s); d[128] = bf1(im * c - re * s); } }
            asm volatile("" ::: "memory"); }
    }
};
struct EpiFB {
    static constexpr bool PERM = false;
    bf16* MIX;
    __device__ __forceinline__ void operator()(const f32x4 (&acc)[2][2][4][2], const Unit& u, int wr, int wc, int fr, int fq) const {
        const int ch = 16 * (u.pm >> 3) + fr;
#pragma unroll
        for (int ai = 0; ai < 2; ++ai)
#pragma unroll
            for (int m = 0; m < 4; ++m) { const int klo = 16 * (u.pm & 7) + 8 * ai + 4 * wr + m;
#pragma unroll
                for (int bj = 0; bj < 2; ++bj)
#pragma unroll
                    for (int n = 0; n < 2; ++n)
#pragma unroll
                        for (int j = 0; j < 4; ++j) { const int khi = 32 * wc + 16 * n + 4 * fq + j;
                            MIX[(size_t)(CTXL + klo + 128 * khi) * MIXP + bj * 512 + ch] = bf1(acc[ai][bj][m][n][j]); }
                asm volatile("" ::: "memory"); }
    }
};
struct EpiCtxF {
    static constexpr bool PERM = false;
    bf16* MIX;
    __device__ __forceinline__ void operator()(const f32x4 (&acc)[2][2][4][2], const Unit& u, int wr, int wc, int fr, int fq) const {
#pragma unroll
        for (int ai = 0; ai < 2; ++ai)
#pragma unroll
            for (int m = 0; m < 4; ++m) { const int k = ai * 128 + wr * 64 + m * 16 + fr;
#pragma unroll
                for (int bj = 0; bj < 2; ++bj)
#pragma unroll
                    for (int n = 0; n < 2; ++n) { const f32x4 v = acc[ai][bj][m][n]; u32x2v w; w.x = cvtpk(v[0], v[1]); w.y = cvtpk(v[2], v[3]);
                        *(u32x2v*)(MIX + (size_t)k * MIXP + u.pm * 512 + u.pn * 256 + bj * 128 + wc * 32 + 16 * n + 4 * fq) = w; }
                asm volatile("" ::: "memory"); }
    }
};
struct EpiWout {
    static constexpr bool PERM = false;
    const float* xc; const float* xl; const float* mod; float* T;
    __device__ __forceinline__ void operator()(const f32x4 (&acc)[2][2][4][2], const Unit& u, int wr, int wc, int fr, int fq) const {
        const int col0 = u.pn * 256 + wc * 32 + 4 * fq;
        const float* gp = mod + (u.pm == 0 ? NMODV : 0) + 2 * DM + col0;
        f32x4 gv[2][2];
#pragma unroll
        for (int bj = 0; bj < 2; ++bj)
#pragma unroll
            for (int n = 0; n < 2; ++n) gv[bj][n] = *(const f32x4*)(gp + bj * 128 + n * 16);
#pragma unroll
        for (int ai = 0; ai < 2; ++ai)
#pragma unroll
            for (int m = 0; m < 4; ++m) { const int row = u.pm * 256 + ai * 128 + wr * 64 + m * 16 + fr;
                const float* xr = (row < CTXL ? xc + (size_t)row * DM : xl + (size_t)(row - CTXL) * DM) + col0; float* tr = T + (size_t)row * DM + col0;
#pragma unroll
                for (int bj = 0; bj < 2; ++bj)
#pragma unroll
                    for (int n = 0; n < 2; ++n) { const f32x4 xv = *(const f32x4*)(xr + bj * 128 + n * 16);
                        *(f32x4*)(tr + bj * 128 + n * 16) = xv * ALPHA + gv[bj][n] * acc[ai][bj][m][n]; } }
    }
};
struct EpiMoe1 {
    static constexpr bool PERM = true;
    bf16* ACT;
    __device__ __forceinline__ void operator()(const f32x4 (&acc)[2][2][4][2], const Unit& u, int wr, int wc, int fr, int fq) const {
#pragma unroll
        for (int ai = 0; ai < 2; ++ai)
#pragma unroll
            for (int m = 0; m < 4; ++m) { bf16* rowp = ACT + (size_t)(u.pm * 256 + ai * 128 + wr * 64 + m * 16 + fr) * DE + u.pn * 128 + wc * 16 + 4 * fq;
#pragma unroll
                for (int bj = 0; bj < 2; ++bj) { const f32x4 v0 = acc[ai][bj][m][0], v1 = acc[ai][bj][m][1];
                    u32x2v w; w.x = cvtpk(silu_f(v0[0]) * v0[1], silu_f(v0[2]) * v0[3]); w.y = cvtpk(silu_f(v1[0]) * v1[1], silu_f(v1[2]) * v1[3]);
                    *(u32x2v*)(rowp + bj * 64) = w; } }
    }
};
struct EpiMoe2 {
    static constexpr bool PERM = true;
    const LAS int* cnt; const int* list; const float* wtok; bf16* YK;
    __device__ __forceinline__ void operator()(const f32x4 (&acc)[2][2][4][2], const Unit& u, int wr, int wc, int fr, int fq) const {
        const int n = cnt[u.e];
#pragma unroll
        for (int ai = 0; ai < 2; ++ai)
#pragma unroll
            for (int m = 0; m < 4; ++m) { const int slot = u.rt * 256 + ai * 128 + wr * 64 + m * 16 + fr;
                if (slot < n) { const int tk = list[u.e * LCAP + slot]; const float w8 = wtok[tk];
                    bf16* rowp = YK + (size_t)tk * DM + u.pn * 256 + wc * 32 + 8 * fq;
#pragma unroll
                    for (int bj = 0; bj < 2; ++bj) { const f32x4 v0 = acc[ai][bj][m][0] * w8, v1 = acc[ai][bj][m][1] * w8;
                        v4u w; w.x = cvtpk(v0[0], v0[1]); w.y = cvtpk(v0[2], v0[3]); w.z = cvtpk(v1[0], v1[1]); w.w = cvtpk(v1[2], v1[3]);
                        *(v4u*)(rowp + bj * 128) = w; } } }
    }
};
template <int MODE> __device__ __forceinline__ int t_rowmap(int n) {
    if (MODE == 2) return 2 * n; if (MODE == 3) return 2 * n + 1;
    if (MODE == 1) { if (n >= 1536 && n < 3584) { const int q = n - 1536, d = q & 63; return 1536 + (q & ~63) + (d < 32 ? 2 * d : 2 * (d - 32) + 1); } return n; }
    return n; }
template <int MODE> __device__ __forceinline__ void transpose_item(const float* W, int ldw, int nblk, bf16* WT, int dpitch, int dcol0, LAS float* scr, int item, int lane) {
    const int kb = item / nblk, nb = item % nblk, k0 = 64 * kb, n0 = 32 * nb;
#pragma unroll 8
    for (int i = 0; i < 32; ++i) { const int kk = 2 * i + (lane >> 5); scr[kk * 33 + (lane & 31)] = W[(size_t)(k0 + kk) * ldw + n0 + (lane & 31)]; }
    LDS_WAIT(); asm volatile("" ::: "memory");
    const int c = lane & 7;
#pragma unroll
    for (int j = 0; j < 4; ++j) { const int n = (lane >> 3) + 8 * j; const LAS float* s = scr + (8 * c) * 33 + n;
        v4u o; o.x = pk2(s[0 * 33], s[1 * 33]); o.y = pk2(s[2 * 33], s[3 * 33]); o.z = pk2(s[4 * 33], s[5 * 33]); o.w = pk2(s[6 * 33], s[7 * 33]);
        *(GAS v4u*)(WT + (size_t)t_rowmap<MODE>(n0 + n) * dpitch + dcol0 + k0 + 8 * c) = o; }
    LDS_WAIT(); asm volatile("" ::: "memory");
}
__device__ __forceinline__ void convert_experts(Frame& F, int l, LAS float* scr) {
    const int gw = F.vcu * NWAVES + F.wave, NGW = F.G * NWAVES;
    bf16* WGU = (bf16*)(F.ws + WS_WGU); bf16* WD = (bf16*)(F.ws + WS_WD);
    for (int it = gw; it < NE * 1536; it += NGW) { const int e = it / 1536, r = it % 1536;
        if (r < 512) transpose_item<2>(F.in[26] + (size_t)(l * NE + e) * DM * DE, DE, 16, WGU + (size_t)e * 1024 * DM, DM, 0, scr, r, F.lane);
        else if (r < 1024) transpose_item<3>(F.in[27] + (size_t)(l * NE + e) * DM * DE, DE, 16, WGU + (size_t)e * 1024 * DM, DM, 0, scr, r - 512, F.lane);
        else transpose_item<0>(F.in[28] + (size_t)(l * NE + e) * DE * DM, DM, 64, WD + (size_t)e * DM * DE, DE, 0, scr, r - 1024, F.lane); }
}
__device__ __forceinline__ void f32gemm_tile(const float* A, int lda, const float* B, int ldb, int Kd, int mb, int nb, int lane, f32x4 (&acc)[4]) {
    const int n = nb * 256 + lane * 4;
#pragma unroll
    for (int i = 0; i < 4; ++i) acc[i] = (f32x4){0.f, 0.f, 0.f, 0.f};
    const float* a0 = A + (size_t)(mb * 4) * lda;
#pragma unroll 4
    for (int k = 0; k < Kd; ++k) { const f32x4 b = *(const f32x4*)(B + (size_t)k * ldb + n);
#pragma unroll
        for (int i = 0; i < 4; ++i) acc[i] += b * a0[(size_t)i * lda + k]; }
}

__device__ __forceinline__ void ph_prologue_a(Frame& F) {
    const int gw = F.vcu * NWAVES + F.wave, NGW = F.G * NWAVES;
    { LAS float* sil = (LAS float*)(F.lds + RING_OFF);
      for (int i = F.tid; i < 2 * DM; i += NWAVES * 64) { const float x = i < DM ? F.in[1][i] : F.in[3][i - DM]; sil[i] = silu_f(x); }
      __syncthreads();
      float* MODP = (float*)(F.ws + WS_MODP);
      for (int it = F.vcu; it < 32 * 48; it += F.G) { const int kc = it & 31, rest = it >> 5, l = rest / 24, jb = rest % 24, j = jb * 512 + F.tid;
          const float* W = F.in[4] + ((size_t)l * DM + kc * 64) * NMODV + j; float s0 = 0.f, s1 = 0.f;
#pragma unroll 16
          for (int k = 0; k < 64; ++k) { const float w = W[(size_t)k * NMODV]; s0 += w * sil[kc * 64 + k]; s1 += w * sil[DM + kc * 64 + k]; }
          MODP[((size_t)(kc * 2 + l) * 2 + 0) * NMODV + j] = s0; MODP[((size_t)(kc * 2 + l) * 2 + 1) * NMODV + j] = s1; }
      __syncthreads(); }
    LAS float* scr = (LAS float*)(F.lds + RING_OFF + F.wave * 16384);
    for (int it = gw; it < 2 * 4608 + 2 * 1024; it += NGW) {
        if (it < 9216) { const int l = it / 4608, r = it % 4608; transpose_item<1>(F.in[6] + (size_t)l * DM * DIN, DIN, 144, (bf16*)(F.ws + WS_WIN) + (size_t)l * DIN * DM, DM, 0, scr, r, F.lane); }
        else { const int q = it - 9216, l = q / 1024, r = q % 1024; transpose_item<0>(F.in[19] + (size_t)l * DM * DM + (size_t)1024 * DM, DM, 64, (bf16*)(F.ws + WS_WCAT) + (size_t)l * DM * MIXP, MIXP, 1536, scr, r, F.lane); } }
    convert_experts(F, 0, scr);
    for (int wt = gw; wt < 4 * 1024; wt += NGW) { const int gsel = wt >> 10, l = gsel >> 1, which = gsel & 1, r = wt & 1023, mb = r >> 3, nb = r & 7;
        const float* A = (which ? F.in[13] : F.in[8]) + (size_t)l * 512 * 512; const float* B = F.in[19] + (size_t)l * DM * DM + (size_t)(which ? 512 : 0) * DM;
        float* C = (float*)(F.ws + (which ? WS_WPO : WS_WFO)) + (size_t)l * 512 * DM;
        f32x4 acc[4]; f32gemm_tile(A, 512, B, DM, 512, mb, nb, F.lane, acc);
#pragma unroll
        for (int i = 0; i < 4; ++i) *(f32x4*)(C + (size_t)(mb * 4 + i) * DM + nb * 256 + F.lane * 4) = acc[i]; }
    { const int gt = F.vcu * NWAVES * 64 + F.tid, NT = F.G * NWAVES * 64;
      constexpr int R0 = 9216, R1 = R0 + 5120, R2 = R1 + 32768, R3 = R2 + 65536, R4 = R3 + 131072, R5 = R4 + 32768, R6 = R5 + 49152, R7 = R6 + 2;
      for (int idx = gt; idx < R7; idx += NT) {
          if (idx < R0) { const int l = idx / DIN, c = idx % DIN; int src = c;
              if (c >= 1536 && c < 3584) { const int q = c - 1536, p = q & 63; src = 1536 + (q & ~63) + (p & 1) * 32 + (p >> 1); }
              ((float*)(F.ws + WS_BINP))[idx] = F.in[7][l * DIN + src]; }
          else if (idx < R1) { const int q = idx - R0, t = q >> 4, i = q & 15, p = t < 256 ? t : t - 256;
              const float inv = 1.0f / powf(10000.0f, (float)i / 16.0f), ang = (float)p * inv; float s, c; sincosf(ang, &s, &c);
              ((f32x2v*)(F.ws + WS_ROPE))[q] = (f32x2v){c, s}; }
          else if (idx < R2) { const int q = idx - R1, np = q >> 7, a = q & 127, kk = np & 127; float s, c; sincospif(2.0f * (float)((a * kk) & 127) / 128.0f, &s, &c);
              ((bf16*)(F.ws + WS_BTA))[q] = bf1((np < 128 ? c : -s) * 0.08838834764831845f); }
          else if (idx < R3) { const int q = idx - R2, np = q >> 8, k = q & 255, khi = np & 127, b = k & 127; float s, c; sincospif(2.0f * (float)((b * khi) & 127) / 128.0f, &s, &c);
              const float v = np < 128 ? (k < 128 ? c : s) : (k < 128 ? -s : c); ((bf16*)(F.ws + WS_BTB))[q] = bf1(v * 0.08838834764831845f); }
          else if (idx < R4) { const int q = idx - R3, r = q >> 8, n = q & 255, k = r & 255; float s, c; sincospif(2.0f * (float)((k * n) & 255) / 256.0f, &s, &c);
              ((bf16*)(F.ws + WS_F256))[q] = bf1((r < 256 ? c : -s) * 0.0625f); }
          else if (idx < R5) { const int q = idx - R4, part = q >> 14, m = (q >> 7) & 127, j = q & 127; float s, c; sincospif(2.0f * (float)((m * j) & 127) / 128.0f, &s, &c);
              ((float*)(F.ws + WS_CS128))[q] = part ? s : c; }
          else if (idx < R6) { const int q = idx - R5, l = q / 24576, r = q % 24576, hl = r / 12288, r2 = r % 12288, ks = r2 / 192, nt = (r2 / 64) % 3, ln = r2 & 63;
              const int n = 16 * nt + (ln & 15), k0 = 32 * ks + 8 * (ln >> 4); unsigned short o[8];
#pragma unroll
              for (int j = 0; j < 8; ++j) { const int k = k0 + j; float w = 0.f;
                  if (n < 4) w = F.in[22][((size_t)l * DM + k) * 4 + n]; else if (n < 36) w = F.in[24][((size_t)l * DM + k) * 32 + (n - 4)];
                  const unsigned short h = bf1(w); o[j] = hl ? bf1(w - bf2f(h)) : h; }
              v4u w4; w4.x = o[0] | ((unsigned)o[1] << 16); w4.y = o[2] | ((unsigned)o[3] << 16); w4.z = o[4] | ((unsigned)o[5] << 16); w4.w = o[6] | ((unsigned)o[7] << 16);
              ((v4u*)(F.ws + WS_WRT))[q] = w4; }
          else { const int l = idx - R6; float a = 0.f, b = 0.f;
              for (int i = 0; i < 64; ++i) { a += F.in[14][l * 64 + i] * F.in[15][l * 64 + i]; b += F.in[16][l * 64 + i] * F.in[17][l * 64 + i]; }
              const float lam_init = 0.8f - 0.6f * expf(-0.3f * (float)l);
              ((float*)(F.ws + WS_LAMV))[l] = expf(a) - expf(b) + lam_init; }
      } }
}
__device__ __forceinline__ void ph_prologue_b(Frame& F) {
    const int gw = F.vcu * NWAVES + F.wave, NGW = F.G * NWAVES;
    { const int gt = F.vcu * NWAVES * 64 + F.tid, NT = F.G * NWAVES * 64; const float* MODP = (const float*)(F.ws + WS_MODP); float* MOD = (float*)(F.ws + WS_MOD);
      for (int idx = gt; idx < 4 * NMODV; idx += NT) { const int lv = idx / NMODV, j = idx % NMODV, l = lv >> 1; float s = F.in[5][l * NMODV + j];
          for (int kc = 0; kc < 32; ++kc) s += MODP[((size_t)kc * 4 + lv) * NMODV + j];
          MOD[idx] = s; } }
    for (int wt = gw; wt < 16 * 256; wt += NGW) { const int sel = wt >> 8, l = sel >> 3, g = (sel >> 1) & 3, part = sel & 1, r = wt & 255, mb = r >> 3, nb = r & 7;
        const float* A = (const float*)(F.ws + WS_CS128) + part * 16384; const float* B = (const float*)(F.ws + WS_WFO) + (size_t)l * 512 * DM + (size_t)(128 * g) * DM;
        f32x4 acc[4]; f32gemm_tile(A, 128, B, DM, 128, mb, nb, F.lane, acc);
        bf16* WC = (bf16*)(F.ws + WS_WCAT) + (size_t)l * DM * MIXP; const int n = nb * 256 + F.lane * 4; const float sc = 0.08838834764831845f;
#pragma unroll
        for (int c = 0; c < 4; ++c) { u32x2v w; w.x = cvtpk(acc[0][c] * sc, acc[1][c] * sc); w.y = cvtpk(acc[2][c] * sc, acc[3][c] * sc);
            *(u32x2v*)(WC + (size_t)(n + c) * MIXP + part * 512 + g * 128 + mb * 4) = w; } }
    LAS float* scr = (LAS float*)(F.lds + RING_OFF + F.wave * 16384);
    for (int it = gw; it < 2 * 512; it += NGW) { const int l = it >> 9, r = it & 511;
        transpose_item<0>((const float*)(F.ws + WS_WPO) + (size_t)l * 512 * DM, DM, 64, (bf16*)(F.ws + WS_WCAT) + (size_t)l * DM * MIXP, MIXP, 1024, scr, r, F.lane); }
}

struct RowV { f32x4 v[8]; };
__device__ __forceinline__ void row_load(RowV& r, const float* p, int lane) {
#pragma unroll
    for (int j = 0; j < 4; ++j) { r.v[2 * j] = *(const f32x4*)(p + 512 * j + 8 * lane); r.v[2 * j + 1] = *(const f32x4*)(p + 512 * j + 8 * lane + 4); } }
__device__ __forceinline__ void row_store(const RowV& r, float* p, int lane) {
#pragma unroll
    for (int j = 0; j < 4; ++j) { *(f32x4*)(p + 512 * j + 8 * lane) = r.v[2 * j]; *(f32x4*)(p + 512 * j + 8 * lane + 4) = r.v[2 * j + 1]; } }
__device__ __forceinline__ void row_norm(RowV& r) {
    float s = 0.f;
#pragma unroll
    for (int i = 0; i < 8; ++i) s += (r.v[i][0] + r.v[i][1]) + (r.v[i][2] + r.v[i][3]);
    const float mean = wave_sum(s) * (1.f / DM); float q = 0.f;
#pragma unroll
    for (int i = 0; i < 8; ++i) { r.v[i] = r.v[i] - mean; q += (r.v[i][0] * r.v[i][0] + r.v[i][1] * r.v[i][1]) + (r.v[i][2] * r.v[i][2] + r.v[i][3] * r.v[i][3]); }
    const float rstd = 1.f / sqrtf(wave_sum(q) * (1.f / DM) + LN_EPS);
#pragma unroll
    for (int i = 0; i < 8; ++i) r.v[i] = r.v[i] * rstd; }
__device__ __forceinline__ void row_affine(RowV& r, const float* mulp, float madd, const float* addp, int lane) {
#pragma unroll
    for (int j = 0; j < 4; ++j)
#pragma unroll
        for (int h = 0; h < 2; ++h) { const f32x4 m = *(const f32x4*)(mulp + 512 * j + 8 * lane + 4 * h), a = *(const f32x4*)(addp + 512 * j + 8 * lane + 4 * h);
            r.v[2 * j + h] = r.v[2 * j + h] * (m + madd) + a; } }
__device__ __forceinline__ void row_store_bf16(const RowV& r, bf16* p, int lane) {
#pragma unroll
    for (int j = 0; j < 4; ++j) { v4u w; w.x = cvtpk(r.v[2 * j][0], r.v[2 * j][1]); w.y = cvtpk(r.v[2 * j][2], r.v[2 * j][3]); w.z = cvtpk(r.v[2 * j + 1][0], r.v[2 * j + 1][1]); w.w = cvtpk(r.v[2 * j + 1][2], r.v[2 * j + 1][3]);
        *(v4u*)(p + 512 * j + 8 * lane) = w; } }

__device__ __forceinline__ void ph_ln1(Frame& F, int l, const float* xc, const float* xl) {
    const int gw = F.vcu * NWAVES + F.wave, NGW = F.G * NWAVES; const float* MOD = (const float*)(F.ws + WS_MOD) + (size_t)l * 2 * NMODV; bf16* XN = (bf16*)(F.ws + WS_XN);
    for (int r = gw; r < ROWS; r += NGW) { const float* xp = r < CTXL ? xc + (size_t)r * DM : xl + (size_t)(r - CTXL) * DM; const float* mp = MOD + (r < CTXL ? NMODV : 0);
        RowV v; row_load(v, xp, F.lane); row_norm(v); row_affine(v, mp + DM, 1.f, mp, F.lane); row_store_bf16(v, XN + (size_t)r * DM, F.lane); }
}

__device__ __forceinline__ void conv_unit(Frame& F, int l, int ub) {
    const int row0 = 32 * ub, lo = row0 < CTXL ? 0 : CTXL, hi = row0 < CTXL ? CTXL : ROWS;
    const bf16* AG = (const bf16*)(F.ws + WS_AG); bf16* MIX = (bf16*)(F.ws + WS_MIX);
    LAS bf16* U = (LAS bf16*)(F.lds + RING_OFF);
    LAS float* Y = (LAS float*)(F.lds + RING_OFF + 65536);
    for (int it = F.tid; it < 62 * 64; it += NWAVES * 64) { const int t = it >> 6, c8 = (it & 63) * 8, gr = row0 - 15 + t;
        v4u o = (v4u){0u, 0u, 0u, 0u};
        if (gr >= lo && gr < hi) { const v4u a = *(const v4u*)(AG + (size_t)gr * 1024 + c8), g = *(const v4u*)(AG + (size_t)gr * 1024 + 512 + c8);
            const unsigned aw[4] = {a.x, a.y, a.z, a.w}, gw[4] = {g.x, g.y, g.z, g.w}; unsigned ow[4];
#pragma unroll
            for (int q = 0; q < 4; ++q) { const float a0 = __uint_as_float(aw[q] << 16), a1 = __uint_as_float(aw[q] & 0xffff0000u), g0 = __uint_as_float(gw[q] << 16), g1 = __uint_as_float(gw[q] & 0xffff0000u);
                ow[q] = cvtpk(a0 / (1.f + __expf(-g0)), a1 / (1.f + __expf(-g1))); }
            o = (v4u){ow[0], ow[1], ow[2], ow[3]}; }
        *(LAS v4u*)(U + t * 512 + c8) = o; }
    __syncthreads();
    { const int c = F.tid; float w[31];
#pragma unroll
      for (int j = 0; j < 31; ++j) w[j] = F.in[9][((size_t)l * 31 + j) * 512 + c];
      const float cb = F.in[10][l * 512 + c];
#pragma unroll
      for (int half = 0; half < 2; ++half) { float u[46];
#pragma unroll
          for (int t = 0; t < 46; ++t) u[t] = bf2f(U[(half * 16 + t) * 512 + c]);
#pragma unroll
          for (int n = 0; n < 16; ++n) { float s = cb;
#pragma unroll
              for (int j = 0; j < 31; ++j) s += u[n + j] * w[j];
              Y[(half * 16 + n) * 512 + c] = s; } } }
    __syncthreads();
    { const float* lg = F.in[11] + l * 512 + 8 * F.lane; const float* lb = F.in[12] + l * 512 + 8 * F.lane;
      const f32x4 g0 = *(const f32x4*)lg, g1 = *(const f32x4*)(lg + 4), b0 = *(const f32x4*)lb, b1 = *(const f32x4*)(lb + 4);
#pragma unroll
      for (int i = 0; i < 4; ++i) { const int n = 4 * F.wave + i; f32x4 y0 = *(LAS f32x4*)(Y + n * 512 + 8 * F.lane), y1 = *(LAS f32x4*)(Y + n * 512 + 8 * F.lane + 4);
          const float mean = wave_sum((y0[0] + y0[1]) + (y0[2] + y0[3]) + (y1[0] + y1[1]) + (y1[2] + y1[3])) * (1.f / 512.f);
          y0 = y0 - mean; y1 = y1 - mean;
          const float var = wave_sum((y0[0] * y0[0] + y0[1] * y0[1]) + (y0[2] * y0[2] + y0[3] * y0[3]) + (y1[0] * y1[0] + y1[1] * y1[1]) + (y1[2] * y1[2] + y1[3] * y1[3])) * (1.f / 512.f);
          const float rstd = 1.f / sqrtf(var + LN_EPS);
          y0 = y0 * rstd * g0 + b0; y1 = y1 * rstd * g1 + b1;
          v4u w4; w4.x = cvtpk(silu_f(y0[0]), silu_f(y0[1])); w4.y = cvtpk(silu_f(y0[2]), silu_f(y0[3])); w4.z = cvtpk(silu_f(y1[0]), silu_f(y1[1])); w4.w = cvtpk(silu_f(y1[2]), silu_f(y1[3]));
          *(v4u*)(MIX + (size_t)(row0 + n) * MIXP + 1024 + 8 * F.lane) = w4; } }
    __syncthreads();
}
constexpr int HP = DM + 8;
__device__ __forceinline__ void ph_ln_router(Frame& F, int l) {
    const float* MOD = (const float*)(F.ws + WS_MOD) + (size_t)l * 2 * NMODV; float* T = (float*)(F.ws + WS_T); bf16* XN = (bf16*)(F.ws + WS_XN);
    const float* ga = F.in[20] + (size_t)l * DM; const float* ba = F.in[21] + (size_t)l * DM;
    const v4u* WRT = (const v4u*)(F.ws + WS_WRT) + (size_t)l * 24576;
    int* LIST = (int*)(F.ws + WS_LIST) + (size_t)l * NE * LCAP; float* WTOK = (float*)(F.ws + WS_WTOK) + (size_t)l * 2 * ROWS;
    LAS bf16* HHI = (LAS bf16*)(F.lds + RING_OFF); LAS bf16* HLO = HHI + 16 * HP;
    LAS float* PART = (LAS float*)(F.lds + RING_OFF);
    LAS float* LOGI = (LAS float*)(F.lds + RING_OFF + 32768);
    const int fr = F.lane & 15, fq = F.lane >> 4;
    for (int blk = F.vcu; blk < ROWS / 16; blk += F.G) {
#pragma unroll 1
        for (int i = 0; i < 2; ++i) { const int rl = 2 * F.wave + i, r = blk * 16 + rl; const float* mp = MOD + (r < CTXL ? NMODV : 0);
            RowV v; row_load(v, T + (size_t)r * DM, F.lane); row_norm(v); row_affine(v, ga, 0.f, ba, F.lane); row_store(v, T + (size_t)r * DM, F.lane);
            row_norm(v); row_affine(v, mp + 4 * DM, 1.f, mp + 3 * DM, F.lane);
#pragma unroll
            for (int j = 0; j < 4; ++j) { unsigned hw[4], lw[4];
#pragma unroll
                for (int q = 0; q < 4; ++q) { const float a = v.v[2 * j + (q >> 1)][(q & 1) * 2], b = v.v[2 * j + (q >> 1)][(q & 1) * 2 + 1];
                    const unsigned h = cvtpk(a, b); hw[q] = h; lw[q] = cvtpk(a - __uint_as_float(h << 16), b - __uint_as_float(h & 0xffff0000u)); }
                const v4u h4 = (v4u){hw[0], hw[1], hw[2], hw[3]}, l4 = (v4u){lw[0], lw[1], lw[2], lw[3]};
                *(v4u*)(XN + (size_t)r * DM + 512 * j + 8 * F.lane) = h4;
                *(LAS v4u*)(HHI + rl * HP + 512 * j + 8 * F.lane) = h4; *(LAS v4u*)(HLO + rl * HP + 512 * j + 8 * F.lane) = l4; } }
        __syncthreads();
        f32x4 acc[3];
#pragma unroll
        for (int n = 0; n < 3; ++n) acc[n] = (f32x4){0.f, 0.f, 0.f, 0.f};
#pragma unroll 2
        for (int s = 0; s < 8; ++s) { const int ks = 8 * F.wave + s;
            const bf16x8 xh = *(const LAS bf16x8*)(HHI + fr * HP + ks * 32 + fq * 8), xl = *(const LAS bf16x8*)(HLO + fr * HP + ks * 32 + fq * 8);
#pragma unroll
            for (int n = 0; n < 3; ++n) { const v4u wh4 = WRT[((size_t)(0 * 64 + ks) * 3 + n) * 64 + F.lane], wl4 = WRT[((size_t)(1 * 64 + ks) * 3 + n) * 64 + F.lane];
                const bf16x8 wh = __builtin_bit_cast(bf16x8, wh4), wl = __builtin_bit_cast(bf16x8, wl4);
                acc[n] = __builtin_amdgcn_mfma_f32_16x16x32_bf16(wh, xh, acc[n], 0, 0, 0);
                acc[n] = __builtin_amdgcn_mfma_f32_16x16x32_bf16(wh, xl, acc[n], 0, 0, 0);
                acc[n] = __builtin_amdgcn_mfma_f32_16x16x32_bf16(wl, xh, acc[n], 0, 0, 0); } }
        __syncthreads();
#pragma unroll
        for (int n = 0; n < 3; ++n)
#pragma unroll
            for (int i = 0; i < 4; ++i) PART[(F.wave * 16 + fr) * 48 + 16 * n + 4 * fq + i] = acc[n][i];
        __syncthreads();
        for (int t = F.tid; t < 16 * 36; t += NWAVES * 64) { const int m = t / 36, n = t % 36; float s = n < 4 ? F.in[23][l * 4 + n] : F.in[25][l * 32 + (n - 4)];
#pragma unroll
            for (int w = 0; w < 8; ++w) s += PART[(w * 16 + m) * 48 + n];
            LOGI[m * 36 + n] = s; }
        __syncthreads();
        if (F.tid < 16) { const int r = blk * 16 + F.tid; const LAS float* lg = LOGI + F.tid * 36;
            int gi = 0; float gm = lg[0];
#pragma unroll
            for (int j = 1; j < 4; ++j) if (lg[j] > gm) { gm = lg[j]; gi = j; }
            float gs = 0.f;
#pragma unroll
            for (int j = 0; j < 4; ++j) gs += __expf(lg[j] - gm);
            const float wg = 1.f / gs;
            const LAS float* le = lg + 4 + gi * 8; int i1 = 0; float m1 = le[0];
#pragma unroll
            for (int j = 1; j < 8; ++j) if (le[j] > m1) { m1 = le[j]; i1 = j; }
            int i2 = -1; float m2 = -3.0e38f;
#pragma unroll
            for (int j = 0; j < 8; ++j) if (j != i1 && le[j] > m2) { m2 = le[j]; i2 = j; }
            const float e2 = __expf(m2 - m1), w1 = wg / (1.f + e2), w2 = wg * e2 / (1.f + e2);
            const int ea = gi * 8 + i1, eb = gi * 8 + i2;
            const int sa = (int)__hip_atomic_fetch_add(F.ctl + CW_CNT + (l * NE + ea) * 64, 1u, RLX_AGENT), sb = (int)__hip_atomic_fetch_add(F.ctl + CW_CNT + (l * NE + eb) * 64, 1u, RLX_AGENT);
            LIST[ea * LCAP + sa] = r * 2; LIST[eb * LCAP + sb] = r * 2 + 1; WTOK[r * 2] = w1; WTOK[r * 2 + 1] = w2; }
        __syncthreads();
    }
}
__device__ __forceinline__ void moe_setup(Frame& F, int l, LAS int* tstart, LAS int* cnt) {
    if (F.tid < NE) cnt[F.tid] = (int)__hip_atomic_load(F.ctl + CW_CNT + (l * NE + F.tid) * 64, RLX_AGENT);
    __syncthreads();
    if (F.tid == 0) { int s = 0; for (int e = 0; e < NE; ++e) { tstart[e] = s; s += (cnt[e] + 255) >> 8; } tstart[NE] = s; }
    __syncthreads();
}
__device__ __forceinline__ void ph_ln_final(Frame& F, int l, float* outc, float* outl) {
    const int gw = F.vcu * NWAVES + F.wave, NGW = F.G * NWAVES;
    const float* MOD = (const float*)(F.ws + WS_MOD) + (size_t)l * 2 * NMODV; const float* X1 = (const float*)(F.ws + WS_T); const bf16* YK = (const bf16*)(F.ws + WS_YK);
    const float* gf = F.in[29] + (size_t)l * DM; const float* bfp = F.in[30] + (size_t)l * DM;
    for (int r = gw; r < ROWS; r += NGW) { if (r < CTXL && outc == nullptr) continue;
        const float* mp = MOD + (r < CTXL ? NMODV : 0) + 5 * DM;
        RowV v; row_load(v, X1 + (size_t)r * DM, F.lane);
#pragma unroll
        for (int j = 0; j < 4; ++j) { const v4u a = *(const v4u*)(YK + (size_t)(2 * r) * DM + 512 * j + 8 * F.lane), b = *(const v4u*)(YK + (size_t)(2 * r + 1) * DM + 512 * j + 8 * F.lane);
            const f32x4 g0 = *(const f32x4*)(mp + 512 * j + 8 * F.lane), g1 = *(const f32x4*)(mp + 512 * j + 8 * F.lane + 4);
            const f32x4 y0 = (f32x4){__uint_as_float(a.x << 16) + __uint_as_float(b.x << 16), __uint_as_float(a.x & 0xffff0000u) + __uint_as_float(b.x & 0xffff0000u),
                                     __uint_as_float(a.y << 16) + __uint_as_float(b.y << 16), __uint_as_float(a.y & 0xffff0000u) + __uint_as_float(b.y & 0xffff0000u)};
            const f32x4 y1 = (f32x4){__uint_as_float(a.z << 16) + __uint_as_float(b.z << 16), __uint_as_float(a.z & 0xffff0000u) + __uint_as_float(b.z & 0xffff0000u),
                                     __uint_as_float(a.w << 16) + __uint_as_float(b.w << 16), __uint_as_float(a.w & 0xffff0000u) + __uint_as_float(b.w & 0xffff0000u)};
            v.v[2 * j] = v.v[2 * j] * ALPHA + g0 * y0; v.v[2 * j + 1] = v.v[2 * j + 1] * ALPHA + g1 * y1; }
        row_norm(v); row_affine(v, gf, 0.f, bfp, F.lane);
        row_store(v, r < CTXL ? outc + (size_t)r * DM : outl + (size_t)(r - CTXL) * DM, F.lane); }
}

#ifndef MK_ONE_LAUNCH
#define MK_ONE_LAUNCH 0
#endif
struct Args { const float* in[NIN]; float* out; unsigned char* ws; int ph_lo, ph_hi, pad0, pad1; };
__global__ void __launch_bounds__(NWAVES * 64, 2) mk_fwd(Args args) {
    extern __shared__ __attribute__((aligned(16))) unsigned char lds[];
    Frame F;
    F.lds = (LAS unsigned char*)lds;
    F.MISC = (volatile LAS unsigned*)(F.lds + MISC_OFF);
    F.tid = threadIdx.x; F.lane = F.tid & 63; F.wave = __builtin_amdgcn_readfirstlane(F.tid >> 6);
    F.G = gridDim.x; { const int bx = blockIdx.x; F.vcu = (F.G % 8 == 0) ? (bx % 8) * (F.G / 8) + bx / 8 : bx; }
    F.ws = args.ws; F.out = args.out; F.ctl = (gu32*)(args.ws + WS_CTL);
    F.in = args.in;
    for (int u = F.tid; u < (LDS_BYTES - LDSCTL_OFF) / 4; u += NWAVES * 64) ((LAS unsigned*)(F.lds + LDSCTL_OFF))[u] = 0u;
    __syncthreads();
#if MK_ONE_LAUNCH
    XcdBarrier bar = xcd_barrier_post((unsigned*)(F.ctl + CW_BAR), F.MISC + 8);
#define GRID_BAR() xcd_barrier(bar)
#else
#define GRID_BAR() do { } while (0)
#endif
    const int lo = args.ph_lo, hi = args.ph_hi;
#ifdef ONLY_REL
#define IN(k) (lo <= (k) && (k) < hi && ((k) < 2 ? (k) == ONLY_REL - 100 : ((k) - 2) % 9 == ONLY_REL))
#else
#define IN(k) (lo <= (k) && (k) < hi)
#endif
#define SEAM(k) do { if (IN(k) && IN((k) + 1)) GRID_BAR(); } while (0)
#define PHASE_BEGIN() do { unsigned char* w_ = args.ws; float* o_ = args.out; asm volatile("" : "+s"(w_), "+s"(o_)); F.ws = w_; F.out = o_; F.ctl = (gu32*)(w_ + WS_CTL); \
        int t_ = threadIdx.x; asm volatile("" : "+v"(t_)); F.tid = t_; F.lane = t_ & 63; F.wave = __builtin_amdgcn_readfirstlane(t_ >> 6); } while (0)
    LAS int* tstart = (LAS int*)(F.lds + LDSCTL_OFF); LAS int* ecnt = (LAS int*)(F.lds + LDSCTL_OFF + 136);
    char* ldsg = (char*)lds + RING_OFF;

    if (IN(0)) { PHASE_BEGIN(); ph_prologue_a(F); } SEAM(0);
    if (IN(1)) { PHASE_BEGIN(); ph_prologue_b(F); } SEAM(1);
#pragma unroll 1
    for (int l = 0; l < DEPTH; ++l) {
        const int P = 2 + 9 * l;
        const float* xc = l == 0 ? F.in[2] : (const float*)(F.ws + WS_X2);
        const float* xl = l == 0 ? F.in[0] : (const float*)(F.ws + WS_X2) + (size_t)CTXL * DM;
        const float* MODL = (const float*)(F.ws + WS_MOD) + (size_t)l * 2 * NMODV;
        if (IN(P + 0)) { PHASE_BEGIN(); ph_ln1(F, l, xc, xl); } SEAM(P + 0);
        if (IN(P + 1)) { PHASE_BEGIN();
            pg8::Gemm g{(const bf16*)(F.ws + WS_XN), (const bf16*)(F.ws + WS_WIN) + (size_t)l * DIN * DM, DM, DM};
            SchedWin S; S.go.init(NMT, DIN / 256, F.G, (int)blockIdx.x);
            EpiWin E{(bf16*)(F.ws + WS_UF), (bf16*)(F.ws + WS_UFC), (bf16*)(F.ws + WS_AG), (bf16*)(F.ws + WS_Q), (bf16*)(F.ws + WS_K), (bf16*)(F.ws + WS_V),
                     (const float*)(F.ws + WS_BINP) + l * DIN, (const f32x2v*)(F.ws + WS_ROPE)};
            pg8::gemm_phase<EpiWin, SchedWin>(F.lds + RING_OFF, g, S, E);
        } SEAM(P + 1);
        if (IN(P + 2)) { PHASE_BEGIN();
            attn::Tensors AT{(const bf16*)(F.ws + WS_Q), (const bf16*)(F.ws + WS_K), (const bf16*)(F.ws + WS_V), (bf16*)(F.ws + WS_MIX),
                             (float*)(F.ws + WS_O2N) + (size_t)blockIdx.x * 64 * 512, F.in[18] + l * 128, ((const float*)(F.ws + WS_LAMV))[l], 1.f - (0.8f - 0.6f * expf(-0.3f * (float)l))};
#ifndef NO_ATT
            for (int u = F.vcu; u < 512; u += F.G) attn::attn_unit(u >> 6, 256 * (1 + (u & 63)), ROWS / 64, AT, ldsg);
            for (int u = F.vcu; u < 8; u += F.G) attn::attn_unit(u, 0, CTXL / 64, AT, ldsg);
#endif
#ifndef NO_CONV
            for (int u = F.vcu; u < ROWS / 32; u += F.G) conv_unit(F, l, u);
#endif
#ifndef NO_FA
            { pg8::Gemm g{(const bf16*)(F.ws + WS_UF), (const bf16*)(F.ws + WS_BTA), 128, 128};
              SchedNat S; S.go.init(256, 1, F.G, (int)blockIdx.x); EpiFA E{(bf16*)(F.ws + WS_PF2)};
              pg8::gemm_phase<EpiFA, SchedNat>(F.lds + RING_OFF, g, S, E); }
#endif
#ifndef NO_CTXF
            { pg8::Gemm g{(const bf16*)(F.ws + WS_F256), (const bf16*)(F.ws + WS_UFC), 256, 256};
              SchedNat S; S.go.init(2, 2, F.G, (int)((blockIdx.x + 128) % F.G)); EpiCtxF E{(bf16*)(F.ws + WS_MIX)};
              pg8::gemm_phase<EpiCtxF, SchedNat>(F.lds + RING_OFF, g, S, E); }
#endif
        } SEAM(P + 2);
        if (IN(P + 3)) { PHASE_BEGIN();
            pg8::Gemm g{(const bf16*)(F.ws + WS_PF2), (const bf16*)(F.ws + WS_BTB), 256, 256};
            SchedFB S; S.go.init(256, 1, F.G, (int)blockIdx.x); EpiFB E{(bf16*)(F.ws + WS_MIX)};
            pg8::gemm_phase<EpiFB, SchedFB>(F.lds + RING_OFF, g, S, E);
        } SEAM(P + 3);
        if (IN(P + 4)) { PHASE_BEGIN();
            pg8::Gemm g{(const bf16*)(F.ws + WS_MIX), (const bf16*)(F.ws + WS_WCAT) + (size_t)l * DM * MIXP, MIXP, MIXP};
            SchedNat S; S.go.init(NMT, DM / 256, F.G, (int)blockIdx.x); EpiWout E{xc, xl, MODL, (float*)(F.ws + WS_T)};
            pg8::gemm_phase<EpiWout, SchedNat>(F.lds + RING_OFF, g, S, E);
        } SEAM(P + 4);
        if (IN(P + 5)) { PHASE_BEGIN(); ph_ln_router(F, l); } SEAM(P + 5);
        if (IN(P + 6)) { PHASE_BEGIN();
            moe_setup(F, l, tstart, ecnt);
            pg8::Gemm g{(const bf16*)(F.ws + WS_XN), (const bf16*)(F.ws + WS_WGU), DM, DM};
            SchedMoe<1> S{tstart, ecnt, (const int*)(F.ws + WS_LIST) + (size_t)l * NE * LCAP, F.G, (int)F.vcu}; EpiMoe1 E{(bf16*)(F.ws + WS_ACT)};
            pg8::gemm_phase<EpiMoe1, SchedMoe<1>>(F.lds + RING_OFF, g, S, E);
        } SEAM(P + 6);
        if (IN(P + 7)) { PHASE_BEGIN();
            moe_setup(F, l, tstart, ecnt);
            pg8::Gemm g{(const bf16*)(F.ws + WS_ACT), (const bf16*)(F.ws + WS_WD), DE, DE};
            SchedMoe<2> S{tstart, ecnt, (const int*)(F.ws + WS_LIST) + (size_t)l * NE * LCAP, F.G, (int)F.vcu};
            EpiMoe2 E{ecnt, (const int*)(F.ws + WS_LIST) + (size_t)l * NE * LCAP, (const float*)(F.ws + WS_WTOK) + (size_t)l * 2 * ROWS, (bf16*)(F.ws + WS_YK)};
            pg8::gemm_phase<EpiMoe2, SchedMoe<2>>(F.lds + RING_OFF, g, S, E);
        } SEAM(P + 7);
        if (IN(P + 8)) { PHASE_BEGIN();
            if (l == 0) { ph_ln_final(F, l, (float*)(F.ws + WS_X2), (float*)(F.ws + WS_X2) + (size_t)CTXL * DM);
                          convert_experts(F, 1, (LAS float*)(F.lds + RING_OFF + F.wave * 16384)); }
            else ph_ln_final(F, l, nullptr, F.out);
        }
        if (l + 1 < DEPTH) SEAM(P + 8);
    }
#undef IN
#undef SEAM
}

extern "C" void kernel_launch(void* const* d_in, const int* in_sizes, int n_in, void* d_out, int out_size, void* d_ws, size_t ws_size, hipStream_t stream) {
    static int grid = 0;
    if (grid == 0) {
        if (n_in != NIN || in_sizes[0] != SEQ * DM || out_size != SEQ * DM || ws_size < WS_END) { fprintf(stderr, "kernel_launch: shape mismatch (n_in %d, in0 %d, out %d, ws %zu < %zu?)\n", n_in, n_in > 0 ? in_sizes[0] : -1, out_size, ws_size, (size_t)WS_END); grid = -1; return; }
        int dev = 0, cus = 0, per_cu = 0;
        if (hipGetDevice(&dev) != hipSuccess || hipDeviceGetAttribute(&cus, hipDeviceAttributeMultiprocessorCount, dev) != hipSuccess) { grid = -1; return; }
        if (hipFuncSetAttribute((const void*)mk_fwd, hipFuncAttributeMaxDynamicSharedMemorySize, LDS_BYTES) != hipSuccess) { fprintf(stderr, "kernel_launch: hipFuncSetAttribute failed\n"); grid = -1; return; }
        if (hipOccupancyMaxActiveBlocksPerMultiprocessor(&per_cu, (const void*)mk_fwd, NWAVES * 64, LDS_BYTES) != hipSuccess || per_cu < 1)
            fprintf(stderr, "kernel_launch: note: occupancy query reports %d workgroups per CU\n", per_cu);
        (void)hipGetLastError();
        grid = cus;
        if (grid > 256) grid = 256;
    }
    if (grid < 0) return;
    if (hipMemsetAsync((char*)d_ws + WS_CTL, 0, CTL_ZERO_BYTES, stream) != hipSuccess) { fprintf(stderr, "kernel_launch: memset failed\n"); return; }
    Args a{};
    for (int i = 0; i < NIN; ++i) a.in[i] = (const float*)d_in[i];
    a.out = (float*)d_out; a.ws = (unsigned char*)d_ws;
#if MK_ONE_LAUNCH
    a.ph_lo = 0; a.ph_hi = NPH;
    hipLaunchKernelGGL(mk_fwd, dim3(grid), dim3(NWAVES * 64), LDS_BYTES, stream, a);
#else
    for (int p = 0; p < NPH; ++p) { a.ph_lo = p; a.ph_hi = p + 1; hipLaunchKernelGGL(mk_fwd, dim3(grid), dim3(NWAVES * 64), LDS_BYTES, stream, a); }
#endif
    const hipError_t le = hipPeekAtLastError();
    if (le != hipSuccess) fprintf(stderr, "kernel_launch: launch failed: %s\n", hipGetErrorName(le));
}
```

```cpp
#include <hip/hip_runtime.h>
#include <cstdio>
#include <cstdint>
#include <cmath>
#ifndef MK_ONE_LAUNCH
#define MK_ONE_LAUNCH 1
#endif
namespace pg8 {
#define PG8_LAS __attribute__((address_space(3)))
typedef unsigned short bf16_t;
typedef short bf16x8 __attribute__((ext_vector_type(8)));
typedef float f32x4 __attribute__((ext_vector_type(4)));
typedef float f32x2 __attribute__((ext_vector_type(2)));
typedef unsigned u32x4 __attribute__((ext_vector_type(4)));
typedef unsigned u32x2 __attribute__((ext_vector_type(2)));
constexpr int BM = 256, BK = 64, HALF = 128, HTB = HALF * BK * 2  , STAGE_BYTES = 8 * HTB, NXCD = 8, WGM = 8;

__host__ __device__ __forceinline__ int lds_byte(int r, int c) { const int st = (r >> 4) * 2 + (c >> 5), rr = r & 15, cc = c & 31, ob = rr * 64 + cc * 2; return st * 1024 + (ob ^ (((ob >> 9) & 1) << 5)); }
__host__ __device__ __forceinline__ void stage_rc(int b, int& R, int& C) { const int st = b / 1024, sb = b % 1024, swz = sb ^ (((sb >> 9) & 1) << 5); R = (st >> 1) * 16 + swz / 64; C = (st & 1) * 32 + (swz % 64) / 2; }
__host__ __device__ __forceinline__ int perm32(int rho) { const int n = rho >> 4, i = rho & 15; return 8 * (i >> 2) + 4 * n + (i & 3); }

struct Unit { int pm, pn, e, rt; };
struct Gemm { const bf16_t* A; const bf16_t* Bt; int K, lda; };

struct GridOrder {
    int nM, nN, nwg, G, c;
    __device__ void init(int nM_, int nN_, int G_, int c_) { nM = nM_; nN = nN_; nwg = nM * nN; G = G_; c = c_; }
    __device__ bool next(int i, Unit& u) const {
        const long L = (long)i * G + c; if (L >= nwg) return false;
        int wgid = (int)L; { const int q = nwg / NXCD, r = nwg % NXCD, xcd = wgid % NXCD, off = wgid / NXCD; wgid = (xcd < r ? xcd * (q + 1) : r * (q + 1) + (xcd - r) * q) + off; }
        const int nig = WGM * nN, gid = wgid / nig, fm = gid * WGM, gsz = (nM - fm) < WGM ? (nM - fm) : WGM;
        u.pm = fm + ((wgid % nig) % gsz); u.pn = (wgid % nig) / gsz; u.e = 0; u.rt = 0; return true;
    }
};

__device__ __forceinline__ unsigned cvt_pk_bf16(float lo, float hi) { unsigned r; asm volatile("v_cvt_pk_bf16_f32 %0, %1, %2" : "=v"(r) : "v"(lo), "v"(hi)); return r; }

template <class Epi, class Sched>
__device__ __forceinline__ void gemm_phase(PG8_LAS unsigned char* lds, const Gemm g, const Sched& S, const Epi& E) {
    int tid_ = threadIdx.x; asm volatile("" : "+v"(tid_));
    const int tid = tid_, wid = __builtin_amdgcn_readfirstlane(tid >> 6), lane = tid & 63, wr = wid >> 2, wc = wid & 3, fr = lane & 15, fq = lane >> 4;
    int K_ = g.K; asm volatile("" : "+s"(K_));
    const int K = K_, nt = K / BK;
    unsigned voffB[2];
#pragma unroll
    for (int i = 0; i < 2; ++i) { int R, C; stage_rc(tid * 16 + i * 8192, R, C); const int Rb = Epi::PERM ? ((R & ~31) + perm32(R & 31)) : R;
        voffB[i] = (unsigned)(Rb * K + C) * 2u; }
    const size_t kstep = (size_t)(BK * 2);
    const size_t hstepB = (size_t)HALF * K * 2;
    const unsigned pitchA = (unsigned)g.lda * 2u;
    const unsigned ldsw = (unsigned)wid * 1024u;
    const int aoff = lds_byte(wr * 64 + fr, fq * 8), boff = lds_byte(wc * 32 + fr, fq * 8);
    const char* gA = (const char*)g.A;
#define PG8_SA(b, h) (((b) * 2 + (h)) * HTB)
#define PG8_SB(b, h) ((4 + (b) * 2 + (h)) * HTB)
#define PG8_STAGEB(bufoff, gbase) do { _Pragma("unroll") for (int _i = 0; _i < 2; ++_i) \
        __builtin_amdgcn_global_load_lds((const unsigned*)((const char*)(gbase) + voffB[_i]), (PG8_LAS unsigned*)(lds + (bufoff) + ldsw + _i * 8192), 16, 0, 0); } while (0)
#define PG8_STAGEA(bufoff, koff, vo) do { _Pragma("unroll") for (int _i = 0; _i < 2; ++_i) \
        __builtin_amdgcn_global_load_lds((const unsigned*)(gA + (koff) + (vo)[_i]), (PG8_LAS unsigned*)(lds + (bufoff) + ldsw + _i * 8192), 16, 0, 0); } while (0)
#define PG8_MKA(dst, u) do { _Pragma("unroll") for (int _i = 0; _i < 2; ++_i) { int R_, C_; stage_rc(tid * 16 + _i * 8192, R_, C_); _Pragma("unroll") for (int _h = 0; _h < 2; ++_h) \
        dst[_h][_i] = (unsigned)S.arow(u, _h * HALF + R_) * pitchA + (unsigned)C_ * 2u; } } while (0)
#define PG8_LDA(dst, b, h) do { _Pragma("unroll") for (int m = 0; m < 4; ++m) _Pragma("unroll") for (int k = 0; k < 2; ++k) dst[m][k] = *(const PG8_LAS bf16x8*)(lds + PG8_SA(b, h) + aoff + m * 2048 + k * 1024); } while (0)
#define PG8_LDB(dst, b, h) do { _Pragma("unroll") for (int n = 0; n < 2; ++n) _Pragma("unroll") for (int k = 0; k < 2; ++k) dst[n][k] = *(const PG8_LAS bf16x8*)(lds + PG8_SB(b, h) + boff + n * 2048 + k * 1024); } while (0)
#define PG8_MMA(ai, bj, At, Bt) do { __builtin_amdgcn_s_setprio(1); _Pragma("unroll") for (int m = 0; m < 4; ++m) _Pragma("unroll") for (int n = 0; n < 2; ++n) _Pragma("unroll") for (int k = 0; k < 2; ++k) \
        acc[ai][bj][m][n] = __builtin_amdgcn_mfma_f32_16x16x32_bf16(Bt[n][k], At[m][k], acc[ai][bj][m][n], 0, 0, 0); __builtin_amdgcn_s_setprio(0); } while (0)
#define PG8_WAIT_V(n) asm volatile("s_waitcnt vmcnt(" #n ")" ::: "memory")
#define PG8_WAIT_L(n) asm volatile("s_waitcnt lgkmcnt(" #n ")" ::: "memory")
#define PG8_BAR __builtin_amdgcn_s_barrier()
#define PG8_SCHED __builtin_amdgcn_sched_barrier(0)
    Unit cur, nxt; int ui = 0;
    if (!S.next(0, cur)) return;
    f32x4 acc[2][2][4][2];
#pragma unroll
    for (int a = 0; a < 2; ++a)
#pragma unroll
        for (int b = 0; b < 2; ++b)
#pragma unroll
            for (int m = 0; m < 4; ++m)
#pragma unroll
                for (int n = 0; n < 2; ++n) acc[a][b][m][n] = (f32x4){0.f, 0.f, 0.f, 0.f};
    bf16x8 At[4][2], B0[2][2], B1[2][2];
    unsigned cvA[2][2], nvA[2][2];
    PG8_MKA(cvA, cur);
    const char* cB = (const char*)g.Bt + (size_t)S.brow(cur) * K * 2;
    PG8_STAGEB(PG8_SB(0, 0), cB); PG8_STAGEB(PG8_SB(0, 1), cB + hstepB); PG8_STAGEA(PG8_SA(0, 0), 0, cvA[0]); PG8_STAGEA(PG8_SA(0, 1), 0, cvA[1]);
    if (wr == 1) PG8_BAR;
    PG8_WAIT_V(2); PG8_BAR;
    PG8_STAGEB(PG8_SB(1, 0), cB + kstep); PG8_STAGEA(PG8_SA(1, 0), kstep, cvA[0]); PG8_STAGEB(PG8_SB(1, 1), cB + hstepB + kstep);
    PG8_WAIT_V(6); PG8_BAR;
    for (;;) {
        const bool has_next = S.next(ui + 1, nxt);
        const char* nB = cB;
        if (has_next) { PG8_MKA(nvA, nxt); nB = (const char*)g.Bt + (size_t)S.brow(nxt) * K * 2; }
        else {
#pragma unroll
            for (int h = 0; h < 2; ++h)
#pragma unroll
                for (int i = 0; i < 2; ++i) nvA[h][i] = cvA[h][i]; }
        for (int t = 0; t < nt; t += 2) {
            const bool last = (t == nt - 2);
            const size_t ka1 = (size_t)(t + 1) * kstep;
            const size_t ka2 = last ? (size_t)0 : (size_t)(t + 2) * kstep; const char* b2 = last ? nB : cB + (size_t)(t + 2) * kstep;
            const size_t ka3 = ka2 + kstep; const char* b3 = b2 + kstep;
            unsigned a2v[2][2];
#pragma unroll
            for (int h = 0; h < 2; ++h)
#pragma unroll
                for (int i = 0; i < 2; ++i) a2v[h][i] = last ? nvA[h][i] : cvA[h][i];
            PG8_LDB(B0, 0, 0); PG8_LDB(B1, 0, 1); PG8_SCHED; PG8_LDA(At, 0, 0); PG8_STAGEA(PG8_SA(1, 1), ka1, cvA[1]);
            PG8_WAIT_V(8); PG8_WAIT_L(0); PG8_BAR; PG8_MMA(0, 0, At, B0); PG8_MMA(0, 1, At, B1); PG8_BAR; PG8_SCHED;
            PG8_LDA(At, 0, 1); PG8_STAGEB(PG8_SB(0, 0), b2); PG8_STAGEB(PG8_SB(0, 1), b2 + hstepB); PG8_STAGEA(PG8_SA(0, 0), ka2, a2v[0]);
            PG8_WAIT_V(8); PG8_WAIT_L(0); PG8_BAR; PG8_MMA(1, 0, At, B0); PG8_MMA(1, 1, At, B1); PG8_BAR; PG8_SCHED;
            PG8_LDB(B0, 1, 0); PG8_LDB(B1, 1, 1); PG8_SCHED; PG8_LDA(At, 1, 0); PG8_STAGEA(PG8_SA(0, 1), ka2, a2v[1]);
            PG8_WAIT_V(8); PG8_WAIT_L(0); PG8_BAR; PG8_MMA(0, 0, At, B0); PG8_MMA(0, 1, At, B1); PG8_BAR; PG8_SCHED;
            PG8_LDA(At, 1, 1); PG8_STAGEB(PG8_SB(1, 0), b3); PG8_STAGEB(PG8_SB(1, 1), b3 + hstepB); PG8_STAGEA(PG8_SA(1, 0), ka3, a2v[0]);
            PG8_WAIT_V(8); PG8_WAIT_L(0); PG8_BAR; PG8_MMA(1, 0, At, B0); PG8_MMA(1, 1, At, B1); PG8_BAR; PG8_SCHED;
        }
        if (wr == 0) PG8_BAR;
        { int fr_ = fr, fq_ = fq, wr_ = wr, wc_ = wc; asm volatile("" : "+v"(fr_), "+v"(fq_), "+s"(wr_), "+s"(wc_));
          E(acc, cur, wr_, wc_, fr_, fq_); }
        if (!has_next) break;
#pragma unroll
        for (int a = 0; a < 2; ++a)
#pragma unroll
            for (int b = 0; b < 2; ++b)
#pragma unroll
                for (int m = 0; m < 4; ++m)
#pragma unroll
                    for (int n = 0; n < 2; ++n) acc[a][b][m][n] = (f32x4){0.f, 0.f, 0.f, 0.f};
        cur = nxt; cB = nB; ++ui;
#pragma unroll
        for (int h = 0; h < 2; ++h)
#pragma unroll
            for (int i = 0; i < 2; ++i) cvA[h][i] = nvA[h][i];
        if (wr == 1) PG8_BAR;
    }
    PG8_WAIT_V(0);
    PG8_BAR;
#undef PG8_SA
#undef PG8_SB
#undef PG8_STAGEA
#undef PG8_STAGEB
#undef PG8_MKA
#undef PG8_LDA
#undef PG8_LDB
#undef PG8_MMA
#undef PG8_WAIT_V
#undef PG8_WAIT_L
#undef PG8_BAR
#undef PG8_SCHED
}
}
#ifndef ATT_D
#define ATT_D 4
#endif
#ifndef ATT_STAGGER
#define ATT_NOSTAGGER 1
#endif
#if ATT_D == 2
#define A_INFLIGHT 3
#elif ATT_D == 3
#define A_INFLIGHT 6
#elif ATT_D == 4
#ifdef ATT_LDR4
#define A_INFLIGHT 18
#else
#define A_INFLIGHT 9
#endif
#else
#error ATT_D
#endif
#define A_GAS __attribute__((address_space(1)))
#ifdef TPROBE
__device__ float g_tprobe;
#ifndef TP_WAVE
#define TP_WAVE 0
#endif
#ifndef TP_Q
#define TP_Q 50.f
#endif
#ifndef TP_OFF
#define TP_OFF 0.f
#endif
#ifndef TP_SCALE
#define TP_SCALE 1e-4f
#endif
#endif
namespace attn {
using bf16x8 = __attribute__((ext_vector_type(8))) short;
using s16x4  = __attribute__((ext_vector_type(4))) short;
using f32x16 = __attribute__((ext_vector_type(16))) float;
using u32x4  = __attribute__((ext_vector_type(4))) unsigned;
using f32x4v = __attribute__((ext_vector_type(4))) float;
typedef unsigned short bf16_t;
constexpr int NW = 8, QBLK = 32, KVBLK = 64, PITCH = 1024;
#ifndef ATT_D
#define ATT_D 4
#endif
constexpr int ADEPTH = ATT_D;
constexpr int NSLOT = ADEPTH + 1, KSLOT = 8192, VSLOT = 16384;
constexpr int LDS_K = 0, LDS_V = NSLOT * KSLOT, LDS_WS = LDS_V + NSLOT * VSLOT, SHM_ATTN = LDS_WS + NW * 64 * 4;
__device__ __forceinline__ int crow(int r, int hi) { return (r & 3) + 8 * (r >> 2) + 4 * hi; }
__device__ __forceinline__ unsigned cvtpk(float lo, float hi) { unsigned r; asm volatile("v_cvt_pk_bf16_f32 %0, %1, %2" : "=v"(r) : "v"(lo), "v"(hi)); return r; }
typedef float f32x2_t __attribute__((ext_vector_type(2))); typedef __bf16 bf16x2_t __attribute__((ext_vector_type(2)));
__device__ __forceinline__ unsigned cvtpk_b(float lo, float hi) { f32x2_t v = {lo, hi}; bf16x2_t b = __builtin_convertvector(v, bf16x2_t); return __builtin_bit_cast(unsigned, b); }
__device__ __forceinline__ void glds16(const void* gsrc, unsigned lds_dst) { unsigned keep;
  asm volatile("s_mov_b32 %0, m0\n\ts_mov_b32 m0, %2\n\ts_nop 0\n\tglobal_load_lds_dwordx4 %1, off\n\ts_mov_b32 m0, %0" : "=&s"(keep) : "v"(gsrc), "s"(lds_dst) : "memory"); }
typedef __attribute__((address_space(3))) const char* lds_cptr;
typedef short v4i16_t __attribute__((ext_vector_type(4)));
__device__ __forceinline__ s16x4 vtr(lds_cptr p) { return __builtin_bit_cast(s16x4, __builtin_amdgcn_ds_read_tr16_b64_v4i16((__attribute__((address_space(3))) v4i16_t*)p)); }
#define A_WAITBAR_(V) asm volatile("s_waitcnt vmcnt(" #V ") lgkmcnt(0)\n\ts_barrier" ::: "memory")
#define A_WAITBAR(V) A_WAITBAR_(V)
#define A_LGKBAR() asm volatile("s_waitcnt lgkmcnt(0)\n\ts_barrier" ::: "memory")
#define A_SBAR() __builtin_amdgcn_sched_barrier(0)

template <int THRL, bool ROTL>
__device__ __forceinline__ void attn_pass(const bf16_t* __restrict__ Qb, const bf16_t* __restrict__ Kh, const bf16_t* __restrict__ Vh, int NT, char* shm, f32x16 (&o)[4], float& l_out) {
  int tid_ = threadIdx.x; asm volatile("" : "+v"(tid_));
  const int tid = tid_, lane = tid & 63, r32 = lane & 31, hi = lane >> 5; const int wid = __builtin_amdgcn_readfirstlane(tid >> 6);
#ifdef ATT_NOSTAGGER
  const int half = 0;
#else
#ifdef ATT_PARITY
  const int half = wid & 1;
#else
  const int half = wid >> 2;
#endif
#endif
  const unsigned lds0 = (unsigned)(uintptr_t)shm;
  float* wsf = (float*)(shm + LDS_WS) + wid * 64;
  const bf16_t* ksrc = Kh + wid * 512 + lane * 8;
  const bf16_t* vsrc = Vh + wid * 512 + lane * 8;
  const unsigned kdst = lds0 + LDS_K + wid * 1024, vdst = lds0 + LDS_V + wid * 1024;
#ifdef ATT_LDR4
#define A_RFL(x) (unsigned)__builtin_amdgcn_readfirstlane(x)
#define DMA_K(t, s) do { if (wid < 4) { glds16(ksrc + (long)(t) * 4096, A_RFL(kdst + (s) * KSLOT)); glds16(ksrc + (long)(t) * 4096 + 2048, A_RFL(kdst + (s) * KSLOT + 4096)); } } while (0)
#define DMA_VA(t, s) do { if (wid < 4) { glds16(vsrc + (long)(t) * 8192, A_RFL(vdst + (s) * VSLOT)); glds16(vsrc + (long)(t) * 8192 + 2048, A_RFL(vdst + (s) * VSLOT + 4096)); } } while (0)
#define DMA_VB(t, s) do { if (wid < 4) { glds16(vsrc + (long)(t) * 8192 + 4096, A_RFL(vdst + (s) * VSLOT + 8192)); glds16(vsrc + (long)(t) * 8192 + 6144, A_RFL(vdst + (s) * VSLOT + 12288)); } } while (0)
#else
#define DMA_K(t, s) glds16(ksrc + (long)(t) * 4096, (unsigned)__builtin_amdgcn_readfirstlane(kdst + (s) * KSLOT))
#define DMA_VA(t, s) glds16(vsrc + (long)(t) * 8192, (unsigned)__builtin_amdgcn_readfirstlane(vdst + (s) * VSLOT))
#define DMA_VB(t, s) glds16(vsrc + (long)(t) * 8192 + 4096, (unsigned)__builtin_amdgcn_readfirstlane(vdst + (s) * VSLOT + 8192))
#endif
#define DMA_V(t, s) do { DMA_VA(t, s); DMA_VB(t, s); } while (0)
  bf16x8 qr[4];
  { const bf16_t* Qw = Qb + (long)(wid * QBLK + r32) * PITCH + hi * 8;
#pragma unroll
    for (int d0 = 0; d0 < 4; ++d0) qr[d0] = *(const A_GAS bf16x8*)(Qw + d0 * 16); }
  DMA_K(0, 0);
#pragma unroll
  for (int g = 1; g < ADEPTH; ++g) { DMA_K(g, g); DMA_V(g - 1, g - 1); }
  float mhat = 0.f, l_reg = 0.f;
#pragma unroll
  for (int d = 0; d < 4; ++d) o[d] = f32x16{};
  f32x16 negm = f32x16{}; asm volatile("" : "+v"(negm));
  f32x16 S0, S1; u32x4 pw0, pw1, pw2, pw3;

  pw0 = pw1 = pw2 = pw3 = (u32x4){0u, 0u, 0u, 0u};
  A_WAITBAR(A_INFLIGHT);
  if (half == 1) A_LGKBAR();
  const unsigned kaddr0 = lds0 + LDS_K + hi * 1024 + r32 * 16;
  const unsigned vaddr0 = lds0 + LDS_V + ((lane >> 4) & 1) * 32 + (lane & 3) * 8 + (4 * hi + ((lane & 15) >> 2)) * 64;
#define A_KRD(dst, addr, off) asm volatile("ds_read_b128 %0, %1 offset:%2" : "=&v"(dst) : "v"(addr), "i"(off) : "memory")
#define A_VRD(dst, addr, off) asm volatile("ds_read_b64_tr_b16 %0, %1 offset:%2" : "=&v"(dst) : "v"(addr), "i"(off) : "memory")
#define A_VRD8(b, addr, d0) do { A_VRD(vl[b][0], addr, (d0) * 4096); A_VRD(vh[b][0], addr, (d0) * 4096 + 512); A_VRD(vl[b][1], addr, (d0) * 4096 + 1024); A_VRD(vh[b][1], addr, (d0) * 4096 + 1536); \
                                  A_VRD(vl[b][2], addr, (d0) * 4096 + 2048); A_VRD(vh[b][2], addr, (d0) * 4096 + 2560); A_VRD(vl[b][3], addr, (d0) * 4096 + 3072); A_VRD(vh[b][3], addr, (d0) * 4096 + 3584); } while (0)
#define A_LWAIT(n) do { asm volatile("s_waitcnt lgkmcnt(" #n ")" ::: "memory"); A_SBAR(); } while (0)
#define A_VFR(b, k) (bf16x8){vl[b][k][0], vl[b][k][1], vl[b][k][2], vl[b][k][3], vh[b][k][0], vh[b][k][1], vh[b][k][2], vh[b][k][3]}
#define A_PV4(od, b) do { od = __builtin_amdgcn_mfma_f32_32x32x16_bf16(__builtin_bit_cast(bf16x8, pw0), A_VFR(b, 0), od, 0, 0, 0); od = __builtin_amdgcn_mfma_f32_32x32x16_bf16(__builtin_bit_cast(bf16x8, pw1), A_VFR(b, 1), od, 0, 0, 0); \
                          od = __builtin_amdgcn_mfma_f32_32x32x16_bf16(__builtin_bit_cast(bf16x8, pw2), A_VFR(b, 2), od, 0, 0, 0); od = __builtin_amdgcn_mfma_f32_32x32x16_bf16(__builtin_bit_cast(bf16x8, pw3), A_VFR(b, 3), od, 0, 0, 0); } while (0)
#define A_QK8() do { S0 = __builtin_amdgcn_mfma_f32_32x32x16_bf16(kf[0], qr[0], negm, 0, 0, 0); S1 = __builtin_amdgcn_mfma_f32_32x32x16_bf16(kf[1], qr[0], negm, 0, 0, 0); \
    _Pragma("unroll") for (int d0 = 1; d0 < 4; ++d0) { S0 = __builtin_amdgcn_mfma_f32_32x32x16_bf16(kf[2 * d0], qr[d0], S0, 0, 0, 0); S1 = __builtin_amdgcn_mfma_f32_32x32x16_bf16(kf[2 * d0 + 1], qr[d0], S1, 0, 0, 0); } } while (0)
#define A_KRD8(addr) do { _Pragma("unroll") for (int d0 = 0; d0 < 4; ++d0) { A_KRD(kf[2 * d0], addr, d0 * 2048); A_KRD(kf[2 * d0 + 1], addr, d0 * 2048 + 512); } } while (0)
  const unsigned wsa = lds0 + LDS_WS + wid * 256 + hi * 16;
#define A_RESCALE_O() do { asm volatile("s_waitcnt lgkmcnt(0)" ::: "memory"); \
    _Pragma("unroll") for (int r4 = 0; r4 < 4; ++r4) { f32x4v w4_; asm volatile("ds_read_b128 %0, %1 offset:%2\n\ts_waitcnt lgkmcnt(0)" : "=&v"(w4_) : "v"(wsa), "i"(r4 * 32) : "memory"); \
      _Pragma("unroll") for (int d = 0; d < 4; ++d) _Pragma("unroll") for (int q = 0; q < 4; ++q) o[d][4 * r4 + q] *= w4_[q]; } } while (0)
#ifdef ATT_NOSTAGGER
#define A_END_M() do { } while (0)
#else
#define A_END_M() do { if (half == 1) { if (i + ADEPTH < NT) A_WAITBAR(A_INFLIGHT); else A_WAITBAR(0); } else A_LGKBAR(); } while (0)
#endif
#define A_MBLOCK(QK, PV) do { bf16x8 kf[8]; s16x4 vl[2][4], vh[2][4]; const unsigned ka = kaddr0 + s * KSLOT, va = vaddr0 + sK * VSLOT; \
    if (i + ADEPTH < NT) DMA_K(i + ADEPTH, sK); if (i + ADEPTH - 1 < NT) DMA_V(i + ADEPTH - 1, sV); \
    if (QK) A_KRD8(ka); \
    if (PV) A_VRD8(0, va, 0); \
    if (QK) { if (PV) A_LWAIT(8); else A_LWAIT(0); A_QK8(); A_SBAR(); } \
    if (PV) { A_VRD8(1, va, 1); A_LWAIT(8); A_PV4(o[0], 0); A_SBAR(); A_VRD8(0, va, 2); A_LWAIT(8); A_PV4(o[1], 1); A_SBAR(); A_VRD8(1, va, 3); A_LWAIT(8); A_PV4(o[2], 0); A_SBAR(); A_LWAIT(0); A_PV4(o[3], 1); } \
    A_END_M(); } while (0)
#define A_VBLOCK(FIRST) do { \
      float a = fmaxf(fmaxf(S0[0], S0[1]), S1[0]), b = fmaxf(fmaxf(S0[2], S0[3]), S1[1]); a = fmaxf(fmaxf(a, S1[2]), S1[3]); \
      _Pragma("unroll") for (int r = 4; r < 16; r += 4) { a = fmaxf(fmaxf(a, S0[r]), S0[r + 1]); b = fmaxf(fmaxf(b, S0[r + 2]), S0[r + 3]); a = fmaxf(fmaxf(a, S1[r]), S1[r + 1]); b = fmaxf(fmaxf(b, S1[r + 2]), S1[r + 3]); } \
      float rm = fmaxf(a, b); \
      { auto rr = __builtin_amdgcn_permlane32_swap(__float_as_uint(rm), __float_as_uint(rm), false, false); rm = fmaxf(__uint_as_float(rr[0]), __uint_as_float(rr[1])); } \
      bool resc = false; \
      if (FIRST || __builtin_expect(__any(rm > (float)THRL), 0)) { \
        const float dl = FIRST ? rm : fmaxf(rm, 0.f); mhat += dl; \
        _Pragma("unroll") for (int r = 0; r < 16; ++r) { S0[r] -= dl; S1[r] -= dl; } \
        _Pragma("unroll") for (int r = 0; r < 16; ++r) negm[r] = -mhat; \
        asm volatile("" : "+v"(negm)); \
        const float f = __builtin_amdgcn_exp2f(-dl); l_reg *= f; if (hi == 0) wsf[r32] = f; resc = !(FIRST); } \
      _Pragma("unroll") for (int r = 0; r < 16; ++r) { S0[r] = __builtin_amdgcn_exp2f(S0[r]); S1[r] = __builtin_amdgcn_exp2f(S1[r]); } \
      float sa = (S0[0] + S0[1]) + (S0[2] + S0[3]), sb = (S1[0] + S1[1]) + (S1[2] + S1[3]); \
      _Pragma("unroll") for (int r = 4; r < 16; r += 4) { sa += (S0[r] + S0[r + 1]) + (S0[r + 2] + S0[r + 3]); sb += (S1[r] + S1[r + 1]) + (S1[r + 2] + S1[r + 3]); } \
      l_reg += sa + sb; \
      pw0 = (u32x4){cvtpk(S0[0], S0[1]), cvtpk(S0[2], S0[3]), cvtpk(S0[4], S0[5]), cvtpk(S0[6], S0[7])}; \
      pw1 = (u32x4){cvtpk(S0[8], S0[9]), cvtpk(S0[10], S0[11]), cvtpk(S0[12], S0[13]), cvtpk(S0[14], S0[15])}; \
      pw2 = (u32x4){cvtpk(S1[0], S1[1]), cvtpk(S1[2], S1[3]), cvtpk(S1[4], S1[5]), cvtpk(S1[6], S1[7])}; \
      pw3 = (u32x4){cvtpk(S1[8], S1[9]), cvtpk(S1[10], S1[11]), cvtpk(S1[12], S1[13]), cvtpk(S1[14], S1[15])}; \
      if (resc) A_RESCALE_O(); \
      if (half == 0) { if (i + ADEPTH < NT) A_WAITBAR(A_INFLIGHT); else A_WAITBAR(0); } else A_LGKBAR(); } while (0)
#ifdef ATT_TRIG1
#define A_TRIG 1.0f
#else
#define A_TRIG (float)(1 << THRL)
#endif
#if defined(TPROBE)
#define A_TP_NOW() __builtin_readcyclecounter()
#define A_TP_DECL() unsigned long long tq0_ = 0, tq1_ = 0
#else
#define A_TP_DECL() do { } while (0)
#endif
#if defined(TPROBE) && TPROBE == 2
#define A_TP_TOP() do { } while (0)
#define A_TP_M8() do { } while (0)
#define A_TP_PRE() tq0_ = A_TP_NOW()
#define A_TP_POST() do { tq1_ = A_TP_NOW(); tpa_ += tq1_ - tq0_; } while (0)
#elif defined(TPROBE) && TPROBE == 3
#define A_TP_TOP() tq0_ = A_TP_NOW()
#define A_TP_M8() tq1_ = A_TP_NOW()
#define A_TP_PRE() do { } while (0)
#define A_TP_POST() tpa_ += tq1_ - tq0_
#elif defined(TPROBE) && TPROBE == 4
#define A_TP_TOP() do { } while (0)
#define A_TP_M8() tq0_ = A_TP_NOW()
#define A_TP_PRE() tq1_ = A_TP_NOW()
#define A_TP_POST() tpa_ += tq1_ - tq0_
#else
#define A_TP_TOP() do { } while (0)
#define A_TP_M8() do { } while (0)
#define A_TP_PRE() do { } while (0)
#define A_TP_POST() do { } while (0)
#endif
#if defined(TPROBE) && TPROBE == 2
#define A_TPB_PRE() const unsigned long long tb0_ = __builtin_readcyclecounter()
#define A_TPB_POST() do { const unsigned long long tb1_ = __builtin_readcyclecounter(); tpa_ += tb1_ - tb0_; } while (0)
#else
#define A_TPB_PRE() do { } while (0)
#define A_TPB_POST() do { } while (0)
#endif
#define A_SX(j) ((j) < 16 ? S0[(j) & 15] : S1[(j) & 15])
#define A_GAP(od, ks, b, w) do { od = __builtin_amdgcn_mfma_f32_32x32x16_bf16(__builtin_bit_cast(bf16x8, pw##ks), A_VFR(b, ks), od, 0, 0, 0); \
    { const float s0_ = A_SX(2 * (w)), s1_ = A_SX(2 * (w) + 1); \
      const float e0_ = __builtin_amdgcn_exp2f(s0_), e1_ = __builtin_amdgcn_exp2f(s1_); sa += e0_; sb += e1_; unsigned w_ = cvtpk_b(e0_, e1_); asm volatile("" : "+v"(w_), "+v"(sa), "+v"(sb)); pwn[(w) >> 2][(w) & 3] = w_; } A_SBAR(); } while (0)
#define A_PV4I(od, b, w0) do { A_GAP(od, 0, b, (w0)); A_GAP(od, 1, b, (w0) + 1); A_GAP(od, 2, b, (w0) + 2); A_GAP(od, 3, b, (w0) + 3); } while (0)
#define A_KRD8S() do { A_KRD(kf[0], ka, 0); A_KRD(kf[2], ka, 2048); A_KRD(kf[4], ka, 4096); A_KRD(kf[6], ka, 6144); } while (0)
#define A_KRD4B() do { A_KRD(kf[1], ka, 512); A_KRD(kf[3], ka, 2560); A_KRD(kf[5], ka, 4608); A_KRD(kf[7], ka, 6656); } while (0)
#define A_HEAD() do { __builtin_amdgcn_s_setprio(3); A_SBAR(); A_KRD8S(); } while (0)
#define A_TAIL(REISSUE) do { o[3] = __builtin_amdgcn_mfma_f32_32x32x16_bf16(__builtin_bit_cast(bf16x8, pw0), A_VFR(1, 0), o[3], 0, 0, 0); { sa += e22_; sb += e23_; unsigned w11_ = cvtpk_b(e22_, e23_); e26_ = __builtin_amdgcn_exp2f(S1[10]); e27_ = __builtin_amdgcn_exp2f(S1[11]); asm volatile("" : "+v"(sa), "+v"(sb), "+v"(w11_), "+v"(e26_), "+v"(e27_)); pwn[2][3] = w11_; } A_SBAR(); o[3] = __builtin_amdgcn_mfma_f32_32x32x16_bf16(__builtin_bit_cast(bf16x8, pw1), A_VFR(1, 1), o[3], 0, 0, 0); { sa += e24_; sb += e25_; unsigned w12_ = cvtpk_b(e24_, e25_); e28_ = __builtin_amdgcn_exp2f(S1[12]); e29_ = __builtin_amdgcn_exp2f(S1[13]); asm volatile("" : "+v"(sa), "+v"(sb), "+v"(w12_), "+v"(e28_), "+v"(e29_)); pwn[3][0] = w12_; } A_SBAR(); o[3] = __builtin_amdgcn_mfma_f32_32x32x16_bf16(__builtin_bit_cast(bf16x8, pw2), A_VFR(1, 2), o[3], 0, 0, 0); { sa += e26_; sb += e27_; unsigned w13_ = cvtpk_b(e26_, e27_); e30_ = __builtin_amdgcn_exp2f(S1[14]); e31_ = __builtin_amdgcn_exp2f(S1[15]); asm volatile("" : "+v"(sa), "+v"(sb), "+v"(w13_), "+v"(e30_), "+v"(e31_)); pwn[3][1] = w13_; } A_SBAR(); o[3] = __builtin_amdgcn_mfma_f32_32x32x16_bf16(__builtin_bit_cast(bf16x8, pw3), A_VFR(1, 3), o[3], 0, 0, 0); { sa += e28_; sb += e29_; unsigned w14_ = cvtpk_b(e28_, e29_); sa += e30_; sb += e31_; unsigned w15_ = cvtpk_b(e30_, e31_); asm volatile("" : "+v"(sa), "+v"(sb), "+v"(w14_), "+v"(w15_)); pwn[3][2] = w14_; pwn[3][3] = w15_; } A_SBAR(); \
      \
    float rm = sa + sb;                                     \
    { auto rr = __builtin_amdgcn_permlane32_swap(__float_as_uint(rm), __float_as_uint(rm), false, false); rm = __uint_as_float(rr[0]) + __uint_as_float(rr[1]); } \
    if (__builtin_expect(__any(rm > A_TRIG), 0)) { asm volatile("s_waitcnt lgkmcnt(0)" ::: "memory");     \
      const float dl = fmaxf(__builtin_amdgcn_logf(rm), 0.f); mhat += dl; \
      _Pragma("unroll") for (int r = 0; r < 16; ++r) negm[r] = -mhat; \
      asm volatile("" : "+v"(negm)); \
      const float f = __builtin_amdgcn_exp2f(-dl); l_reg *= f; sa *= f; sb *= f; \
      _Pragma("unroll") for (int q = 0; q < 4; ++q) _Pragma("unroll") for (int c = 0; c < 4; ++c) { const unsigned w_ = pwn[q][c]; pwn[q][c] = cvtpk_b(__uint_as_float(w_ << 16) * f, __uint_as_float(w_ & 0xffff0000u) * f); } \
      if (hi == 0) wsf[r32] = f; A_RESCALE_O(); REISSUE; } \
    l_reg += sa + sb; pw0 = pwn[0]; pw1 = pwn[1]; pw2 = pwn[2]; pw3 = pwn[3]; \
    sa = 0.f; sb = 0.f; } while (0)
#define A_BODY() do { A_KRD4B(); \
    A_LWAIT(7); S0 = __builtin_amdgcn_mfma_f32_32x32x16_bf16(kf[0], qr[0], negm, 0, 0, 0); A_SBAR(); if (i + ADEPTH < NT) DMA_K(i + ADEPTH, sK); A_SBAR(); \
    A_LWAIT(6); S0 = __builtin_amdgcn_mfma_f32_32x32x16_bf16(kf[2], qr[1], S0, 0, 0, 0); A_SBAR(); \
    A_LWAIT(5); S0 = __builtin_amdgcn_mfma_f32_32x32x16_bf16(kf[4], qr[2], S0, 0, 0, 0); A_SBAR(); if (i + ADEPTH - 1 < NT) DMA_VA(i + ADEPTH - 1, sV); A_SBAR(); \
    A_LWAIT(4); S0 = __builtin_amdgcn_mfma_f32_32x32x16_bf16(kf[6], qr[3], S0, 0, 0, 0); A_SBAR(); A_VRD8(0, va, 0); \
    A_LWAIT(11); S1 = __builtin_amdgcn_mfma_f32_32x32x16_bf16(kf[1], qr[0], negm, 0, 0, 0); A_SBAR(); if (i + ADEPTH - 1 < NT) DMA_VB(i + ADEPTH - 1, sV); A_SBAR(); __builtin_amdgcn_s_setprio(2); A_SBAR(); \
    A_LWAIT(10); S1 = __builtin_amdgcn_mfma_f32_32x32x16_bf16(kf[3], qr[1], S1, 0, 0, 0); A_SBAR(); { e0_ = __builtin_amdgcn_exp2f(S0[0]); e1_ = __builtin_amdgcn_exp2f(S0[1]); e2_ = __builtin_amdgcn_exp2f(S0[2]); asm volatile("" : "+v"(e0_), "+v"(e1_), "+v"(e2_)); } A_SBAR(); \
    A_LWAIT(9); S1 = __builtin_amdgcn_mfma_f32_32x32x16_bf16(kf[5], qr[2], S1, 0, 0, 0); A_SBAR(); { e3_ = __builtin_amdgcn_exp2f(S0[3]); sa += e0_; sb += e1_; unsigned w0_ = cvtpk_b(e0_, e1_); asm volatile("" : "+v"(e3_), "+v"(sa), "+v"(sb), "+v"(w0_)); pwn[0][0] = w0_; } A_SBAR(); \
    A_LWAIT(8); S1 = __builtin_amdgcn_mfma_f32_32x32x16_bf16(kf[7], qr[3], S1, 0, 0, 0); A_SBAR(); { e4_ = __builtin_amdgcn_exp2f(S0[4]); e5_ = __builtin_amdgcn_exp2f(S0[5]); sa += e2_; sb += e3_; asm volatile("" : "+v"(e4_), "+v"(e5_), "+v"(sa), "+v"(sb)); } A_SBAR(); \
    A_VRD8(1, va, 1); A_LWAIT(8); o[0] = __builtin_amdgcn_mfma_f32_32x32x16_bf16(__builtin_bit_cast(bf16x8, pw0), A_VFR(0, 0), o[0], 0, 0, 0); { unsigned w1_ = cvtpk_b(e2_, e3_); e6_ = __builtin_amdgcn_exp2f(S0[6]); e7_ = __builtin_amdgcn_exp2f(S0[7]); sa += e4_; asm volatile("" : "+v"(w1_), "+v"(e6_), "+v"(e7_), "+v"(sa)); pwn[0][1] = w1_; } A_SBAR(); o[0] = __builtin_amdgcn_mfma_f32_32x32x16_bf16(__builtin_bit_cast(bf16x8, pw1), A_VFR(0, 1), o[0], 0, 0, 0); { sb += e5_; unsigned w2_ = cvtpk_b(e4_, e5_); e8_ = __builtin_amdgcn_exp2f(S0[8]); e9_ = __builtin_amdgcn_exp2f(S0[9]); asm volatile("" : "+v"(sb), "+v"(w2_), "+v"(e8_), "+v"(e9_)); pwn[0][2] = w2_; } A_SBAR(); o[0] = __builtin_amdgcn_mfma_f32_32x32x16_bf16(__builtin_bit_cast(bf16x8, pw2), A_VFR(0, 2), o[0], 0, 0, 0); { sa += e6_; sb += e7_; unsigned w3_ = cvtpk_b(e6_, e7_); e10_ = __builtin_amdgcn_exp2f(S0[10]); asm volatile("" : "+v"(sa), "+v"(sb), "+v"(w3_), "+v"(e10_)); pwn[0][3] = w3_; } A_SBAR(); o[0] = __builtin_amdgcn_mfma_f32_32x32x16_bf16(__builtin_bit_cast(bf16x8, pw3), A_VFR(0, 3), o[0], 0, 0, 0); { e11_ = __builtin_amdgcn_exp2f(S0[11]); sa += e8_; sb += e9_; unsigned w4_ = cvtpk_b(e8_, e9_); asm volatile("" : "+v"(e11_), "+v"(sa), "+v"(sb), "+v"(w4_)); pwn[1][0] = w4_; } A_SBAR(); __builtin_amdgcn_s_setprio(1); A_SBAR(); \
    A_VRD8(0, va, 2); A_LWAIT(8); o[1] = __builtin_amdgcn_mfma_f32_32x32x16_bf16(__builtin_bit_cast(bf16x8, pw0), A_VFR(1, 0), o[1], 0, 0, 0); { e12_ = __builtin_amdgcn_exp2f(S0[12]); e13_ = __builtin_amdgcn_exp2f(S0[13]); sa += e10_; sb += e11_; asm volatile("" : "+v"(e12_), "+v"(e13_), "+v"(sa), "+v"(sb)); } A_SBAR(); o[1] = __builtin_amdgcn_mfma_f32_32x32x16_bf16(__builtin_bit_cast(bf16x8, pw1), A_VFR(1, 1), o[1], 0, 0, 0); { unsigned w5_ = cvtpk_b(e10_, e11_); e14_ = __builtin_amdgcn_exp2f(S0[14]); e15_ = __builtin_amdgcn_exp2f(S0[15]); sa += e12_; asm volatile("" : "+v"(w5_), "+v"(e14_), "+v"(e15_), "+v"(sa)); pwn[1][1] = w5_; } A_SBAR(); o[1] = __builtin_amdgcn_mfma_f32_32x32x16_bf16(__builtin_bit_cast(bf16x8, pw2), A_VFR(1, 2), o[1], 0, 0, 0); { sb += e13_; unsigned w6_ = cvtpk_b(e12_, e13_); e16_ = __builtin_amdgcn_exp2f(S1[0]); e17_ = __builtin_amdgcn_exp2f(S1[1]); asm volatile("" : "+v"(sb), "+v"(w6_), "+v"(e16_), "+v"(e17_)); pwn[1][2] = w6_; } A_SBAR(); o[1] = __builtin_amdgcn_mfma_f32_32x32x16_bf16(__builtin_bit_cast(bf16x8, pw3), A_VFR(1, 3), o[1], 0, 0, 0); { sa += e14_; sb += e15_; unsigned w7_ = cvtpk_b(e14_, e15_); e18_ = __builtin_amdgcn_exp2f(S1[2]); asm volatile("" : "+v"(sa), "+v"(sb), "+v"(w7_), "+v"(e18_)); pwn[1][3] = w7_; } A_SBAR(); \
    A_VRD8(1, va, 3); A_LWAIT(8); o[2] = __builtin_amdgcn_mfma_f32_32x32x16_bf16(__builtin_bit_cast(bf16x8, pw0), A_VFR(0, 0), o[2], 0, 0, 0); { e19_ = __builtin_amdgcn_exp2f(S1[3]); sa += e16_; sb += e17_; unsigned w8_ = cvtpk_b(e16_, e17_); asm volatile("" : "+v"(e19_), "+v"(sa), "+v"(sb), "+v"(w8_)); pwn[2][0] = w8_; } A_SBAR(); __builtin_amdgcn_s_setprio(0); A_SBAR(); o[2] = __builtin_amdgcn_mfma_f32_32x32x16_bf16(__builtin_bit_cast(bf16x8, pw1), A_VFR(0, 1), o[2], 0, 0, 0); { e20_ = __builtin_amdgcn_exp2f(S1[4]); e21_ = __builtin_amdgcn_exp2f(S1[5]); sa += e18_; sb += e19_; asm volatile("" : "+v"(e20_), "+v"(e21_), "+v"(sa), "+v"(sb)); } A_SBAR(); o[2] = __builtin_amdgcn_mfma_f32_32x32x16_bf16(__builtin_bit_cast(bf16x8, pw2), A_VFR(0, 2), o[2], 0, 0, 0); { unsigned w9_ = cvtpk_b(e18_, e19_); e22_ = __builtin_amdgcn_exp2f(S1[6]); e23_ = __builtin_amdgcn_exp2f(S1[7]); sa += e20_; asm volatile("" : "+v"(w9_), "+v"(e22_), "+v"(e23_), "+v"(sa)); pwn[2][1] = w9_; } A_SBAR(); o[2] = __builtin_amdgcn_mfma_f32_32x32x16_bf16(__builtin_bit_cast(bf16x8, pw3), A_VFR(0, 3), o[2], 0, 0, 0); { sb += e21_; unsigned w10_ = cvtpk_b(e20_, e21_); e24_ = __builtin_amdgcn_exp2f(S1[8]); e25_ = __builtin_amdgcn_exp2f(S1[9]); asm volatile("" : "+v"(sb), "+v"(w10_), "+v"(e24_), "+v"(e25_)); pwn[2][2] = w10_; } A_SBAR(); \
    A_TPB_PRE(); if (i + ADEPTH < NT) A_WAITBAR(A_INFLIGHT); else A_WAITBAR(0); A_TPB_POST(); } while (0)
#define A_ITER1() do { bf16x8 kf[8]; const unsigned ka = kaddr0 + s * KSLOT, va = vaddr0 + sK * VSLOT; A_HEAD(); A_BODY(); } while (0)
#define A_ITER() do { bf16x8 kf[8]; const unsigned ka = kaddr0 + s * KSLOT, va = vaddr0 + sK * VSLOT; A_HEAD(); A_TAIL(A_KRD8S()); A_BODY(); } while (0)
#define A_ITER0() do { bf16x8 kf[8]; s16x4 vl[2][4], vh[2][4]; const unsigned ka = kaddr0 + s * KSLOT, va = vaddr0 + sK * VSLOT; \
      \
    __builtin_amdgcn_s_setprio(3); A_SBAR(); A_KRD(kf[0], ka, 0); A_KRD(kf[2], ka, 2048); A_KRD(kf[4], ka, 4096); A_KRD(kf[6], ka, 6144); A_KRD(kf[1], ka, 512); A_KRD(kf[3], ka, 2560); A_KRD(kf[5], ka, 4608); A_KRD(kf[7], ka, 6656); \
    float sa = 0.f, sb = 0.f; u32x4 pwn[4]; float e0_, e1_, e2_, e3_, e4_, e5_, e6_, e7_, e8_, e9_, e10_, e11_, e12_, e13_, e14_, e15_, e16_, e17_, e18_, e19_, e20_, e21_, e22_, e23_, e24_, e25_, e26_, e27_, e28_, e29_, e30_, e31_; \
      \
    A_LWAIT(7); S0 = __builtin_amdgcn_mfma_f32_32x32x16_bf16(kf[0], qr[0], negm, 0, 0, 0); A_SBAR(); if (i + ADEPTH < NT) DMA_K(i + ADEPTH, sK); A_SBAR(); \
    A_LWAIT(6); S0 = __builtin_amdgcn_mfma_f32_32x32x16_bf16(kf[2], qr[1], S0, 0, 0, 0); A_SBAR(); \
    A_LWAIT(5); S0 = __builtin_amdgcn_mfma_f32_32x32x16_bf16(kf[4], qr[2], S0, 0, 0, 0); A_SBAR(); if (i + ADEPTH - 1 < NT) DMA_VA(i + ADEPTH - 1, sV); A_SBAR(); \
    A_LWAIT(4); S0 = __builtin_amdgcn_mfma_f32_32x32x16_bf16(kf[6], qr[3], S0, 0, 0, 0); A_SBAR(); A_VRD8(0, va, 0); \
    A_LWAIT(11); S1 = __builtin_amdgcn_mfma_f32_32x32x16_bf16(kf[1], qr[0], negm, 0, 0, 0); A_SBAR(); if (i + ADEPTH - 1 < NT) DMA_VB(i + ADEPTH - 1, sV); A_SBAR(); \
    A_LWAIT(10); S1 = __builtin_amdgcn_mfma_f32_32x32x16_bf16(kf[3], qr[1], S1, 0, 0, 0); A_SBAR(); { e0_ = __builtin_amdgcn_exp2f(S0[0]); e1_ = __builtin_amdgcn_exp2f(S0[1]); e2_ = __builtin_amdgcn_exp2f(S0[2]); asm volatile("" : "+v"(e0_), "+v"(e1_), "+v"(e2_)); } A_SBAR(); __builtin_amdgcn_s_setprio(2); A_SBAR(); \
    A_LWAIT(9); S1 = __builtin_amdgcn_mfma_f32_32x32x16_bf16(kf[5], qr[2], S1, 0, 0, 0); A_SBAR(); { e3_ = __builtin_amdgcn_exp2f(S0[3]); sa += e0_; sb += e1_; unsigned w0_ = cvtpk_b(e0_, e1_); asm volatile("" : "+v"(e3_), "+v"(sa), "+v"(sb), "+v"(w0_)); pwn[0][0] = w0_; } A_SBAR(); \
    A_LWAIT(8); S1 = __builtin_amdgcn_mfma_f32_32x32x16_bf16(kf[7], qr[3], S1, 0, 0, 0); A_SBAR(); { e4_ = __builtin_amdgcn_exp2f(S0[4]); e5_ = __builtin_amdgcn_exp2f(S0[5]); sa += e2_; sb += e3_; asm volatile("" : "+v"(e4_), "+v"(e5_), "+v"(sa), "+v"(sb)); } A_SBAR(); \
    A_VRD8(1, va, 1); A_LWAIT(8); o[0] = __builtin_amdgcn_mfma_f32_32x32x16_bf16(__builtin_bit_cast(bf16x8, pw0), A_VFR(0, 0), o[0], 0, 0, 0); { unsigned w1_ = cvtpk_b(e2_, e3_); e6_ = __builtin_amdgcn_exp2f(S0[6]); e7_ = __builtin_amdgcn_exp2f(S0[7]); sa += e4_; asm volatile("" : "+v"(w1_), "+v"(e6_), "+v"(e7_), "+v"(sa)); pwn[0][1] = w1_; } A_SBAR(); o[0] = __builtin_amdgcn_mfma_f32_32x32x16_bf16(__builtin_bit_cast(bf16x8, pw1), A_VFR(0, 1), o[0], 0, 0, 0); { sb += e5_; unsigned w2_ = cvtpk_b(e4_, e5_); e8_ = __builtin_amdgcn_exp2f(S0[8]); e9_ = __builtin_amdgcn_exp2f(S0[9]); asm volatile("" : "+v"(sb), "+v"(w2_), "+v"(e8_), "+v"(e9_)); pwn[0][2] = w2_; } A_SBAR(); o[0] = __builtin_amdgcn_mfma_f32_32x32x16_bf16(__builtin_bit_cast(bf16x8, pw2), A_VFR(0, 2), o[0], 0, 0, 0); { sa += e6_; sb += e7_; unsigned w3_ = cvtpk_b(e6_, e7_); e10_ = __builtin_amdgcn_exp2f(S0[10]); asm volatile("" : "+v"(sa), "+v"(sb), "+v"(w3_), "+v"(e10_)); pwn[0][3] = w3_; } A_SBAR(); o[0] = __builtin_amdgcn_mfma_f32_32x32x16_bf16(__builtin_bit_cast(bf16x8, pw3), A_VFR(0, 3), o[0], 0, 0, 0); { e11_ = __builtin_amdgcn_exp2f(S0[11]); sa += e8_; sb += e9_; unsigned w4_ = cvtpk_b(e8_, e9_); asm volatile("" : "+v"(e11_), "+v"(sa), "+v"(sb), "+v"(w4_)); pwn[1][0] = w4_; } A_SBAR(); __builtin_amdgcn_s_setprio(1); A_SBAR(); \
    A_VRD8(0, va, 2); A_LWAIT(8); o[1] = __builtin_amdgcn_mfma_f32_32x32x16_bf16(__builtin_bit_cast(bf16x8, pw0), A_VFR(1, 0), o[1], 0, 0, 0); { e12_ = __builtin_amdgcn_exp2f(S0[12]); e13_ = __builtin_amdgcn_exp2f(S0[13]); sa += e10_; sb += e11_; asm volatile("" : "+v"(e12_), "+v"(e13_), "+v"(sa), "+v"(sb)); } A_SBAR(); o[1] = __builtin_amdgcn_mfma_f32_32x32x16_bf16(__builtin_bit_cast(bf16x8, pw1), A_VFR(1, 1), o[1], 0, 0, 0); { unsigned w5_ = cvtpk_b(e10_, e11_); e14_ = __builtin_amdgcn_exp2f(S0[14]); e15_ = __builtin_amdgcn_exp2f(S0[15]); sa += e12_; asm volatile("" : "+v"(w5_), "+v"(e14_), "+v"(e15_), "+v"(sa)); pwn[1][1] = w5_; } A_SBAR(); o[1] = __builtin_amdgcn_mfma_f32_32x32x16_bf16(__builtin_bit_cast(bf16x8, pw2), A_VFR(1, 2), o[1], 0, 0, 0); { sb += e13_; unsigned w6_ = cvtpk_b(e12_, e13_); e16_ = __builtin_amdgcn_exp2f(S1[0]); e17_ = __builtin_amdgcn_exp2f(S1[1]); asm volatile("" : "+v"(sb), "+v"(w6_), "+v"(e16_), "+v"(e17_)); pwn[1][2] = w6_; } A_SBAR(); o[1] = __builtin_amdgcn_mfma_f32_32x32x16_bf16(__builtin_bit_cast(bf16x8, pw3), A_VFR(1, 3), o[1], 0, 0, 0); { sa += e14_; sb += e15_; unsigned w7_ = cvtpk_b(e14_, e15_); e18_ = __builtin_amdgcn_exp2f(S1[2]); asm volatile("" : "+v"(sa), "+v"(sb), "+v"(w7_), "+v"(e18_)); pwn[1][3] = w7_; } A_SBAR(); \
    A_VRD8(1, va, 3); A_LWAIT(8); o[2] = __builtin_amdgcn_mfma_f32_32x32x16_bf16(__builtin_bit_cast(bf16x8, pw0), A_VFR(0, 0), o[2], 0, 0, 0); { e19_ = __builtin_amdgcn_exp2f(S1[3]); sa += e16_; sb += e17_; unsigned w8_ = cvtpk_b(e16_, e17_); asm volatile("" : "+v"(e19_), "+v"(sa), "+v"(sb), "+v"(w8_)); pwn[2][0] = w8_; } A_SBAR(); o[2] = __builtin_amdgcn_mfma_f32_32x32x16_bf16(__builtin_bit_cast(bf16x8, pw1), A_VFR(0, 1), o[2], 0, 0, 0); { e20_ = __builtin_amdgcn_exp2f(S1[4]); e21_ = __builtin_amdgcn_exp2f(S1[5]); sa += e18_; sb += e19_; asm volatile("" : "+v"(e20_), "+v"(e21_), "+v"(sa), "+v"(sb)); } A_SBAR(); __builtin_amdgcn_s_setprio(0); A_SBAR(); o[2] = __builtin_amdgcn_mfma_f32_32x32x16_bf16(__builtin_bit_cast(bf16x8, pw2), A_VFR(0, 2), o[2], 0, 0, 0); { unsigned w9_ = cvtpk_b(e18_, e19_); e22_ = __builtin_amdgcn_exp2f(S1[6]); e23_ = __builtin_amdgcn_exp2f(S1[7]); sa += e20_; asm volatile("" : "+v"(w9_), "+v"(e22_), "+v"(e23_), "+v"(sa)); pwn[2][1] = w9_; } A_SBAR(); o[2] = __builtin_amdgcn_mfma_f32_32x32x16_bf16(__builtin_bit_cast(bf16x8, pw3), A_VFR(0, 3), o[2], 0, 0, 0); { sb += e21_; unsigned w10_ = cvtpk_b(e20_, e21_); e24_ = __builtin_amdgcn_exp2f(S1[8]); e25_ = __builtin_amdgcn_exp2f(S1[9]); asm volatile("" : "+v"(sb), "+v"(w10_), "+v"(e24_), "+v"(e25_)); pwn[2][2] = w10_; } A_SBAR(); \
    A_LWAIT(0); o[3] = __builtin_amdgcn_mfma_f32_32x32x16_bf16(__builtin_bit_cast(bf16x8, pw0), A_VFR(1, 0), o[3], 0, 0, 0); { sa += e22_; sb += e23_; unsigned w11_ = cvtpk_b(e22_, e23_); e26_ = __builtin_amdgcn_exp2f(S1[10]); e27_ = __builtin_amdgcn_exp2f(S1[11]); asm volatile("" : "+v"(sa), "+v"(sb), "+v"(w11_), "+v"(e26_), "+v"(e27_)); pwn[2][3] = w11_; } A_SBAR(); o[3] = __builtin_amdgcn_mfma_f32_32x32x16_bf16(__builtin_bit_cast(bf16x8, pw1), A_VFR(1, 1), o[3], 0, 0, 0); { sa += e24_; sb += e25_; unsigned w12_ = cvtpk_b(e24_, e25_); e28_ = __builtin_amdgcn_exp2f(S1[12]); e29_ = __builtin_amdgcn_exp2f(S1[13]); asm volatile("" : "+v"(sa), "+v"(sb), "+v"(w12_), "+v"(e28_), "+v"(e29_)); pwn[3][0] = w12_; } A_SBAR(); o[3] = __builtin_amdgcn_mfma_f32_32x32x16_bf16(__builtin_bit_cast(bf16x8, pw2), A_VFR(1, 2), o[3], 0, 0, 0); { sa += e26_; sb += e27_; unsigned w13_ = cvtpk_b(e26_, e27_); e30_ = __builtin_amdgcn_exp2f(S1[14]); e31_ = __builtin_amdgcn_exp2f(S1[15]); asm volatile("" : "+v"(sa), "+v"(sb), "+v"(w13_), "+v"(e30_), "+v"(e31_)); pwn[3][1] = w13_; } A_SBAR(); o[3] = __builtin_amdgcn_mfma_f32_32x32x16_bf16(__builtin_bit_cast(bf16x8, pw3), A_VFR(1, 3), o[3], 0, 0, 0); { sa += e28_; sb += e29_; unsigned w14_ = cvtpk_b(e28_, e29_); sa += e30_; sb += e31_; unsigned w15_ = cvtpk_b(e30_, e31_); asm volatile("" : "+v"(sa), "+v"(sb), "+v"(w14_), "+v"(w15_)); pwn[3][2] = w14_; pwn[3][3] = w15_; } A_SBAR(); \
      \
    float rm = sa + sb;                                     \
    { auto rr = __builtin_amdgcn_permlane32_swap(__float_as_uint(rm), __float_as_uint(rm), false, false); rm = __uint_as_float(rr[0]) + __uint_as_float(rr[1]); } \
    if (__builtin_expect(__any(rm > A_TRIG), 0)) { \
      const float dl = fmaxf(__builtin_amdgcn_logf(rm), 0.f); mhat += dl; \
      _Pragma("unroll") for (int r = 0; r < 16; ++r) negm[r] = -mhat; \
      asm volatile("" : "+v"(negm)); \
      const float f = __builtin_amdgcn_exp2f(-dl); l_reg *= f; sa *= f; sb *= f; \
      _Pragma("unroll") for (int q = 0; q < 4; ++q) _Pragma("unroll") for (int c = 0; c < 4; ++c) { const unsigned w_ = pwn[q][c]; pwn[q][c] = cvtpk_b(__uint_as_float(w_ << 16) * f, __uint_as_float(w_ & 0xffff0000u) * f); } \
      if (hi == 0) wsf[r32] = f; A_RESCALE_O(); } \
    l_reg += sa + sb; pw0 = pwn[0]; pw1 = pwn[1]; pw2 = pwn[2]; pw3 = pwn[3]; \
    if (i + ADEPTH < NT) A_WAITBAR(A_INFLIGHT); else A_WAITBAR(0); } while (0)
#define A_ROT() do { sV = sK; sK = s; s = (s == NSLOT - 1) ? 0 : s + 1; } while (0)
  int s = 0, sK = NSLOT - 1, sV = NSLOT - 2, i = 0;
  if (ROTL) {
  s16x4 vl[2][4], vh[2][4]; float sa = 0.f, sb = 0.f; u32x4 pwn[4]; float e0_, e1_, e2_, e3_, e4_, e5_, e6_, e7_, e8_, e9_, e10_, e11_, e12_, e13_, e14_, e15_, e16_, e17_, e18_, e19_, e20_, e21_, e22_, e23_, e24_, e25_, e26_, e27_, e28_, e29_, e30_, e31_;
  A_MBLOCK(true, false); A_VBLOCK(true); A_ROT();
#ifdef TPROBE
  unsigned long long tp0_ = __builtin_readcyclecounter(); unsigned long long tpa_ = 0;
#endif
  i = 1; A_ITER1(); A_ROT(); ++i;
#pragma unroll 1
  for (; i + 1 < NT; ) { A_ITER(); A_ROT(); ++i; A_ITER(); A_ROT(); ++i; }
  if (i < NT) { A_ITER(); A_ROT(); ++i; }
#ifdef TPROBE
  if (NT > 100 && blockIdx.x == 0 && wid == TP_WAVE) { const unsigned long long tp1_ = __builtin_readcyclecounter();
    if (lane == 0) g_tprobe = floorf(((float)(TPROBE == 1 ? tp1_ - tp0_ : tpa_) / (float)(NT - 1) - TP_OFF) * TP_SCALE * TP_Q + 0.5f) / TP_Q; }
#endif
  A_TAIL((void)0);
  __builtin_amdgcn_s_setprio(0);
  } else {
  A_MBLOCK(true, false); A_VBLOCK(true); A_ROT();
#pragma unroll 1
  for (i = 1; i < NT; ) { A_ITER0(); A_ROT(); ++i; }
  }
  A_MBLOCK(false, true);
#ifdef ATT_NOSTAGGER
  A_LGKBAR();
#endif
#undef A_KRD
#undef A_VRD
#undef A_VRD8
#undef A_LWAIT
#undef A_VFR
#undef A_PV4
#undef A_QK8
#undef A_KRD8
#undef A_RESCALE_O
#undef A_MBLOCK
#undef A_VBLOCK
#undef A_ROT
#undef A_SX
#undef A_TRIG
#undef A_GAP
#undef A_PV4I
#undef A_ITER
#undef A_ITER0
#undef A_ITER1
#undef A_HEAD
#undef A_TAIL
#undef A_BODY
#undef A_KRD8S
#undef A_KRD4B
#ifndef ATT_NOSTAGGER
  if (half == 0) A_LGKBAR();
#endif
  { auto rr = __builtin_amdgcn_permlane32_swap(__float_as_uint(l_reg), __float_as_uint(l_reg), false, false); l_out = __uint_as_float(rr[0]) + __uint_as_float(rr[1]); }
#undef DMA_K
#undef DMA_V
#undef DMA_VA
#undef DMA_VB
}

struct Tensors { const bf16_t* Q; const bf16_t* K; const bf16_t* V; bf16_t* MIX; float* scr; const float* g; float lam, oml; };
constexpr int MIXP = 2560, MIX_ATT = 1536, KTILES = 260;
template <bool ROTL> __device__ __forceinline__ void attn_unit(int h, int q0, int NT, const Tensors& T, char* lds) {
  int tid_ = threadIdx.x; asm volatile("" : "+v"(tid_));
  const int tid = tid_, wid = tid >> 6, lane = tid & 63, r32 = lane & 31, hi = lane >> 5;
  float* li_l = (float*)(lds + LDS_WS) + wid * 64 + 32;
  f32x16 o[4]; float l_reg;
  attn_pass<8, ROTL>(T.Q + (long)q0 * PITCH + h * 128 + 64, T.K + (size_t)(h * 2 + 1) * KTILES * 4096, T.V + (size_t)h * KTILES * 8192, NT, lds, o, l_reg);
  if (hi == 0) li_l[r32] = l_reg; asm volatile("s_waitcnt lgkmcnt(0)" ::: "memory");
  {
    float rli[16];
#pragma unroll
    for (int r = 0; r < 16; ++r) rli[r] = __builtin_amdgcn_rcpf(li_l[crow(r, hi)]);
    typedef float f4 __attribute__((ext_vector_type(4)));
    A_GAS f4* sp = (A_GAS f4*)(T.scr + (size_t)tid * 64);
#pragma unroll
    for (int d0 = 0; d0 < 4; ++d0)
#pragma unroll
      for (int r4 = 0; r4 < 4; ++r4) sp[d0 * 4 + r4] = (f4){o[d0][4 * r4] * rli[4 * r4], o[d0][4 * r4 + 1] * rli[4 * r4 + 1], o[d0][4 * r4 + 2] * rli[4 * r4 + 2], o[d0][4 * r4 + 3] * rli[4 * r4 + 3]};
  }
  asm volatile("s_waitcnt vmcnt(0) lgkmcnt(0)" ::: "memory");
  attn_pass<8, ROTL>(T.Q + (long)q0 * PITCH + h * 128, T.K + (size_t)(h * 2) * KTILES * 4096, T.V + (size_t)h * KTILES * 8192, NT, lds, o, l_reg);
  if (hi == 0) li_l[r32] = l_reg; asm volatile("s_waitcnt lgkmcnt(0)" ::: "memory");
  float ss[16];
#pragma unroll
  for (int r = 0; r < 16; ++r) ss[r] = 0.f;
  { typedef float f4 __attribute__((ext_vector_type(4)));
    const A_GAS f4* sp = (const A_GAS f4*)(T.scr + (size_t)tid * 64);
#pragma unroll
    for (int r4 = 0; r4 < 4; ++r4) { float rl[4];
#pragma unroll
      for (int q = 0; q < 4; ++q) rl[q] = __builtin_amdgcn_rcpf(li_l[crow(4 * r4 + q, hi)]);
#pragma unroll
      for (int d0 = 0; d0 < 4; ++d0) { const f4 p2 = sp[d0 * 4 + r4];
#pragma unroll
        for (int q = 0; q < 4; ++q) { const float v = o[d0][4 * r4 + q] * rl[q] - T.lam * p2[q]; o[d0][4 * r4 + q] = v; ss[4 * r4 + q] += v * v; } } } }
#pragma unroll
  for (int r = 0; r < 16; ++r) {
#pragma unroll
    for (int x = 1; x < 32; x <<= 1) ss[r] += __shfl_xor(ss[r], x);
    ss[r] = T.oml / sqrtf(ss[r] * (1.f / 128.f) + 1e-6f); }
  float gv[4];
#pragma unroll
  for (int d0 = 0; d0 < 4; ++d0) gv[d0] = ((const A_GAS float*)T.g)[d0 * 32 + r32];
  A_GAS bf16_t* Ow = (A_GAS bf16_t*)T.MIX + (long)(q0 + wid * QBLK) * MIXP + MIX_ATT + h * 128;
#pragma unroll
  for (int r = 0; r < 16; ++r) { const int orow = crow(r, hi);
#pragma unroll
    for (int d0 = 0; d0 < 4; ++d0) { const unsigned w = cvtpk(o[d0][r] * ss[r] * gv[d0], 0.f); Ow[(long)orow * MIXP + d0 * 32 + r32] = (bf16_t)(w & 0xffffu); } }
  asm volatile("s_waitcnt vmcnt(0) lgkmcnt(0)" ::: "memory");
  __syncthreads();
}
#undef A_WAITBAR
#undef A_LGKBAR
#undef A_SBAR
}
#define GAS __attribute__((address_space(1)))
#define LAS __attribute__((address_space(3)))
typedef unsigned short bf16;
typedef unsigned v4u __attribute__((ext_vector_type(4)));
typedef float f32x4 __attribute__((ext_vector_type(4)));
typedef short bf16x8 __attribute__((ext_vector_type(8)));
typedef GAS unsigned gu32;
typedef GAS unsigned long long gu64;
#define RLX_AGENT __ATOMIC_RELAXED, __HIP_MEMORY_SCOPE_AGENT
#define LDS_WAIT() asm volatile("s_waitcnt lgkmcnt(0)" ::: "memory")
#define VM_WAIT() asm volatile("s_waitcnt vmcnt(0)" ::: "memory")
__device__ __forceinline__ unsigned long long rt() { return __builtin_amdgcn_s_memrealtime(); }
__device__ __forceinline__ unsigned f2bf(float f) { unsigned u = __builtin_bit_cast(unsigned, f); return (u + 0x7fffu + ((u >> 16) & 1u)) >> 16; }
__device__ __forceinline__ unsigned pk2(float lo, float hi) { return f2bf(lo) | (f2bf(hi) << 16); }

#define XB_TMO      128
#define XB_XCNT(j)  (256  + 64 * (j))
#define XB_XSUB(j)  (1280 + 64 * (j))
#define XB_XGEN(j)  (2304 + 64 * (j))
#define XB_TOP      3328
#define XB_TOPGEN   3392
#define XCD_BAR_WORDS 3456
#define XB_SPIN_CAP (1u << 18)

__device__ __forceinline__ unsigned xb_ld(unsigned* p)              { return __hip_atomic_load(p, __ATOMIC_RELAXED, __HIP_MEMORY_SCOPE_AGENT); }
__device__ __forceinline__ unsigned xb_add(unsigned* p, unsigned v) { return __hip_atomic_fetch_add(p, v, __ATOMIC_RELAXED, __HIP_MEMORY_SCOPE_AGENT); }
__device__ __forceinline__ unsigned xb_xcc_id() { return (unsigned)__builtin_amdgcn_s_getreg((3 << 11) | 20) & 0xFu; }
#define XB_SPIN(cond, bar) do { unsigned _sp = 0; while (cond) { __builtin_amdgcn_s_sleep(1); \
    if ((++_sp & 255u) == 0u) { if (xb_ld(&(bar)[XB_TMO])) break; if (_sp > XB_SPIN_CAP) { atomicAdd(&(bar)[XB_TMO], 1u); break; } } } } while (0)

struct XcdBarrier {
    unsigned* bar; unsigned x;
    volatile LAS unsigned* st;
};

__device__ __forceinline__ XcdBarrier xcd_barrier_post(unsigned* bar, volatile LAS unsigned* st) {
    XcdBarrier b; b.bar = bar; b.x = xb_xcc_id(); b.st = st;
    if (threadIdx.x == 0) (void)xb_add(&bar[XB_XCNT(b.x)], 1u);
    return b;
}
__device__ __forceinline__ void xcd_barrier_complete(unsigned* bar, unsigned x, unsigned& nloc, unsigned& nx) {
    const unsigned G = gridDim.x * gridDim.y * gridDim.z;
    unsigned sum, cnt, mine, sp = 0u;
    for (;;) {
        sum = 0u; cnt = 0u; mine = 0u;
#pragma unroll
        for (unsigned j = 0; j < 16; ++j) { const unsigned c = xb_ld(&bar[XB_XCNT(j)]); sum += c; cnt += (c > 0u) ? 1u : 0u; mine = (j == x) ? c : mine; }
        if (sum == G) break;
        __builtin_amdgcn_s_sleep(1);
        if ((++sp & 255u) == 0u) { if (xb_ld(&bar[XB_TMO])) break; if (sp > XB_SPIN_CAP) { atomicAdd(&bar[XB_TMO], 1u); break; } }
    }
    nloc = mine > 0u ? mine : 1u; nx = cnt > 0u ? cnt : 1u;
}

__device__ __forceinline__ void xcd_barrier(const XcdBarrier& b) {
    asm volatile("s_waitcnt vmcnt(0)" ::: "memory");
    __syncthreads();
    if (threadIdx.x == 0) {
        unsigned* bar = b.bar;
        __builtin_amdgcn_s_waitcnt(0);
        unsigned nloc = b.st[0], nx = b.st[1];
        if (nloc == 0u) { xcd_barrier_complete(bar, b.x, nloc, nx); b.st[0] = nloc; b.st[1] = nx; }
        const unsigned old = xb_add(&bar[XB_XSUB(b.x)], 1u);
        const unsigned gen = old / nloc;
        if (old + 1u == (gen + 1u) * nloc) {
            __builtin_amdgcn_fence(__ATOMIC_RELEASE, "agent");
            asm volatile("s_waitcnt vmcnt(0)" ::: "memory");
            const unsigned og = xb_add(&bar[XB_TOP], 1u);
            const unsigned tg = og / nx;
            if (og + 1u == (tg + 1u) * nx) xb_add(&bar[XB_TOPGEN], 1u);
            else XB_SPIN(xb_ld(&bar[XB_TOPGEN]) == tg, bar);
            __builtin_amdgcn_fence(__ATOMIC_ACQUIRE, "agent");
            xb_add(&bar[XB_XGEN(b.x)], 1u);
            asm volatile("s_waitcnt vmcnt(0)" ::: "memory");
        } else {
            XB_SPIN(xb_ld(&bar[XB_XGEN(b.x)]) == gen, bar);
            __builtin_amdgcn_fence(__ATOMIC_ACQUIRE, "agent");
            asm volatile("s_waitcnt vmcnt(0)" ::: "memory");
        }
    }
    __syncthreads();
}
constexpr int DM = 2048, SEQ = 16384, CTXL = 256, ROWS = SEQ + CTXL, NMT = ROWS / 256;
constexpr int DIN = 4608, NMODV = 6 * DM, DEPTH = 2, NE = 32, DE = 512, NIN = 31;
constexpr int MIXP = 2560;
constexpr float LN_EPS = 1e-6f, ALPHA = 1.4142135623730951f;
constexpr float QSCALE = 0.125f * 1.4426950408889634f;
constexpr int LCAP = ROWS;
constexpr int NPH = 2 + 9 * DEPTH;

constexpr size_t MiB = 1u << 20, KiB = 1024;
constexpr size_t WS_CTL = 0, CTL_ZERO_BYTES = 128 * KiB;
constexpr size_t WS_MOD = 1 * MiB;
constexpr size_t WS_SMALL = 2 * MiB;
constexpr size_t WS_BINP = WS_SMALL, WS_ROPE = WS_SMALL + 64 * KiB, WS_BTA = WS_SMALL + 128 * KiB, WS_BTB = WS_SMALL + 192 * KiB, WS_F256 = WS_SMALL + 320 * KiB,
                 WS_LAMV = WS_SMALL + 576 * KiB, WS_CS128 = WS_SMALL + 640 * KiB  ;
constexpr size_t WS_WRT = 3 * MiB;
constexpr size_t WS_MODP = 4 * MiB;
constexpr size_t WS_WOT = 10 * MiB;
constexpr size_t WS_HB = 18 * MiB, WS_PWB = 21 * MiB;
constexpr size_t WS_WCAT = 26 * MiB;
constexpr size_t WS_WIN = 46 * MiB;
constexpr size_t WS_WGU = 82 * MiB;
constexpr size_t WS_WD = 210 * MiB;
constexpr size_t WS_XN = 274 * MiB;
constexpr size_t QKV_BYTES = (size_t)ROWS * 1024 * 2;
constexpr size_t WS_Q = 339 * MiB, WS_K = WS_Q + QKV_BYTES, WS_V = WS_K + QKV_BYTES, WS_AG = WS_V + QKV_BYTES;
constexpr size_t WS_YK = WS_Q;
constexpr size_t WS_UF = 469 * MiB, WS_UFC = 485 * MiB, WS_PF2 = 486 * MiB;
constexpr size_t WS_MIX = 518 * MiB;
constexpr size_t WS_T = 600 * MiB;
constexpr size_t WS_X2 = 730 * MiB;
constexpr size_t WS_ACT = 860 * MiB;
constexpr size_t WS_DMIX = WS_ACT;
constexpr size_t WS_O2N = 902 * MiB;
static_assert(WS_DMIX + (size_t)ROWS * DM * 2 <= 934 * MiB, "Dmix overlays ACT | O2N");
constexpr size_t WS_LIST = 934 * MiB;
constexpr size_t WS_WTOK = 939 * MiB;
constexpr size_t WS_END = 940 * MiB;
static_assert(WS_AG + QKV_BYTES <= WS_UF && WS_XN + (size_t)ROWS * DM * 2 <= WS_Q && WS_MIX + (size_t)ROWS * MIXP * 2 <= WS_T && WS_T + (size_t)ROWS * DM * 4 <= WS_X2 && WS_X2 + (size_t)ROWS * DM * 4 <= WS_ACT, "ws map");
static_assert(WS_WIN + (size_t)2 * DIN * DM * 2 <= WS_WGU && WS_WGU + (size_t)NE * 1024 * DM * 2 <= WS_WD && WS_WD + (size_t)NE * DM * DE * 2 <= WS_XN && WS_WCAT + (size_t)2 * DM * MIXP * 2 <= WS_WIN, "ws map 2");
constexpr int CW_TMO = 0, CW_CODE = 1, CW_BAR = 4096, CW_CNT = 16384;
static_assert((size_t)(CW_CNT + 2 * 32 * 64) * 4 <= CTL_ZERO_BYTES, "control words inside the per-call memset");

constexpr int RING_OFF = 0, RING_BYTES = 139264;
constexpr int LDSCTL_OFF = RING_BYTES, MISC_OFF = LDSCTL_OFF + 320;
constexpr int LDS_BYTES = 147456;
constexpr int NWAVES = 8;

typedef float f32x2v __attribute__((ext_vector_type(2)));
typedef unsigned u32x2v __attribute__((ext_vector_type(2)));
using pg8::Unit;

__device__ __forceinline__ unsigned cvtpk(float lo, float hi) { unsigned r; asm volatile("v_cvt_pk_bf16_f32 %0, %1, %2" : "=v"(r) : "v"(lo), "v"(hi)); return r; }
__device__ __forceinline__ bf16 bf1(float x) { return (bf16)(cvtpk(x, 0.f) & 0xffffu); }
__device__ __forceinline__ float bf2f(unsigned short b) { return __uint_as_float((unsigned)b << 16); }
__device__ __forceinline__ float wave_sum(float v) {
#pragma unroll
    for (int o = 1; o < 64; o <<= 1) v += __shfl_xor(v, o);
    return v;
}
__device__ __forceinline__ float silu_f(float x) { return x / (1.f + __expf(-x)); }

struct Frame {
    LAS unsigned char* lds;
    volatile LAS unsigned* MISC;
    gu32* ctl;
    int tid, lane, wave;
    int vcu, G;
    const float* const* in; float* out; unsigned char* ws;
};

struct SchedWin { pg8::GridOrder go;
    __device__ __forceinline__ bool next(int i, Unit& u) const { return go.next(i, u); }
    __device__ __forceinline__ int arow(const Unit& u, int R) const { return (u.pn < 2 && u.pm >= 1) ? CTXL + 128 * (R & 127) + 2 * (u.pm - 1) + (R >> 7) : u.pm * 256 + R; }
    __device__ __forceinline__ int brow(const Unit& u) const { return u.pn * 256; } };
struct SchedNat { pg8::GridOrder go; int pmoff;
    __device__ __forceinline__ bool next(int i, Unit& u) const { if (!go.next(i, u)) return false; u.pm += pmoff; return true; }
    __device__ __forceinline__ int arow(const Unit& u, int R) const { return u.pm * 256 + R; }
    __device__ __forceinline__ int brow(const Unit& u) const { return u.pn * 256; } };
struct SchedFA { pg8::GridOrder go;
    __device__ __forceinline__ bool next(int i, Unit& u) const { return go.next(i, u); }
    __device__ __forceinline__ int arow(const Unit& u, int R) const { return (u.pm & 255) * 256 + R; }
    __device__ __forceinline__ int brow(const Unit&) const { return 0; } };
struct SchedFB { pg8::GridOrder go;
    __device__ __forceinline__ bool next(int i, Unit& u) const { return go.next(i, u); }
    __device__ __forceinline__ int arow(const Unit& u, int R) const { return (16 * (u.pm >> 3) + (R & 15)) * 128 + 16 * (u.pm & 7) + (R >> 4); }
    __device__ __forceinline__ int brow(const Unit&) const { return 0; } };
template <int WHICH> struct SchedMoe {
    const LAS int* tstart; const LAS int* cnt; const int* list; int G, c;
    static constexpr int NPN = WHICH == 1 ? 4 : 8;
    __device__ __forceinline__ bool next(int i, Unit& u) const {
        const int L = i * G + c, gt = L / NPN; if (gt >= tstart[NE]) return false;
        int e = 0; while (tstart[e + 1] <= gt) ++e;
        u.pm = gt; u.pn = L % NPN; u.e = e; u.rt = gt - tstart[e]; return true; }
    __device__ __forceinline__ int arow(const Unit& u, int R) const {
        if (WHICH == 2) return u.pm * 256 + R;
        const int slot = u.rt * 256 + R; return slot < cnt[u.e] ? (((const GAS int*)list)[u.e * LCAP + slot] >> 1) : 0; }
    __device__ __forceinline__ int brow(const Unit& u) const { return WHICH == 1 ? u.e * 1024 + u.pn * 256 : u.e * DM + u.pn * 256; } };

struct EpiWin {
    static constexpr bool PERM = true;
    bf16 *Uf, *UfC, *AG, *Q, *Kb, *V; const float* bias; const f32x2v* rope;
    __device__ __forceinline__ void operator()(const f32x4 (&acc)[2][2][4][2], const Unit& u, int wr, int wc, int fr, int fq) const {
        const int pn = u.pn, pm = u.pm, c0 = wc * 32 + 8 * fq;
        f32x4 bv[2][2];
#pragma unroll
        for (int bj = 0; bj < 2; ++bj)
#pragma unroll
            for (int n = 0; n < 2; ++n) bv[bj][n] = *(const GAS f32x4*)(bias + pn * 256 + bj * 128 + c0 + 4 * n);
        if (pn < 2) {
#pragma unroll
            for (int ai = 0; ai < 2; ++ai)
#pragma unroll
                for (int m = 0; m < 4; ++m)
#pragma unroll
                    for (int bj = 0; bj < 2; ++bj) {
                        const f32x4 v0 = acc[ai][bj][m][0] + bv[bj][0], v1 = acc[ai][bj][m][1] + bv[bj][1];
                        const int ch = pn * 256 + bj * 128 + c0, a = wr * 64 + m * 16 + fr;
                        GAS bf16* dst; size_t st;
                        if (pm == 0) { dst = (GAS bf16*)UfC + (size_t)ch * 256 + (ai * 128 + a); st = 256; }
                        else { dst = (GAS bf16*)Uf + ((size_t)ch * 128 + (2 * (pm - 1) + ai)) * 128 + a; st = 128 * 128; }
                        dst[0] = bf1(v0[0]); dst[st] = bf1(v0[1]); dst[2 * st] = bf1(v0[2]); dst[3 * st] = bf1(v0[3]);
                        dst[4 * st] = bf1(v1[0]); dst[5 * st] = bf1(v1[1]); dst[6 * st] = bf1(v1[2]); dst[7 * st] = bf1(v1[3]);
                    }
        } else if (pn < 6) {
            bf16* base = AG; const int colt = (pn - 2) * 256;
#pragma unroll
            for (int ai = 0; ai < 2; ++ai)
#pragma unroll
                for (int m = 0; m < 4; ++m) { bf16* rowp = base + (size_t)(pm * 256 + ai * 128 + wr * 64 + m * 16 + fr) * 1024 + colt + c0;
#pragma unroll
                    for (int bj = 0; bj < 2; ++bj) { const f32x4 v0 = acc[ai][bj][m][0] + bv[bj][0], v1 = acc[ai][bj][m][1] + bv[bj][1];
                        v4u w; w.x = cvtpk(v0[0], v0[1]); w.y = cvtpk(v0[2], v0[3]); w.z = cvtpk(v1[0], v1[1]); w.w = cvtpk(v1[2], v1[3]);
                        *(GAS v4u*)(rowp + bj * 128) = w; } }
        } else if (pn >= 14) {
#pragma unroll
            for (int ai = 0; ai < 2; ++ai)
#pragma unroll
                for (int m = 0; m < 4; ++m) { const int row = pm * 256 + ai * 128 + wr * 64 + m * 16 + fr, t = row >> 6, key = row & 63;
#pragma unroll
                    for (int bj = 0; bj < 2; ++bj) { const f32x4 v0 = acc[ai][bj][m][0] + bv[bj][0], v1 = acc[ai][bj][m][1] + bv[bj][1];
                        v4u w; w.x = cvtpk(v0[0], v0[1]); w.y = cvtpk(v0[2], v0[3]); w.z = cvtpk(v1[0], v1[1]); w.w = cvtpk(v1[2], v1[3]);
                        const int h = 2 * (pn - 14) + bj;
                        *(GAS v4u*)(V + ((((size_t)h * 260 + t) * 16 + (c0 >> 5) * 4 + (key >> 4)) * 16 + (key & 15)) * 32 + (c0 & 31)) = w; } }
        } else {
            const bool isq = pn < 10; const int colt = (pn - (isq ? 6 : 10)) * 256; const float sc = isq ? QSCALE : 1.f;
#pragma unroll
            for (int ai = 0; ai < 2; ++ai)
#pragma unroll
                for (int m = 0; m < 4; ++m) { const int row = pm * 256 + ai * 128 + wr * 64 + m * 16 + fr;
                    f32x4 cs0 = (f32x4){1.f, 0.f, 1.f, 0.f}, cs1 = cs0;
                    if (pm > 0) { const int pos = row - CTXL; const int t = (wc & 1) ? 256 + (pos & 63) : (pos >> 6);
                        const GAS f32x4* rp = (const GAS f32x4*)(rope + t * 16 + 4 * fq); cs0 = rp[0]; cs1 = rp[1]; }
#pragma unroll
                    for (int bj = 0; bj < 2; ++bj) { const f32x4 v0 = acc[ai][bj][m][0] + bv[bj][0], v1 = acc[ai][bj][m][1] + bv[bj][1];
                        const float o0 = (v0[0] * cs0[0] - v0[1] * cs0[1]) * sc, o1 = (v0[0] * cs0[1] + v0[1] * cs0[0]) * sc;
                        const float o2 = (v0[2] * cs0[2] - v0[3] * cs0[3]) * sc, o3 = (v0[2] * cs0[3] + v0[3] * cs0[2]) * sc;
                        const float o4 = (v1[0] * cs1[0] - v1[1] * cs1[1]) * sc, o5 = (v1[0] * cs1[1] + v1[1] * cs1[0]) * sc;
                        const float o6 = (v1[2] * cs1[2] - v1[3] * cs1[3]) * sc, o7 = (v1[2] * cs1[3] + v1[3] * cs1[2]) * sc;
                        v4u w; w.x = cvtpk(o0, o1); w.y = cvtpk(o2, o3); w.z = cvtpk(o4, o5); w.w = cvtpk(o6, o7);
                        if (isq) *(GAS v4u*)(Q + (size_t)row * 1024 + colt + bj * 128 + c0) = w;
                        else {
                            const int h = (colt >> 7) + bj, t = row >> 6, key = row & 63;
                            *(GAS v4u*)(Kb + (((((size_t)(h * 2 + (c0 >> 6))) * 260 + t) * 8 + ((c0 & 63) >> 3)) * 64 + key) * 8) = w; } } }
        }
    }
};
struct EpiFA {
    static constexpr bool PERM = false;
    bf16* Pf2;
    __device__ __forceinline__ void operator()(const f32x4 (&acc)[2][2][4][2], const Unit& u, int wr, int wc, int fr, int fq) const {
#pragma unroll
        for (int m = 0; m < 4; ++m) { const int b = wr * 64 + m * 16 + fr;
#pragma unroll
            for (int n = 0; n < 2; ++n)
#pragma unroll
                for (int j = 0; j < 4; ++j) { const int klo = 32 * wc + 16 * n + 4 * fq + j;
                    const float f = (float)((b * klo) & 16383) * (1.f / 16384.f);
                    const float c = __builtin_amdgcn_cosf(f), s = __builtin_amdgcn_sinf(f);
#pragma unroll
                    for (int ai = 0; ai < 2; ++ai) { const float re = acc[ai][0][m][n][j], im = acc[ai][1][m][n][j];
                        GAS bf16* d = (GAS bf16*)Pf2 + (size_t)((2 * (u.pm & 255) + ai) * 128 + klo) * 256 + b;
                        d[0] = bf1(re * c + im * s); d[128] = bf1(im * c - re * s); } }
            asm volatile("" ::: "memory"); }
    }
};
struct EpiFB {
    static constexpr bool PERM = false;
    bf16* MIX;
    __device__ __forceinline__ void operator()(const f32x4 (&acc)[2][2][4][2], const Unit& u, int wr, int wc, int fr, int fq) const {
        const int ch = 16 * (u.pm >> 3) + fr;
#pragma unroll
        for (int ai = 0; ai < 2; ++ai)
#pragma unroll
            for (int m = 0; m < 4; ++m) { const int klo = 16 * (u.pm & 7) + 8 * ai + 4 * wr + m;
#pragma unroll
                for (int bj = 0; bj < 2; ++bj)
#pragma unroll
                    for (int n = 0; n < 2; ++n)
#pragma unroll
                        for (int j = 0; j < 4; ++j) { const int khi = 32 * wc + 16 * n + 4 * fq + j;
                            ((GAS bf16*)MIX)[(size_t)(CTXL + klo + 128 * khi) * MIXP + bj * 512 + ch] = bf1(acc[ai][bj][m][n][j]); }
                asm volatile("" ::: "memory"); }
    }
};
struct EpiCtxF {
    static constexpr bool PERM = false;
    bf16* MIX;
    __device__ __forceinline__ void operator()(const f32x4 (&acc)[2][2][4][2], const Unit& u, int wr, int wc, int fr, int fq) const {
#pragma unroll
        for (int ai = 0; ai < 2; ++ai)
#pragma unroll
            for (int m = 0; m < 4; ++m) { const int k = ai * 128 + wr * 64 + m * 16 + fr;
#pragma unroll
                for (int bj = 0; bj < 2; ++bj)
#pragma unroll
                    for (int n = 0; n < 2; ++n) { const f32x4 v = acc[ai][bj][m][n]; u32x2v w; w.x = cvtpk(v[0], v[1]); w.y = cvtpk(v[2], v[3]);
                        *(GAS u32x2v*)(MIX + (size_t)k * MIXP + u.pm * 512 + u.pn * 256 + bj * 128 + wc * 32 + 16 * n + 4 * fq) = w; }
                asm volatile("" ::: "memory"); }
    }
};
struct EpiWout {
    static constexpr bool PERM = true;
    const float* mod; bf16* Dm;
    __device__ __forceinline__ void operator()(const f32x4 (&acc)[2][2][4][2], const Unit& u, int wr, int wc, int fr, int fq) const {
        const int col0 = u.pn * 256 + wc * 32 + 8 * fq;
        const float* gp = mod + (u.pm == 0 ? NMODV : 0) + 2 * DM + col0;
        f32x4 gv[2][2];
#pragma unroll
        for (int bj = 0; bj < 2; ++bj)
#pragma unroll
            for (int n = 0; n < 2; ++n) gv[bj][n] = *(const GAS f32x4*)(gp + bj * 128 + 4 * n);
#pragma unroll
        for (int ai = 0; ai < 2; ++ai)
#pragma unroll
            for (int m = 0; m < 4; ++m) { bf16* rowp = Dm + (size_t)(u.pm * 256 + ai * 128 + wr * 64 + m * 16 + fr) * DM + col0;
#pragma unroll
                for (int bj = 0; bj < 2; ++bj) { const f32x4 v0 = acc[ai][bj][m][0] * gv[bj][0], v1 = acc[ai][bj][m][1] * gv[bj][1];
                    v4u w; w.x = cvtpk(v0[0], v0[1]); w.y = cvtpk(v0[2], v0[3]); w.z = cvtpk(v1[0], v1[1]); w.w = cvtpk(v1[2], v1[3]);
                    *(GAS v4u*)(rowp + bj * 128) = w; } }
    }
};
struct EpiFold {
    static constexpr bool PERM = true;
    bf16* out; int col0;
    __device__ __forceinline__ void operator()(const f32x4 (&acc)[2][2][4][2], const Unit& u, int wr, int wc, int fr, int fq) const {
        const int c0 = col0 + u.pn * 256 + wc * 32 + 8 * fq;
#pragma unroll
        for (int ai = 0; ai < 2; ++ai)
#pragma unroll
            for (int m = 0; m < 4; ++m) { bf16* rowp = out + (size_t)(u.pm * 256 + ai * 128 + wr * 64 + m * 16 + fr) * MIXP + c0;
#pragma unroll
                for (int bj = 0; bj < 2; ++bj) { const f32x4 v0 = acc[ai][bj][m][0], v1 = acc[ai][bj][m][1];
                    v4u w; w.x = cvtpk(v0[0], v0[1]); w.y = cvtpk(v0[2], v0[3]); w.z = cvtpk(v1[0], v1[1]); w.w = cvtpk(v1[2], v1[3]);
                    *(GAS v4u*)(rowp + bj * 128) = w; } }
    }
};
struct EpiMoe1 {
    static constexpr bool PERM = true;
    bf16* ACT;
    __device__ __forceinline__ void operator()(const f32x4 (&acc)[2][2][4][2], const Unit& u, int wr, int wc, int fr, int fq) const {
#pragma unroll
        for (int ai = 0; ai < 2; ++ai)
#pragma unroll
            for (int m = 0; m < 4; ++m) { bf16* rowp = ACT + (size_t)(u.pm * 256 + ai * 128 + wr * 64 + m * 16 + fr) * DE + u.pn * 128 + wc * 16 + 4 * fq;
#pragma unroll
                for (int bj = 0; bj < 2; ++bj) { const f32x4 v0 = acc[ai][bj][m][0], v1 = acc[ai][bj][m][1];
                    u32x2v w; w.x = cvtpk(silu_f(v0[0]) * v0[1], silu_f(v0[2]) * v0[3]); w.y = cvtpk(silu_f(v1[0]) * v1[1], silu_f(v1[2]) * v1[3]);
                    *(GAS u32x2v*)(rowp + bj * 64) = w; } }
    }
};
struct EpiMoe2 {
    static constexpr bool PERM = true;
    const LAS int* cnt; const int* list; const float* wtok; bf16* YK;
    __device__ __forceinline__ void operator()(const f32x4 (&acc)[2][2][4][2], const Unit& u, int wr, int wc, int fr, int fq) const {
        const int n = cnt[u.e];
#pragma unroll
        for (int ai = 0; ai < 2; ++ai)
#pragma unroll
            for (int m = 0; m < 4; ++m) { const int slot = u.rt * 256 + ai * 128 + wr * 64 + m * 16 + fr;
                if (slot < n) { const int tk = ((const GAS int*)list)[u.e * LCAP + slot]; const float w8 = ((const GAS float*)wtok)[tk];
                    bf16* rowp = YK + (size_t)tk * DM + u.pn * 256 + wc * 32 + 8 * fq;
#pragma unroll
                    for (int bj = 0; bj < 2; ++bj) { const f32x4 v0 = acc[ai][bj][m][0] * w8, v1 = acc[ai][bj][m][1] * w8;
                        v4u w; w.x = cvtpk(v0[0], v0[1]); w.y = cvtpk(v0[2], v0[3]); w.z = cvtpk(v1[0], v1[1]); w.w = cvtpk(v1[2], v1[3]);
                        *(GAS v4u*)(rowp + bj * 128) = w; } } }
    }
};
template <int MODE> __device__ __forceinline__ int t_rowmap(int n) {
    if (MODE == 2) return 2 * n; if (MODE == 3) return 2 * n + 1;
    if (MODE == 1) { if (n >= 1536 && n < 3584) { const int q = n - 1536, d = q & 63; return 1536 + (q & ~63) + (d < 32 ? 2 * d : 2 * (d - 32) + 1); } return n; }
    return n; }
struct TrLoad { f32x4 v[16]; };
__device__ __forceinline__ void tr_load(TrLoad& t, const float* W, int ldw, int nblk  , int item, int lane) {
    const int kb = item / nblk, nb = item % nblk, k0 = 64 * kb, n0 = 64 * nb, lr = lane >> 4, lc = (lane & 15) * 4;
#pragma unroll
    for (int i = 0; i < 16; ++i) t.v[i] = *(const GAS f32x4*)(W + (size_t)(k0 + 4 * i + lr) * ldw + n0 + lc);
}
template <int MODE> __device__ __forceinline__ void tr_finish(const TrLoad& t, int nblk, bf16* WT, int dpitch, int dcol0, LAS float* scr, int item, int lane) {
    const int kb = item / nblk, nb = item % nblk, k0 = 64 * kb, n0 = 64 * nb, lr = lane >> 4, lc = (lane & 15) * 4;
#pragma unroll
    for (int i = 0; i < 16; ++i) { LAS float* d = scr + (4 * i + lr) * 65 + lc; d[0] = t.v[i][0]; d[1] = t.v[i][1]; d[2] = t.v[i][2]; d[3] = t.v[i][3]; }
    LDS_WAIT(); asm volatile("" ::: "memory");
    const int c = lane & 7;
#pragma unroll
    for (int j = 0; j < 8; ++j) { const int n = (lane >> 3) + 8 * j; const LAS float* s = scr + (8 * c) * 65 + n;
        v4u o; o.x = pk2(s[0 * 65], s[1 * 65]); o.y = pk2(s[2 * 65], s[3 * 65]); o.z = pk2(s[4 * 65], s[5 * 65]); o.w = pk2(s[6 * 65], s[7 * 65]);
        *(GAS v4u*)(WT + (size_t)t_rowmap<MODE>(n0 + n) * dpitch + dcol0 + k0 + 8 * c) = o; }
    LDS_WAIT(); asm volatile("" ::: "memory");
}
template <int MODE> __device__ __forceinline__ void transpose_item(const float* W, int ldw, int nblk, bf16* WT, int dpitch, int dcol0, LAS float* scr, int item, int lane) {
    TrLoad t; tr_load(t, W, ldw, nblk, item, lane); tr_finish<MODE>(t, nblk, WT, dpitch, dcol0, scr, item, lane);
}
__device__ __forceinline__ void convert_experts(Frame& F, int l, LAS float* scr) {
    const int gw = F.vcu * NWAVES + F.wave, NGW = F.G * NWAVES;
    bf16* WGU = (bf16*)(F.ws + WS_WGU); bf16* WD = (bf16*)(F.ws + WS_WD);
    for (int it = gw; it < NE * 768; it += NGW) { const int e = it / 768, r = it % 768;
        if (r < 256) transpose_item<2>(F.in[26] + (size_t)(l * NE + e) * DM * DE, DE, 8, WGU + (size_t)e * 1024 * DM, DM, 0, scr, r, F.lane);
        else if (r < 512) transpose_item<3>(F.in[27] + (size_t)(l * NE + e) * DM * DE, DE, 8, WGU + (size_t)e * 1024 * DM, DM, 0, scr, r - 256, F.lane);
        else transpose_item<0>(F.in[28] + (size_t)(l * NE + e) * DE * DM, DM, 32, WD + (size_t)e * DM * DE, DE, 0, scr, r - 512, F.lane); }
}
__device__ __forceinline__ void f32gemm_tile(const float* A, int lda, const float* B, int ldb, int Kd, int mb, int nb, int lane, f32x4 (&acc)[4]) {
    const int n = nb * 256 + lane * 4;
#pragma unroll
    for (int i = 0; i < 4; ++i) acc[i] = (f32x4){0.f, 0.f, 0.f, 0.f};
    const float* a0 = A + (size_t)(mb * 4) * lda;
#pragma unroll 8
    for (int k = 0; k < Kd; ++k) { const f32x4 b = *(const GAS f32x4*)(B + (size_t)k * ldb + n);
#pragma unroll
        for (int i = 0; i < 4; ++i) acc[i] += b * ((const GAS float*)a0)[(size_t)i * lda + k]; }
}

__device__ __forceinline__ void ph_prologue_a(Frame& F) {
    const int gw = F.vcu * NWAVES + F.wave, NGW = F.G * NWAVES;
    if (F.tid < 128) { float s_, c_; sincospif(2.0f * (float)F.tid / 128.0f, &s_, &c_); LAS float* cst = (LAS float*)(F.lds + LDSCTL_OFF + 2048); cst[F.tid] = c_; cst[128 + F.tid] = s_; }
    { LAS float* sil = (LAS float*)(F.lds + RING_OFF);
      for (int i = F.tid; i < 2 * DM; i += NWAVES * 64) { const float x = i < DM ? F.in[1][i] : F.in[3][i - DM]; sil[i] = silu_f(x); }
      __syncthreads();
      float* MODP = (float*)(F.ws + WS_T);
      for (int it = F.vcu; it < 64 * 12; it += F.G) { const int kc = it & 63, rest = it >> 6, l = rest / 6, jb = rest % 6, j = jb * 2048 + F.tid * 4;
          const float* W = F.in[4] + ((size_t)l * DM + kc * 32) * NMODV + j; f32x4 s0 = (f32x4){0.f, 0.f, 0.f, 0.f}, s1 = s0;
#pragma unroll 8
          for (int k = 0; k < 32; ++k) { const f32x4 w = *(const GAS f32x4*)(W + (size_t)k * NMODV); s0 += w * sil[kc * 32 + k]; s1 += w * sil[DM + kc * 32 + k]; }
          *(GAS f32x4*)(MODP + ((size_t)(kc * 2 + l) * 2 + 0) * NMODV + j) = s0; *(GAS f32x4*)(MODP + ((size_t)(kc * 2 + l) * 2 + 1) * NMODV + j) = s1; }
      __syncthreads(); }
    LAS float* scr = (LAS float*)(F.lds + RING_OFF + F.wave * 16896);
    for (int it = gw; it < 2 * 2304 + 2 * 512 + 2 * 512; it += NGW) {
        if (it < 4608) { const int l = it / 2304, r = it % 2304; transpose_item<1>(F.in[6] + (size_t)l * DM * DIN, DIN, 72, (bf16*)(F.ws + WS_WIN) + (size_t)l * DIN * DM, DM, 0, scr, r, F.lane); }
        else if (it < 5632) { const int q = it - 4608, l = q / 512, r = q % 512; transpose_item<0>(F.in[19] + (size_t)l * DM * DM + (size_t)1024 * DM, DM, 32, (bf16*)(F.ws + WS_WCAT) + (size_t)l * DM * MIXP, MIXP, 1536, scr, r, F.lane); }
        else { const int q = it - 5632, l = q / 512, r = q % 512; transpose_item<0>(F.in[19] + (size_t)l * DM * DM, DM, 32, (bf16*)(F.ws + WS_WOT) + (size_t)l * DM * 1024, 1024, 0, scr, r, F.lane); } }
    convert_experts(F, 0, scr);
    { const LAS float* cst = (const LAS float*)(F.lds + LDSCTL_OFF + 2048);
      for (int wt = gw; wt < 2 * 8 * 64; wt += NGW) { const int sel = wt >> 6, l = sel >> 3, part = (sel >> 2) & 1, g = sel & 3, r = wt & 63, mb = r >> 1, nb = r & 1;
          const float* B = F.in[8] + (size_t)l * 512 * 512 + (size_t)(128 * g) * 512; const int n = nb * 256 + F.lane * 4;
          f32x4 acc[4];
#pragma unroll
          for (int i = 0; i < 4; ++i) acc[i] = (f32x4){0.f, 0.f, 0.f, 0.f};
#pragma unroll 8
          for (int j = 0; j < 128; ++j) { const f32x4 b = *(const GAS f32x4*)(B + (size_t)j * 512 + n);
#pragma unroll
              for (int i = 0; i < 4; ++i) acc[i] += b * cst[part * 128 + (((mb * 4 + i) * j) & 127)]; }
          bf16* HB = (bf16*)(F.ws + WS_HB) + (size_t)l * 1024 * 512; const float sc = 0.08838834764831845f;
#pragma unroll
          for (int i = 0; i < 4; ++i) { u32x2v w; w.x = cvtpk(acc[i][0] * sc, acc[i][1] * sc); w.y = cvtpk(acc[i][2] * sc, acc[i][3] * sc);
              *(GAS u32x2v*)(HB + (size_t)(part * 512 + g * 128 + mb * 4 + i) * 512 + n) = w; } }
      const int gt = F.vcu * NWAVES * 64 + F.tid, NTH = F.G * NWAVES * 64;
      for (int idx = gt; idx < 2 * 512 * 512 / 4; idx += NTH) { const f32x4 v = *(const GAS f32x4*)(F.in[13] + (size_t)idx * 4);
          u32x2v w; w.x = cvtpk(v[0], v[1]); w.y = cvtpk(v[2], v[3]); *(GAS u32x2v*)((bf16*)(F.ws + WS_PWB) + (size_t)idx * 4) = w; } }
    { const int gt = F.vcu * NWAVES * 64 + F.tid, NT = F.G * NWAVES * 64;
      constexpr int R0 = 9216, R1 = R0 + 5120, R2 = R1 + 32768, R3 = R2 + 65536, R4 = R3 + 131072, R5 = R4 + 32768, R6 = R5 + 49152, R7 = R6 + 2;
      for (int idx = gt; idx < R7; idx += NT) {
          if (idx < R0) { const int l = idx / DIN, c = idx % DIN; int src = c;
              if (c >= 1536 && c < 3584) { const int q = c - 1536, p = q & 63; src = 1536 + (q & ~63) + (p & 1) * 32 + (p >> 1); }
              ((float*)(F.ws + WS_BINP))[idx] = F.in[7][l * DIN + src]; }
          else if (idx < R1) { const int q = idx - R0, t = q >> 4, i = q & 15, p = t < 256 ? t : t - 256;
              const float inv = 1.0f / powf(10000.0f, (float)i / 16.0f), ang = (float)p * inv; float s, c; sincosf(ang, &s, &c);
              ((f32x2v*)(F.ws + WS_ROPE))[q] = (f32x2v){c, s}; }
          else if (idx < R2) { const int q = idx - R1, np = q >> 7, a = q & 127, kk = np & 127; float s, c; sincospif(2.0f * (float)((a * kk) & 127) / 128.0f, &s, &c);
              ((bf16*)(F.ws + WS_BTA))[q] = bf1((np < 128 ? c : -s) * 0.08838834764831845f); }
          else if (idx < R3) { const int q = idx - R2, np = q >> 8, k = q & 255, khi = np & 127, b = k & 127; float s, c; sincospif(2.0f * (float)((b * khi) & 127) / 128.0f, &s, &c);
              const float v = np < 128 ? (k < 128 ? c : s) : (k < 128 ? -s : c); ((bf16*)(F.ws + WS_BTB))[q] = bf1(v * 0.08838834764831845f); }
          else if (idx < R4) { const int q = idx - R3, r = q >> 8, n = q & 255, k = r & 255; float s, c; sincospif(2.0f * (float)((k * n) & 255) / 256.0f, &s, &c);
              ((bf16*)(F.ws + WS_F256))[q] = bf1((r < 256 ? c : -s) * 0.0625f); }
          else if (idx < R5) { const int q = idx - R4, part = q >> 14, m = (q >> 7) & 127, j = q & 127; float s, c; sincospif(2.0f * (float)((m * j) & 127) / 128.0f, &s, &c);
              ((float*)(F.ws + WS_CS128))[q] = part ? s : c; }
          else if (idx < R6) { const int q = idx - R5, l = q / 24576, r = q % 24576, hl = r / 12288, r2 = r % 12288, ks = r2 / 192, nt = (r2 / 64) % 3, ln = r2 & 63;
              const int n = 16 * nt + (ln & 15), k0 = 32 * ks + 8 * (ln >> 4); unsigned short o[8];
#pragma unroll
              for (int j = 0; j < 8; ++j) { const int k = k0 + j; float w = 0.f;
                  if (n < 4) w = F.in[22][((size_t)l * DM + k) * 4 + n]; else if (n < 36) w = F.in[24][((size_t)l * DM + k) * 32 + (n - 4)];
                  const unsigned short h = bf1(w); o[j] = hl ? bf1(w - bf2f(h)) : h; }
              v4u w4; w4.x = o[0] | ((unsigned)o[1] << 16); w4.y = o[2] | ((unsigned)o[3] << 16); w4.z = o[4] | ((unsigned)o[5] << 16); w4.w = o[6] | ((unsigned)o[7] << 16);
              ((v4u*)(F.ws + WS_WRT))[q] = w4; }
          else { const int l = idx - R6; float a = 0.f, b = 0.f;
              for (int i = 0; i < 64; ++i) { a += F.in[14][l * 64 + i] * F.in[15][l * 64 + i]; b += F.in[16][l * 64 + i] * F.in[17][l * 64 + i]; }
              const float lam_init = 0.8f - 0.6f * expf(-0.3f * (float)l);
              ((float*)(F.ws + WS_LAMV))[l] = expf(a) - expf(b) + lam_init; }
      } }
}
__device__ __forceinline__ void ph_prologue_b(Frame& F) {
    const int gw = F.vcu * NWAVES + F.wave, NGW = F.G * NWAVES;
    { const int gt = F.vcu * NWAVES * 64 + F.tid, NT = F.G * NWAVES * 64; const float* MODP = (const float*)(F.ws + WS_T); float* MOD = (float*)(F.ws + WS_MOD);
      for (int idx = gt; idx < 4 * NMODV; idx += NT) { const int lv = idx / NMODV, j = idx % NMODV, l = lv >> 1; float s = F.in[5][l * NMODV + j];
          for (int kc = 0; kc < 64; ++kc) s += MODP[((size_t)kc * 4 + lv) * NMODV + j];
          MOD[idx] = s; } }
#pragma unroll 1
    for (int l = 0; l < DEPTH; ++l) {
        { pg8::Gemm g{(const bf16*)(F.ws + WS_WOT) + (size_t)l * DM * 1024, (const bf16*)(F.ws + WS_HB) + (size_t)l * 1024 * 512, 512, 1024};
          SchedNat S; S.go.init(8, 4, F.G, (int)((blockIdx.x + F.G - 48 * l) % F.G)); S.pmoff = 0; EpiFold E{(bf16*)(F.ws + WS_WCAT) + (size_t)l * DM * MIXP, 0};
          pg8::gemm_phase<EpiFold, SchedNat>(F.lds + RING_OFF, g, S, E); }
        { pg8::Gemm g{(const bf16*)(F.ws + WS_WOT) + (size_t)l * DM * 1024 + 512, (const bf16*)(F.ws + WS_PWB) + (size_t)l * 512 * 512, 512, 1024};
          SchedNat S; S.go.init(8, 2, F.G, (int)((blockIdx.x + F.G - 48 * l - 32) % F.G)); S.pmoff = 0; EpiFold E{(bf16*)(F.ws + WS_WCAT) + (size_t)l * DM * MIXP, 1024};
          pg8::gemm_phase<EpiFold, SchedNat>(F.lds + RING_OFF, g, S, E); } }
}

struct RowV { f32x4 v[8]; };
__device__ __forceinline__ void row_load(RowV& r, const float* p, int lane) {
#pragma unroll
    for (int j = 0; j < 4; ++j) { r.v[2 * j] = *(const GAS f32x4*)(p + 512 * j + 8 * lane); r.v[2 * j + 1] = *(const GAS f32x4*)(p + 512 * j + 8 * lane + 4); } }
__device__ __forceinline__ void row_load_bf16(RowV& r, const bf16* p, int lane) {
#pragma unroll
    for (int j = 0; j < 4; ++j) { const v4u d = *(const GAS v4u*)(p + 512 * j + 8 * lane);
        r.v[2 * j] = (f32x4){__uint_as_float(d.x << 16), __uint_as_float(d.x & 0xffff0000u), __uint_as_float(d.y << 16), __uint_as_float(d.y & 0xffff0000u)};
        r.v[2 * j + 1] = (f32x4){__uint_as_float(d.z << 16), __uint_as_float(d.z & 0xffff0000u), __uint_as_float(d.w << 16), __uint_as_float(d.w & 0xffff0000u)}; } }
__device__ __forceinline__ void row_store(const RowV& r, float* p, int lane) {
#pragma unroll
    for (int j = 0; j < 4; ++j) { *(GAS f32x4*)(p + 512 * j + 8 * lane) = r.v[2 * j]; *(GAS f32x4*)(p + 512 * j + 8 * lane + 4) = r.v[2 * j + 1]; } }
__device__ __forceinline__ void row_norm(RowV& r) {
    float s = 0.f;
#pragma unroll
    for (int i = 0; i < 8; ++i) s += (r.v[i][0] + r.v[i][1]) + (r.v[i][2] + r.v[i][3]);
    const float mean = wave_sum(s) * (1.f / DM); float q = 0.f;
#pragma unroll
    for (int i = 0; i < 8; ++i) { r.v[i] = r.v[i] - mean; q += (r.v[i][0] * r.v[i][0] + r.v[i][1] * r.v[i][1]) + (r.v[i][2] * r.v[i][2] + r.v[i][3] * r.v[i][3]); }
    const float rstd = 1.f / sqrtf(wave_sum(q) * (1.f / DM) + LN_EPS);
#pragma unroll
    for (int i = 0; i < 8; ++i) r.v[i] = r.v[i] * rstd; }
__device__ __forceinline__ void row_affine(RowV& r, const float* mulp, float madd, const float* addp, int lane) {
#pragma unroll
    for (int j = 0; j < 4; ++j)
#pragma unroll
        for (int h = 0; h < 2; ++h) { const f32x4 m = *(const GAS f32x4*)(mulp + 512 * j + 8 * lane + 4 * h), a = *(const GAS f32x4*)(addp + 512 * j + 8 * lane + 4 * h);
            r.v[2 * j + h] = r.v[2 * j + h] * (m + madd) + a; } }
__device__ __forceinline__ void row_store_bf16(const RowV& r, bf16* p, int lane) {
#pragma unroll
    for (int j = 0; j < 4; ++j) { v4u w; w.x = cvtpk(r.v[2 * j][0], r.v[2 * j][1]); w.y = cvtpk(r.v[2 * j][2], r.v[2 * j][3]); w.z = cvtpk(r.v[2 * j + 1][0], r.v[2 * j + 1][1]); w.w = cvtpk(r.v[2 * j + 1][2], r.v[2 * j + 1][3]);
        *(GAS v4u*)(p + 512 * j + 8 * lane) = w; } }

__device__ __forceinline__ void ph_ln1(Frame& F, int l, const float* xc, const float* xl) {
    const int gw = F.vcu * NWAVES + F.wave, NGW = F.G * NWAVES; const float* MOD = (const float*)(F.ws + WS_MOD) + (size_t)l * 2 * NMODV; bf16* XN = (bf16*)(F.ws + WS_XN);
    for (int r = gw; r < ROWS; r += NGW) { const float* xp = r < CTXL ? xc + (size_t)r * DM : xl + (size_t)(r - CTXL) * DM; const float* mp = MOD + (r < CTXL ? NMODV : 0);
        RowV v; row_load(v, xp, F.lane); row_norm(v); row_affine(v, mp + DM, 1.f, mp, F.lane); row_store_bf16(v, XN + (size_t)r * DM, F.lane); }
}

__device__ __forceinline__ void conv_unit(Frame& F, int l, int ub) {
    const int row0 = 32 * ub, lo = row0 < CTXL ? 0 : CTXL, hi = row0 < CTXL ? CTXL : ROWS;
    const bf16* AG = (const bf16*)(F.ws + WS_AG); bf16* MIX = (bf16*)(F.ws + WS_MIX);
    LAS bf16* U = (LAS bf16*)(F.lds + RING_OFF);
    LAS float* Y = (LAS float*)(F.lds + RING_OFF + 65536);
    for (int it = F.tid; it < 62 * 64; it += NWAVES * 64) { const int t = it >> 6, c8 = (it & 63) * 8, gr = row0 - 15 + t;
        v4u o = (v4u){0u, 0u, 0u, 0u};
        if (gr >= lo && gr < hi) { const v4u a = *(const GAS v4u*)(AG + (size_t)gr * 1024 + c8), g = *(const GAS v4u*)(AG + (size_t)gr * 1024 + 512 + c8);
            const unsigned aw[4] = {a.x, a.y, a.z, a.w}, gw[4] = {g.x, g.y, g.z, g.w}; unsigned ow[4];
#pragma unroll
            for (int q = 0; q < 4; ++q) { const float a0 = __uint_as_float(aw[q] << 16), a1 = __uint_as_float(aw[q] & 0xffff0000u), g0 = __uint_as_float(gw[q] << 16), g1 = __uint_as_float(gw[q] & 0xffff0000u);
                ow[q] = cvtpk(a0 / (1.f + __expf(-g0)), a1 / (1.f + __expf(-g1))); }
            o = (v4u){ow[0], ow[1], ow[2], ow[3]}; }
        *(LAS v4u*)(U + t * 512 + c8) = o; }
    __syncthreads();
    { const int c = F.tid; float w[31];
#pragma unroll
      for (int j = 0; j < 31; ++j) w[j] = ((const GAS float*)F.in[9])[((size_t)l * 31 + j) * 512 + c];
      const float cb = F.in[10][l * 512 + c];
#pragma unroll
      for (int half = 0; half < 2; ++half) { float u[46];
#pragma unroll
          for (int t = 0; t < 46; ++t) u[t] = bf2f(U[(half * 16 + t) * 512 + c]);
#pragma unroll
          for (int n = 0; n < 16; ++n) { float s = cb;
#pragma unroll
              for (int j = 0; j < 31; ++j) s += u[n + j] * w[j];
              Y[(half * 16 + n) * 512 + c] = s; } } }
    __syncthreads();
    { const float* lg = F.in[11] + l * 512 + 8 * F.lane; const float* lb = F.in[12] + l * 512 + 8 * F.lane;
      const f32x4 g0 = *(const f32x4*)lg, g1 = *(const GAS f32x4*)(lg + 4), b0 = *(const f32x4*)lb, b1 = *(const GAS f32x4*)(lb + 4);
#pragma unroll
      for (int i = 0; i < 4; ++i) { const int n = 4 * F.wave + i; f32x4 y0 = *(LAS f32x4*)(Y + n * 512 + 8 * F.lane), y1 = *(LAS f32x4*)(Y + n * 512 + 8 * F.lane + 4);
          const float mean = wave_sum((y0[0] + y0[1]) + (y0[2] + y0[3]) + (y1[0] + y1[1]) + (y1[2] + y1[3])) * (1.f / 512.f);
          y0 = y0 - mean; y1 = y1 - mean;
          const float var = wave_sum((y0[0] * y0[0] + y0[1] * y0[1]) + (y0[2] * y0[2] + y0[3] * y0[3]) + (y1[0] * y1[0] + y1[1] * y1[1]) + (y1[2] * y1[2] + y1[3] * y1[3])) * (1.f / 512.f);
          const float rstd = 1.f / sqrtf(var + LN_EPS);
          y0 = y0 * rstd * g0 + b0; y1 = y1 * rstd * g1 + b1;
          v4u w4; w4.x = cvtpk(silu_f(y0[0]), silu_f(y0[1])); w4.y = cvtpk(silu_f(y0[2]), silu_f(y0[3])); w4.z = cvtpk(silu_f(y1[0]), silu_f(y1[1])); w4.w = cvtpk(silu_f(y1[2]), silu_f(y1[3]));
          *(GAS v4u*)(MIX + (size_t)(row0 + n) * MIXP + 1024 + 8 * F.lane) = w4; } }
    __syncthreads();
}
constexpr int HP = DM + 8;
template <bool XBF> __device__ __forceinline__ void ph_ln_router(Frame& F, int l, const void* xcv, const void* xlv) {
    const float* MOD = (const float*)(F.ws + WS_MOD) + (size_t)l * 2 * NMODV; bf16* T = (bf16*)(F.ws + WS_T); bf16* XN = (bf16*)(F.ws + WS_XN); const bf16* DMX = (const bf16*)(F.ws + WS_DMIX);
    const float* ga = F.in[20] + (size_t)l * DM; const float* ba = F.in[21] + (size_t)l * DM;
    const v4u* WRT = (const v4u*)(F.ws + WS_WRT) + (size_t)l * 24576;
    int* LIST = (int*)(F.ws + WS_LIST) + (size_t)l * NE * LCAP; float* WTOK = (float*)(F.ws + WS_WTOK) + (size_t)l * 2 * ROWS;
    LAS bf16* HHI = (LAS bf16*)(F.lds + RING_OFF); LAS bf16* HLO = HHI + 16 * HP;
    LAS float* PART = (LAS float*)(F.lds + RING_OFF);
    LAS float* LOGI = (LAS float*)(F.lds + RING_OFF + 32768);
    const int fr = F.lane & 15, fq = F.lane >> 4;
    const int blk0 = (l + 1 < DEPTH) ? 0 : CTXL / 16;
    for (int blk = blk0 + F.vcu; blk < ROWS / 16; blk += F.G) {
        RowV vv[2];
#pragma unroll
        for (int i = 0; i < 2; ++i) { const int r = blk * 16 + 2 * F.wave + i;
            if (XBF) row_load_bf16(vv[i], r < CTXL ? (const bf16*)xcv + (size_t)r * DM : (const bf16*)xlv + (size_t)(r - CTXL) * DM, F.lane);
            else row_load(vv[i], r < CTXL ? (const float*)xcv + (size_t)r * DM : (const float*)xlv + (size_t)(r - CTXL) * DM, F.lane);
#pragma unroll
            for (int j = 0; j < 4; ++j) { const v4u d = *(const GAS v4u*)(DMX + (size_t)r * DM + 512 * j + 8 * F.lane);
                vv[i].v[2 * j] = vv[i].v[2 * j] * ALPHA + (f32x4){__uint_as_float(d.x << 16), __uint_as_float(d.x & 0xffff0000u), __uint_as_float(d.y << 16), __uint_as_float(d.y & 0xffff0000u)};
                vv[i].v[2 * j + 1] = vv[i].v[2 * j + 1] * ALPHA + (f32x4){__uint_as_float(d.z << 16), __uint_as_float(d.z & 0xffff0000u), __uint_as_float(d.w << 16), __uint_as_float(d.w & 0xffff0000u)}; } }
#pragma unroll
        for (int i = 0; i < 2; ++i) { const int rl = 2 * F.wave + i, r = blk * 16 + rl; const float* mp = MOD + (r < CTXL ? NMODV : 0);
            RowV& v = vv[i]; row_norm(v); row_affine(v, ga, 0.f, ba, F.lane); row_store_bf16(v, T + (size_t)r * DM, F.lane);
            row_norm(v); row_affine(v, mp + 4 * DM, 1.f, mp + 3 * DM, F.lane);
#pragma unroll
            for (int j = 0; j < 4; ++j) { unsigned hw[4], lw[4];
#pragma unroll
                for (int q = 0; q < 4; ++q) { const float a = v.v[2 * j + (q >> 1)][(q & 1) * 2], b = v.v[2 * j + (q >> 1)][(q & 1) * 2 + 1];
                    const unsigned h = cvtpk(a, b); hw[q] = h; lw[q] = cvtpk(a - __uint_as_float(h << 16), b - __uint_as_float(h & 0xffff0000u)); }
                const v4u h4 = (v4u){hw[0], hw[1], hw[2], hw[3]}, l4 = (v4u){lw[0], lw[1], lw[2], lw[3]};
                *(GAS v4u*)(XN + (size_t)r * DM + 512 * j + 8 * F.lane) = h4;
                *(LAS v4u*)(HHI + rl * HP + 512 * j + 8 * F.lane) = h4; *(LAS v4u*)(HLO + rl * HP + 512 * j + 8 * F.lane) = l4; } }
        __syncthreads();
        f32x4 acc[3];
#pragma unroll
        for (int n = 0; n < 3; ++n) acc[n] = (f32x4){0.f, 0.f, 0.f, 0.f};
#pragma unroll 2
        for (int s = 0; s < 8; ++s) { const int ks = 8 * F.wave + s;
            const bf16x8 xh = *(const LAS bf16x8*)(HHI + fr * HP + ks * 32 + fq * 8), xl = *(const LAS bf16x8*)(HLO + fr * HP + ks * 32 + fq * 8);
#pragma unroll
            for (int n = 0; n < 3; ++n) { const v4u wh4 = ((const GAS v4u*)WRT)[((size_t)(0 * 64 + ks) * 3 + n) * 64 + F.lane], wl4 = ((const GAS v4u*)WRT)[((size_t)(1 * 64 + ks) * 3 + n) * 64 + F.lane];
                const bf16x8 wh = __builtin_bit_cast(bf16x8, wh4), wl = __builtin_bit_cast(bf16x8, wl4);
                acc[n] = __builtin_amdgcn_mfma_f32_16x16x32_bf16(wh, xh, acc[n], 0, 0, 0);
                acc[n] = __builtin_amdgcn_mfma_f32_16x16x32_bf16(wh, xl, acc[n], 0, 0, 0);
                acc[n] = __builtin_amdgcn_mfma_f32_16x16x32_bf16(wl, xh, acc[n], 0, 0, 0); } }
        __syncthreads();
#pragma unroll
        for (int n = 0; n < 3; ++n)
#pragma unroll
            for (int i = 0; i < 4; ++i) PART[(F.wave * 16 + fr) * 48 + 16 * n + 4 * fq + i] = acc[n][i];
        __syncthreads();
        for (int t = F.tid; t < 16 * 36; t += NWAVES * 64) { const int m = t / 36, n = t % 36; float s = n < 4 ? F.in[23][l * 4 + n] : F.in[25][l * 32 + (n - 4)];
#pragma unroll
            for (int w = 0; w < 8; ++w) s += PART[(w * 16 + m) * 48 + n];
            LOGI[m * 36 + n] = s; }
        __syncthreads();
        if (F.tid < 16) { const int r = blk * 16 + F.tid; const LAS float* lg = LOGI + F.tid * 36;
            int gi = 0; float gm = lg[0];
#pragma unroll
            for (int j = 1; j < 4; ++j) if (lg[j] > gm) { gm = lg[j]; gi = j; }
            float gs = 0.f;
#pragma unroll
            for (int j = 0; j < 4; ++j) gs += __expf(lg[j] - gm);
            const float wg = 1.f / gs;
            const LAS float* le = lg + 4 + gi * 8; int i1 = 0; float m1 = le[0];
#pragma unroll
            for (int j = 1; j < 8; ++j) if (le[j] > m1) { m1 = le[j]; i1 = j; }
            int i2 = -1; float m2 = -3.0e38f;
#pragma unroll
            for (int j = 0; j < 8; ++j) if (j != i1 && le[j] > m2) { m2 = le[j]; i2 = j; }
            const float e2 = __expf(m2 - m1), w1 = wg / (1.f + e2), w2 = wg * e2 / (1.f + e2);
            const int ea = gi * 8 + i1, eb = gi * 8 + i2;
            const int sa = (int)__hip_atomic_fetch_add(F.ctl + CW_CNT + (l * NE + ea) * 64, 1u, RLX_AGENT), sb = (int)__hip_atomic_fetch_add(F.ctl + CW_CNT + (l * NE + eb) * 64, 1u, RLX_AGENT);
            ((GAS int*)LIST)[ea * LCAP + sa] = r * 2; ((GAS int*)LIST)[eb * LCAP + sb] = r * 2 + 1; ((GAS float*)WTOK)[r * 2] = w1; ((GAS float*)WTOK)[r * 2 + 1] = w2; }
        __syncthreads();
    }
}
__device__ __forceinline__ void moe_setup(Frame& F, int l, LAS int* tstart, LAS int* cnt) {
    if (F.tid < NE) cnt[F.tid] = (int)__hip_atomic_load(F.ctl + CW_CNT + (l * NE + F.tid) * 64, RLX_AGENT);
    __syncthreads();
    if (F.tid == 0) { int s = 0; for (int e = 0; e < NE; ++e) { tstart[e] = s; s += (cnt[e] + 255) >> 8; } tstart[NE] = s; }
    __syncthreads();
}
template <bool FUSE_NEXT> __device__ __forceinline__ void ph_ln_final(Frame& F, int l, void* outcv, void* outlv) {
    const int gw = F.vcu * NWAVES + F.wave, NGW = F.G * NWAVES;
    const float* MOD = (const float*)(F.ws + WS_MOD) + (size_t)l * 2 * NMODV; const bf16* X1 = (const bf16*)(F.ws + WS_T); const bf16* YK = (const bf16*)(F.ws + WS_YK);
    const float* gf = F.in[29] + (size_t)l * DM; const float* bfp = F.in[30] + (size_t)l * DM;
    for (int r = gw; r < ROWS; r += NGW) { if (r < CTXL && outcv == nullptr) continue;
        const float* mp = MOD + (r < CTXL ? NMODV : 0) + 5 * DM;
        RowV v; row_load_bf16(v, X1 + (size_t)r * DM, F.lane);
#pragma unroll
        for (int j = 0; j < 4; ++j) { const v4u a = *(const GAS v4u*)(YK + (size_t)(2 * r) * DM + 512 * j + 8 * F.lane), b = *(const GAS v4u*)(YK + (size_t)(2 * r + 1) * DM + 512 * j + 8 * F.lane);
            const f32x4 g0 = *(const GAS f32x4*)(mp + 512 * j + 8 * F.lane), g1 = *(const GAS f32x4*)(mp + 512 * j + 8 * F.lane + 4);
            const f32x4 y0 = (f32x4){__uint_as_float(a.x << 16) + __uint_as_float(b.x << 16), __uint_as_float(a.x & 0xffff0000u) + __uint_as_float(b.x & 0xffff0000u),
                                     __uint_as_float(a.y << 16) + __uint_as_float(b.y << 16), __uint_as_float(a.y & 0xffff0000u) + __uint_as_float(b.y & 0xffff0000u)};
            const f32x4 y1 = (f32x4){__uint_as_float(a.z << 16) + __uint_as_float(b.z << 16), __uint_as_float(a.z & 0xffff0000u) + __uint_as_float(b.z & 0xffff0000u),
                                     __uint_as_float(a.w << 16) + __uint_as_float(b.w << 16), __uint_as_float(a.w & 0xffff0000u) + __uint_as_float(b.w & 0xffff0000u)};
            v.v[2 * j] = v.v[2 * j] * ALPHA + g0 * y0; v.v[2 * j + 1] = v.v[2 * j + 1] * ALPHA + g1 * y1; }
        row_norm(v); row_affine(v, gf, 0.f, bfp, F.lane);
#ifdef TPROBE
        if (!FUSE_NEXT) { const float tsc_ = 1.f + *(const volatile float*)&g_tprobe;
#pragma unroll
            for (int q = 0; q < 8; ++q) v.v[q] = v.v[q] * tsc_; }
#endif
        if (FUSE_NEXT) row_store_bf16(v, r < CTXL ? (bf16*)outcv + (size_t)r * DM : (bf16*)outlv + (size_t)(r - CTXL) * DM, F.lane);
        else row_store(v, r < CTXL ? (float*)outcv + (size_t)r * DM : (float*)outlv + (size_t)(r - CTXL) * DM, F.lane);
        if (FUSE_NEXT) { const float* mn = (const float*)(F.ws + WS_MOD) + (size_t)(l + 1) * 2 * NMODV + (r < CTXL ? NMODV : 0);
            row_norm(v); row_affine(v, mn + DM, 1.f, mn, F.lane); row_store_bf16(v, (bf16*)(F.ws + WS_XN) + (size_t)r * DM, F.lane); } }
}

#ifndef MK_ONE_LAUNCH
#define MK_ONE_LAUNCH 0
#endif
struct Args { const float* in[NIN]; float* out; unsigned char* ws; int ph_lo, ph_hi, pad0, pad1; };
__global__ void __launch_bounds__(NWAVES * 64, 2) mk_fwd(Args args) {
    extern __shared__ __attribute__((aligned(16))) unsigned char lds[];
    Frame F;
    F.lds = (LAS unsigned char*)lds;
    F.MISC = (volatile LAS unsigned*)(F.lds + MISC_OFF);
    F.tid = threadIdx.x; F.lane = F.tid & 63; F.wave = __builtin_amdgcn_readfirstlane(F.tid >> 6);
    F.G = gridDim.x; { const int bx = blockIdx.x; F.vcu = (F.G % 8 == 0) ? (bx % 8) * (F.G / 8) + bx / 8 : bx; }
    F.ws = args.ws; F.out = args.out; F.ctl = (gu32*)(args.ws + WS_CTL);
    F.in = args.in;
    for (int u = F.tid; u < (LDS_BYTES - LDSCTL_OFF) / 4; u += NWAVES * 64) ((LAS unsigned*)(F.lds + LDSCTL_OFF))[u] = 0u;
    __syncthreads();
#if MK_ONE_LAUNCH
    XcdBarrier bar = xcd_barrier_post((unsigned*)(F.ctl + CW_BAR), F.MISC + 8);
#define GRID_BAR() xcd_barrier(bar)
#else
#define GRID_BAR() do { } while (0)
#endif
    const int lo = args.ph_lo, hi = args.ph_hi;
#ifdef ONLY_REL
#define IN(k) (lo <= (k) && (k) < hi && ((k) < 2 ? (k) == ONLY_REL - 100 : ((k) - 2) % 9 == ONLY_REL))
#else
#define IN(k) (lo <= (k) && (k) < hi)
#endif
#ifndef REPEAT_REL
#define REPEAT_REL -1
#endif
#ifndef REPEAT_N
#define REPEAT_N 2
#endif
#ifndef REPEAT_MASK
#define REPEAT_MASK 0
#endif
#define REP(r) for (int rep_ = 0; rep_ < (((r) == REPEAT_REL || ((r) < 32 && ((REPEAT_MASK >> (r)) & 1))) ? REPEAT_N : 1); ++rep_)
#ifdef PROBE_PHASE
#ifndef PROBE_MULT
#define PROBE_MULT 3
#endif
    unsigned long long tprev_ = __builtin_amdgcn_s_memrealtime();
#define SEAM(k) do { if (IN(k) && IN((k) + 1)) { GRID_BAR(); const unsigned long long tn_ = __builtin_amdgcn_s_memrealtime(); \
        if ((k) == PROBE_PHASE) { const unsigned long long until_ = tn_ + PROBE_MULT * (tn_ - tprev_); while (__builtin_amdgcn_s_memrealtime() < until_) __builtin_amdgcn_s_sleep(8); } \
        tprev_ = __builtin_amdgcn_s_memrealtime(); } } while (0)
#else
#define SEAM(k) do { if (IN(k) && IN((k) + 1)) GRID_BAR(); } while (0)
#endif
#define PHASE_BEGIN() do { unsigned char* w_ = args.ws; float* o_ = args.out; asm volatile("" : "+s"(w_), "+s"(o_)); F.ws = w_; F.out = o_; F.ctl = (gu32*)(w_ + WS_CTL); \
        int t_ = threadIdx.x; asm volatile("" : "+v"(t_)); F.tid = t_; F.lane = t_ & 63; F.wave = __builtin_amdgcn_readfirstlane(t_ >> 6); } while (0)
    LAS int* tstart = (LAS int*)(F.lds + LDSCTL_OFF); LAS int* ecnt = (LAS int*)(F.lds + LDSCTL_OFF + 136);
    char* ldsg = (char*)lds + RING_OFF;

    if (IN(0)) REP(100) { PHASE_BEGIN(); ph_prologue_a(F); } SEAM(0);
    if (IN(1)) REP(101) { PHASE_BEGIN(); ph_prologue_b(F); } SEAM(1);
#pragma unroll 1
    for (int l = 0; l < DEPTH; ++l) {
        const int P = 2 + 9 * l;
        const float* xc = F.in[2]; const float* xl = F.in[0];
        const float* MODL = (const float*)(F.ws + WS_MOD) + (size_t)l * 2 * NMODV;
        if (l == 0) { if (IN(P + 0)) REP(0) { PHASE_BEGIN(); ph_ln1(F, l, xc, xl); } SEAM(P + 0); }
        if (IN(P + 1)) REP(1) { PHASE_BEGIN();
            pg8::Gemm g{(const bf16*)(F.ws + WS_XN), (const bf16*)(F.ws + WS_WIN) + (size_t)l * DIN * DM, DM, DM};
            SchedWin S; S.go.init(NMT, DIN / 256, F.G, (int)blockIdx.x);
            EpiWin E{(bf16*)(F.ws + WS_UF), (bf16*)(F.ws + WS_UFC), (bf16*)(F.ws + WS_AG), (bf16*)(F.ws + WS_Q), (bf16*)(F.ws + WS_K), (bf16*)(F.ws + WS_V),
                     (const float*)(F.ws + WS_BINP) + l * DIN, (const f32x2v*)(F.ws + WS_ROPE)};
            pg8::gemm_phase<EpiWin, SchedWin>(F.lds + RING_OFF, g, S, E);
        } SEAM(P + 1);
        if (IN(P + 2)) REP(2) { PHASE_BEGIN();
            attn::Tensors AT{(const bf16*)(F.ws + WS_Q), (const bf16*)(F.ws + WS_K), (const bf16*)(F.ws + WS_V), (bf16*)(F.ws + WS_MIX),
                             (float*)(F.ws + WS_O2N) + (size_t)blockIdx.x * 64 * 512, F.in[18] + l * 128, ((const float*)(F.ws + WS_LAMV))[l], 1.f - (0.8f - 0.6f * expf(-0.3f * (float)l))};
#ifndef NO_ATT
#ifndef REPEAT_ATT_N
#define REPEAT_ATT_N 1
#endif
            for (int u = F.vcu; u < 512 * REPEAT_ATT_N; u += F.G) attn::attn_unit<true>((u & 511) >> 6, 256 * (1 + (u & 63)), ROWS / 64, AT, ldsg);
            for (int u = F.vcu; u < 8; u += F.G) attn::attn_unit<false>(u, 0, CTXL / 64, AT, ldsg);
#endif
#ifndef NO_CONV
#ifndef REPEAT_CONV_N
#define REPEAT_CONV_N 1
#endif
            for (int u = F.vcu; u < (ROWS / 32) * REPEAT_CONV_N; u += F.G) conv_unit(F, l, u % (ROWS / 32));
#endif
#ifndef NO_FA
            { pg8::Gemm g{(const bf16*)(F.ws + WS_UF), (const bf16*)(F.ws + WS_BTA), 128, 128};
#ifndef REPEAT_FA_N
#define REPEAT_FA_N 1
#endif
              SchedFA S; S.go.init(256 * REPEAT_FA_N, 1, F.G, (int)blockIdx.x); EpiFA E{(bf16*)(F.ws + WS_PF2)};
#ifndef REPEAT_FA_N
#define REPEAT_FA_N 1
#endif
              pg8::gemm_phase<EpiFA, SchedFA>(F.lds + RING_OFF, g, S, E); }
#endif
#ifndef NO_CTXF
            { pg8::Gemm g{(const bf16*)(F.ws + WS_F256), (const bf16*)(F.ws + WS_UFC), 256, 256};
              SchedNat S; S.go.init(2, 2, F.G, (int)((blockIdx.x + 128) % F.G)); S.pmoff = 0; EpiCtxF E{(bf16*)(F.ws + WS_MIX)};
              pg8::gemm_phase<EpiCtxF, SchedNat>(F.lds + RING_OFF, g, S, E); }
#endif
        } SEAM(P + 2);
        if (IN(P + 3)) REP(3) { PHASE_BEGIN();
            pg8::Gemm g{(const bf16*)(F.ws + WS_PF2), (const bf16*)(F.ws + WS_BTB), 256, 256};
            SchedFB S; S.go.init(256, 1, F.G, (int)blockIdx.x); EpiFB E{(bf16*)(F.ws + WS_MIX)};
            pg8::gemm_phase<EpiFB, SchedFB>(F.lds + RING_OFF, g, S, E);
            if (l + 1 < DEPTH) {
                pg8::Gemm g2{(const bf16*)(F.ws + WS_MIX), (const bf16*)(F.ws + WS_WCAT) + (size_t)l * DM * MIXP, MIXP, MIXP};
                SchedNat S2; S2.go.init(1, DM / 256, F.G, (int)((blockIdx.x + 96) % F.G)); S2.pmoff = 0; EpiWout E2{MODL, (bf16*)(F.ws + WS_DMIX)};
                pg8::gemm_phase<EpiWout, SchedNat>(F.lds + RING_OFF, g2, S2, E2); }
        } SEAM(P + 3);
        if (IN(P + 4)) REP(4) { PHASE_BEGIN();
            pg8::Gemm g{(const bf16*)(F.ws + WS_MIX), (const bf16*)(F.ws + WS_WCAT) + (size_t)l * DM * MIXP, MIXP, MIXP};
            SchedNat S; S.go.init(NMT - 1, DM / 256, F.G, (int)blockIdx.x); S.pmoff = 1; EpiWout E{MODL, (bf16*)(F.ws + WS_DMIX)};
            pg8::gemm_phase<EpiWout, SchedNat>(F.lds + RING_OFF, g, S, E);
        } SEAM(P + 4);
        if (IN(P + 5)) REP(5) { PHASE_BEGIN(); if (l == 0) ph_ln_router<false>(F, l, xc, xl); else ph_ln_router<true>(F, l, F.ws + WS_X2, (bf16*)(F.ws + WS_X2) + (size_t)CTXL * DM); } SEAM(P + 5);
        if (IN(P + 6)) REP(6) { PHASE_BEGIN();
            moe_setup(F, l, tstart, ecnt);
            pg8::Gemm g{(const bf16*)(F.ws + WS_XN), (const bf16*)(F.ws + WS_WGU), DM, DM};
            SchedMoe<1> S{tstart, ecnt, (const int*)(F.ws + WS_LIST) + (size_t)l * NE * LCAP, F.G, (int)F.vcu}; EpiMoe1 E{(bf16*)(F.ws + WS_ACT)};
            pg8::gemm_phase<EpiMoe1, SchedMoe<1>>(F.lds + RING_OFF, g, S, E);
        } SEAM(P + 6);
        if (IN(P + 7)) REP(7) { PHASE_BEGIN();
            moe_setup(F, l, tstart, ecnt);
            pg8::Gemm g{(const bf16*)(F.ws + WS_ACT), (const bf16*)(F.ws + WS_WD), DE, DE};
            SchedMoe<2> S{tstart, ecnt, (const int*)(F.ws + WS_LIST) + (size_t)l * NE * LCAP, F.G, (int)F.vcu};
            EpiMoe2 E{ecnt, (const int*)(F.ws + WS_LIST) + (size_t)l * NE * LCAP, (const float*)(F.ws + WS_WTOK) + (size_t)l * 2 * ROWS, (bf16*)(F.ws + WS_YK)};
            pg8::gemm_phase<EpiMoe2, SchedMoe<2>>(F.lds + RING_OFF, g, S, E);
        } SEAM(P + 7);
        if (IN(P + 8)) REP(8) { PHASE_BEGIN();
            if (l == 0) { ph_ln_final<true>(F, l, F.ws + WS_X2, (bf16*)(F.ws + WS_X2) + (size_t)CTXL * DM);
                          convert_experts(F, 1, (LAS float*)(F.lds + RING_OFF + F.wave * 16896)); }
            else ph_ln_final<false>(F, l, nullptr, F.out);
        }
        if (l + 1 < DEPTH) SEAM(P + 8);
    }
#undef IN
#undef SEAM
}

extern "C" void kernel_launch(void* const* d_in, const int* in_sizes, int n_in, void* d_out, int out_size, void* d_ws, size_t ws_size, hipStream_t stream) {
    static int grid = 0;
    if (grid == 0) {
        if (n_in != NIN || in_sizes[0] != SEQ * DM || out_size != SEQ * DM || ws_size < WS_END) { fprintf(stderr, "kernel_launch: shape mismatch (n_in %d, in0 %d, out %d, ws %zu < %zu?)\n", n_in, n_in > 0 ? in_sizes[0] : -1, out_size, ws_size, (size_t)WS_END); grid = -1; return; }
        int dev = 0, cus = 0, per_cu = 0;
        if (hipGetDevice(&dev) != hipSuccess || hipDeviceGetAttribute(&cus, hipDeviceAttributeMultiprocessorCount, dev) != hipSuccess) { grid = -1; return; }
        if (hipFuncSetAttribute((const void*)mk_fwd, hipFuncAttributeMaxDynamicSharedMemorySize, LDS_BYTES) != hipSuccess) { fprintf(stderr, "kernel_launch: hipFuncSetAttribute failed\n"); grid = -1; return; }
        if (hipOccupancyMaxActiveBlocksPerMultiprocessor(&per_cu, (const void*)mk_fwd, NWAVES * 64, LDS_BYTES) != hipSuccess || per_cu < 1)
            fprintf(stderr, "kernel_launch: note: occupancy query reports %d workgroups per CU\n", per_cu);
        (void)hipGetLastError();
        grid = cus;
        if (grid > 256) grid = 256;
    }
    if (grid < 0) return;
    if (hipMemsetAsync((char*)d_ws + WS_CTL, 0, CTL_ZERO_BYTES, stream) != hipSuccess) { fprintf(stderr, "kernel_launch: memset failed\n"); return; }
    Args a{};
    for (int i = 0; i < NIN; ++i) a.in[i] = (const float*)d_in[i];
    a.out = (float*)d_out; a.ws = (unsigned char*)d_ws;
#if MK_ONE_LAUNCH
    a.ph_lo = 0; a.ph_hi = NPH;
    hipLaunchKernelGGL(mk_fwd, dim3(grid), dim3(NWAVES * 64), LDS_BYTES, stream, a);
#else
    for (int p = 0; p < NPH; ++p) { a.ph_lo = p; a.ph_hi = p + 1; hipLaunchKernelGGL(mk_fwd, dim3(grid), dim3(NWAVES * 64), LDS_BYTES, stream, a); }
#endif
    const hipError_t le = hipPeekAtLastError();
    if (le != hipSuccess) fprintf(stderr, "kernel_launch: launch failed: %s\n", hipGetErrorName(le));
}
```

```cpp
#include <hip/hip_runtime.h>
#include <cstdio>
#include <cstdint>
#include <cmath>
#ifndef MK_ONE_LAUNCH
#define MK_ONE_LAUNCH 1
#endif
namespace pg8 {
#define PG8_LAS __attribute__((address_space(3)))
typedef unsigned short bf16_t;
typedef short bf16x8 __attribute__((ext_vector_type(8)));
typedef float f32x4 __attribute__((ext_vector_type(4)));
typedef float f32x2 __attribute__((ext_vector_type(2)));
typedef unsigned u32x4 __attribute__((ext_vector_type(4)));
typedef unsigned u32x2 __attribute__((ext_vector_type(2)));
constexpr int BM = 256, BK = 64, HALF = 128, HTB = HALF * BK * 2  , STAGE_BYTES = 8 * HTB, NXCD = 8, WGM = 8;

__host__ __device__ __forceinline__ int lds_byte(int r, int c) { const int st = (r >> 4) * 2 + (c >> 5), rr = r & 15, cc = c & 31, ob = rr * 64 + cc * 2; return st * 1024 + (ob ^ (((ob >> 9) & 1) << 5)); }
__host__ __device__ __forceinline__ void stage_rc(int b, int& R, int& C) { const int st = b / 1024, sb = b % 1024, swz = sb ^ (((sb >> 9) & 1) << 5); R = (st >> 1) * 16 + swz / 64; C = (st & 1) * 32 + (swz % 64) / 2; }
__host__ __device__ __forceinline__ int perm32(int rho) { const int n = rho >> 4, i = rho & 15; return 8 * (i >> 2) + 4 * n + (i & 3); }

struct Unit { int pm, pn, e, rt, hb; };
struct Gemm { const bf16_t* A; const bf16_t* Bt; int K, lda; };

struct GridOrder {
    int nM, nN, nwg, G, c;
    __device__ void init(int nM_, int nN_, int G_, int c_) { nM = nM_; nN = nN_; nwg = nM * nN; G = G_; c = c_; }
    __device__ bool next(int i, Unit& u) const {
        const long L = (long)i * G + c; if (L >= nwg) return false;
        int wgid = (int)L; { const int q = nwg / NXCD, r = nwg % NXCD, xcd = wgid % NXCD, off = wgid / NXCD; wgid = (xcd < r ? xcd * (q + 1) : r * (q + 1) + (xcd - r) * q) + off; }
        const int nig = WGM * nN, gid = wgid / nig, fm = gid * WGM, gsz = (nM - fm) < WGM ? (nM - fm) : WGM;
        u.pm = fm + ((wgid % nig) % gsz); u.pn = (wgid % nig) / gsz; u.e = 0; u.rt = 0; u.hb = -1; return true;
    }
};

__device__ __forceinline__ unsigned cvt_pk_bf16(float lo, float hi) { unsigned r; asm volatile("v_cvt_pk_bf16_f32 %0, %1, %2" : "=v"(r) : "v"(lo), "v"(hi)); return r; }

template <class Epi, class Sched>
__device__ __forceinline__ void gemm_phase(PG8_LAS unsigned char* lds, const Gemm g, const Sched& S, const Epi& E) {
    int tid_ = threadIdx.x; asm volatile("" : "+v"(tid_));
    const int tid = tid_, wid = __builtin_amdgcn_readfirstlane(tid >> 6), lane = tid & 63, wr = wid >> 2, wc = wid & 3, fr = lane & 15, fq = lane >> 4;
    int K_ = g.K; asm volatile("" : "+s"(K_));
    const int K = K_, nt = K / BK;
    unsigned voffB[2];
#pragma unroll
    for (int i = 0; i < 2; ++i) { int R, C; stage_rc(tid * 16 + i * 8192, R, C); const int Rb = Epi::PERM ? ((R & ~31) + perm32(R & 31)) : R;
        voffB[i] = (unsigned)(Rb * K + C) * 2u; }
    const size_t kstep = (size_t)(BK * 2);
    const size_t hstepB = (size_t)HALF * K * 2;
    const unsigned pitchA = (unsigned)g.lda * 2u;
    const unsigned ldsw = (unsigned)wid * 1024u;
    const int aoff = lds_byte(wr * 64 + fr, fq * 8), boff = lds_byte(wc * 32 + fr, fq * 8);
    const char* gA = (const char*)g.A;
#define PG8_SA(b, h) (((b) * 2 + (h)) * HTB)
#define PG8_SB(b, h) ((4 + (b) * 2 + (h)) * HTB)
#define PG8_STAGEB(bufoff, gbase) do { _Pragma("unroll") for (int _i = 0; _i < 2; ++_i) \
        __builtin_amdgcn_global_load_lds((const unsigned*)((const char*)(gbase) + voffB[_i]), (PG8_LAS unsigned*)(lds + (bufoff) + ldsw + _i * 8192), 16, 0, 0); } while (0)
#define PG8_STAGEA(bufoff, koff, vo) do { _Pragma("unroll") for (int _i = 0; _i < 2; ++_i) \
        __builtin_amdgcn_global_load_lds((const unsigned*)(gA + (koff) + (vo)[_i]), (PG8_LAS unsigned*)(lds + (bufoff) + ldsw + _i * 8192), 16, 0, 0); } while (0)
#define PG8_MKA(dst, u) do { _Pragma("unroll") for (int _i = 0; _i < 2; ++_i) { int R_, C_; stage_rc(tid * 16 + _i * 8192, R_, C_); _Pragma("unroll") for (int _h = 0; _h < 2; ++_h) \
        dst[_h][_i] = (unsigned)S.arow(u, _h * HALF + R_) * pitchA + (unsigned)C_ * 2u; } } while (0)
#define PG8_LDA(dst, b, h) do { _Pragma("unroll") for (int m = 0; m < 4; ++m) _Pragma("unroll") for (int k = 0; k < 2; ++k) dst[m][k] = *(const PG8_LAS bf16x8*)(lds + PG8_SA(b, h) + aoff + m * 2048 + k * 1024); } while (0)
#define PG8_LDB(dst, b, h) do { _Pragma("unroll") for (int n = 0; n < 2; ++n) _Pragma("unroll") for (int k = 0; k < 2; ++k) dst[n][k] = *(const PG8_LAS bf16x8*)(lds + PG8_SB(b, h) + boff + n * 2048 + k * 1024); } while (0)
#define PG8_MMA(ai, bj, At, Bt) do { __builtin_amdgcn_s_setprio(1); _Pragma("unroll") for (int m = 0; m < 4; ++m) _Pragma("unroll") for (int n = 0; n < 2; ++n) _Pragma("unroll") for (int k = 0; k < 2; ++k) \
        acc[ai][bj][m][n] = __builtin_amdgcn_mfma_f32_16x16x32_bf16(Bt[n][k], At[m][k], acc[ai][bj][m][n], 0, 0, 0); __builtin_amdgcn_s_setprio(0); } while (0)
#define PG8_WAIT_V(n) asm volatile("s_waitcnt vmcnt(" #n ")" ::: "memory")
#define PG8_WAIT_L(n) asm volatile("s_waitcnt lgkmcnt(" #n ")" ::: "memory")
#define PG8_BAR __builtin_amdgcn_s_barrier()
#define PG8_SCHED __builtin_amdgcn_sched_barrier(0)
    Unit cur, nxt; int ui = 0;
    if (!S.next(0, cur)) return;
    f32x4 acc[2][2][4][2];
#pragma unroll
    for (int a = 0; a < 2; ++a)
#pragma unroll
        for (int b = 0; b < 2; ++b)
#pragma unroll
            for (int m = 0; m < 4; ++m)
#pragma unroll
                for (int n = 0; n < 2; ++n) acc[a][b][m][n] = (f32x4){0.f, 0.f, 0.f, 0.f};
    bf16x8 At[4][2], B0[2][2], B1[2][2];
    unsigned cvA[2][2], nvA[2][2];
    PG8_MKA(cvA, cur);
    const char* cB = (const char*)g.Bt + (size_t)S.brow(cur) * K * 2;
    PG8_STAGEB(PG8_SB(0, 0), cB); PG8_STAGEB(PG8_SB(0, 1), cB + hstepB); PG8_STAGEA(PG8_SA(0, 0), 0, cvA[0]); PG8_STAGEA(PG8_SA(0, 1), 0, cvA[1]);
    if (wr == 1) PG8_BAR;
    PG8_WAIT_V(2); PG8_BAR;
    PG8_STAGEB(PG8_SB(1, 0), cB + kstep); PG8_STAGEA(PG8_SA(1, 0), kstep, cvA[0]); PG8_STAGEB(PG8_SB(1, 1), cB + hstepB + kstep);
    PG8_WAIT_V(6); PG8_BAR;
    for (;;) {
        const bool has_next = S.next(ui + 1, nxt); const int hb = cur.hb;
        const char* nB = cB;
        if (has_next) { PG8_MKA(nvA, nxt); nB = (const char*)g.Bt + (size_t)S.brow(nxt) * K * 2; }
        else {
#pragma unroll
            for (int h = 0; h < 2; ++h)
#pragma unroll
                for (int i = 0; i < 2; ++i) nvA[h][i] = cvA[h][i]; }
        for (int t = 0; t < nt; t += 2) {
            const bool last = (t == nt - 2);
            const size_t ka1 = (size_t)(t + 1) * kstep;
            const size_t ka2 = last ? (size_t)0 : (size_t)(t + 2) * kstep; const char* b2 = last ? nB : cB + (size_t)(t + 2) * kstep;
            const size_t ka3 = ka2 + kstep; const char* b3 = b2 + kstep;
            unsigned a2v[2][2];
#pragma unroll
            for (int h = 0; h < 2; ++h)
#pragma unroll
                for (int i = 0; i < 2; ++i) a2v[h][i] = last ? nvA[h][i] : cvA[h][i];
            PG8_LDB(B0, 0, 0); PG8_LDB(B1, 0, 1); PG8_SCHED; PG8_LDA(At, 0, 0); PG8_STAGEA(PG8_SA(1, 1), ka1, cvA[1]);
            PG8_WAIT_V(8); PG8_WAIT_L(0); PG8_BAR; if (hb != 1) PG8_MMA(0, 0, At, B0); if (hb != 0) PG8_MMA(0, 1, At, B1); PG8_BAR; PG8_SCHED;
            PG8_LDA(At, 0, 1); PG8_STAGEB(PG8_SB(0, 0), b2); PG8_STAGEB(PG8_SB(0, 1), b2 + hstepB); PG8_STAGEA(PG8_SA(0, 0), ka2, a2v[0]);
            PG8_WAIT_V(8); PG8_WAIT_L(0); PG8_BAR; if (hb != 1) PG8_MMA(1, 0, At, B0); if (hb != 0) PG8_MMA(1, 1, At, B1); PG8_BAR; PG8_SCHED;
            PG8_LDB(B0, 1, 0); PG8_LDB(B1, 1, 1); PG8_SCHED; PG8_LDA(At, 1, 0); PG8_STAGEA(PG8_SA(0, 1), ka2, a2v[1]);
            PG8_WAIT_V(8); PG8_WAIT_L(0); PG8_BAR; if (hb != 1) PG8_MMA(0, 0, At, B0); if (hb != 0) PG8_MMA(0, 1, At, B1); PG8_BAR; PG8_SCHED;
            PG8_LDA(At, 1, 1); PG8_STAGEB(PG8_SB(1, 0), b3); PG8_STAGEB(PG8_SB(1, 1), b3 + hstepB); PG8_STAGEA(PG8_SA(1, 0), ka3, a2v[0]);
            PG8_WAIT_V(8); PG8_WAIT_L(0); PG8_BAR; if (hb != 1) PG8_MMA(1, 0, At, B0); if (hb != 0) PG8_MMA(1, 1, At, B1); PG8_BAR; PG8_SCHED;
        }
        if (wr == 0) PG8_BAR;
        { int fr_ = fr, fq_ = fq, wr_ = wr, wc_ = wc; asm volatile("" : "+v"(fr_), "+v"(fq_), "+s"(wr_), "+s"(wc_));
          E(acc, cur, wr_, wc_, fr_, fq_); }
        if (!has_next) break;
#pragma unroll
        for (int a = 0; a < 2; ++a)
#pragma unroll
            for (int b = 0; b < 2; ++b)
#pragma unroll
                for (int m = 0; m < 4; ++m)
#pragma unroll
                    for (int n = 0; n < 2; ++n) acc[a][b][m][n] = (f32x4){0.f, 0.f, 0.f, 0.f};
        cur = nxt; cB = nB; ++ui;
#pragma unroll
        for (int h = 0; h < 2; ++h)
#pragma unroll
            for (int i = 0; i < 2; ++i) cvA[h][i] = nvA[h][i];
        if (wr == 1) PG8_BAR;
    }
    PG8_WAIT_V(0);
    PG8_BAR;
#undef PG8_SA
#undef PG8_SB
#undef PG8_STAGEA
#undef PG8_STAGEB
#undef PG8_MKA
#undef PG8_LDA
#undef PG8_LDB
#undef PG8_MMA
#undef PG8_WAIT_V
#undef PG8_WAIT_L
#undef PG8_BAR
#undef PG8_SCHED
}
}
#ifndef ATT_D
#define ATT_D 4
#endif
#ifndef ATT_STAGGER
#define ATT_NOSTAGGER 1
#endif
#if ATT_D == 2
#define A_INFLIGHT 3
#elif ATT_D == 3
#define A_INFLIGHT 6
#elif ATT_D == 4
#ifdef ATT_LDR4
#define A_INFLIGHT 18
#else
#define A_INFLIGHT 9
#endif
#else
#error ATT_D
#endif
#define A_GAS __attribute__((address_space(1)))
#ifdef TPROBE
__device__ float g_tprobe;
#ifndef TP_WAVE
#define TP_WAVE 0
#endif
#ifndef TP_Q
#define TP_Q 50.f
#endif
#ifndef TP_OFF
#define TP_OFF 0.f
#endif
#ifndef TP_SCALE
#define TP_SCALE 1e-4f
#endif
#endif
namespace attn {
using bf16x8 = __attribute__((ext_vector_type(8))) short;
using s16x4  = __attribute__((ext_vector_type(4))) short;
using f32x16 = __attribute__((ext_vector_type(16))) float;
using u32x4  = __attribute__((ext_vector_type(4))) unsigned;
using f32x4v = __attribute__((ext_vector_type(4))) float;
typedef unsigned short bf16_t;
constexpr int NW = 8, QBLK = 32, KVBLK = 64, PITCH = 1024;
#ifndef ATT_D
#define ATT_D 4
#endif
constexpr int ADEPTH = ATT_D;
constexpr int NSLOT = ADEPTH + 1, KSLOT = 8192, VSLOT = 16384;
constexpr int LDS_K = 0, LDS_V = NSLOT * KSLOT, LDS_WS = LDS_V + NSLOT * VSLOT, SHM_ATTN = LDS_WS + NW * 64 * 4;
__device__ __forceinline__ int crow(int r, int hi) { return (r & 3) + 8 * (r >> 2) + 4 * hi; }
__device__ __forceinline__ unsigned cvtpk(float lo, float hi) { unsigned r; asm volatile("v_cvt_pk_bf16_f32 %0, %1, %2" : "=v"(r) : "v"(lo), "v"(hi)); return r; }
typedef float f32x2_t __attribute__((ext_vector_type(2))); typedef __bf16 bf16x2_t __attribute__((ext_vector_type(2)));
__device__ __forceinline__ unsigned cvtpk_b(float lo, float hi) { f32x2_t v = {lo, hi}; bf16x2_t b = __builtin_convertvector(v, bf16x2_t); return __builtin_bit_cast(unsigned, b); }
__device__ __forceinline__ void glds16(const void* gsrc, unsigned lds_dst) { unsigned keep;
  asm volatile("s_mov_b32 %0, m0\n\ts_mov_b32 m0, %2\n\ts_nop 0\n\tglobal_load_lds_dwordx4 %1, off\n\ts_mov_b32 m0, %0" : "=&s"(keep) : "v"(gsrc), "s"(lds_dst) : "memory"); }
typedef __attribute__((address_space(3))) const char* lds_cptr;
typedef short v4i16_t __attribute__((ext_vector_type(4)));
__device__ __forceinline__ s16x4 vtr(lds_cptr p) { return __builtin_bit_cast(s16x4, __builtin_amdgcn_ds_read_tr16_b64_v4i16((__attribute__((address_space(3))) v4i16_t*)p)); }
#define A_WAITBAR_(V) asm volatile("s_waitcnt vmcnt(" #V ") lgkmcnt(0)\n\ts_barrier" ::: "memory")
#define A_WAITBAR(V) A_WAITBAR_(V)
#define A_LGKBAR() asm volatile("s_waitcnt lgkmcnt(0)\n\ts_barrier" ::: "memory")
#define A_SBAR() __builtin_amdgcn_sched_barrier(0)

template <int THRL, bool ROTL>
__device__ __forceinline__ void attn_pass(const bf16_t* __restrict__ Qb, const bf16_t* __restrict__ Kh, const bf16_t* __restrict__ Vh, int NT, char* shm, f32x16 (&o)[4], float& l_out) {
  int tid_ = threadIdx.x; asm volatile("" : "+v"(tid_));
  const int tid = tid_, lane = tid & 63, r32 = lane & 31, hi = lane >> 5; const int wid = __builtin_amdgcn_readfirstlane(tid >> 6);
#ifdef ATT_NOSTAGGER
  const int half = 0;
#else
#ifdef ATT_PARITY
  const int half = wid & 1;
#else
  const int half = wid >> 2;
#endif
#endif
  const unsigned lds0 = (unsigned)(uintptr_t)shm;
  float* wsf = (float*)(shm + LDS_WS) + wid * 64;
  const bf16_t* ksrc = Kh + wid * 512 + lane * 8;
  const bf16_t* vsrc = Vh + wid * 512 + lane * 8;
  const unsigned kdst = lds0 + LDS_K + wid * 1024, vdst = lds0 + LDS_V + wid * 1024;
#ifdef ATT_LDR4
#define A_RFL(x) (unsigned)__builtin_amdgcn_readfirstlane(x)
#define DMA_K(t, s) do { if (wid < 4) { glds16(ksrc + (long)(t) * 4096, A_RFL(kdst + (s) * KSLOT)); glds16(ksrc + (long)(t) * 4096 + 2048, A_RFL(kdst + (s) * KSLOT + 4096)); } } while (0)
#define DMA_VA(t, s) do { if (wid < 4) { glds16(vsrc + (long)(t) * 8192, A_RFL(vdst + (s) * VSLOT)); glds16(vsrc + (long)(t) * 8192 + 2048, A_RFL(vdst + (s) * VSLOT + 4096)); } } while (0)
#define DMA_VB(t, s) do { if (wid < 4) { glds16(vsrc + (long)(t) * 8192 + 4096, A_RFL(vdst + (s) * VSLOT + 8192)); glds16(vsrc + (long)(t) * 8192 + 6144, A_RFL(vdst + (s) * VSLOT + 12288)); } } while (0)
#else
#define DMA_K(t, s) glds16(ksrc + (long)(t) * 4096, (unsigned)__builtin_amdgcn_readfirstlane(kdst + (s) * KSLOT))
#define DMA_VA(t, s) glds16(vsrc + (long)(t) * 8192, (unsigned)__builtin_amdgcn_readfirstlane(vdst + (s) * VSLOT))
#define DMA_VB(t, s) glds16(vsrc + (long)(t) * 8192 + 4096, (unsigned)__builtin_amdgcn_readfirstlane(vdst + (s) * VSLOT + 8192))
#endif
#define DMA_V(t, s) do { DMA_VA(t, s); DMA_VB(t, s); } while (0)
  bf16x8 qr[4];
  { const bf16_t* Qw = Qb + (long)(wid * QBLK + r32) * PITCH + hi * 8;
#pragma unroll
    for (int d0 = 0; d0 < 4; ++d0) qr[d0] = *(const A_GAS bf16x8*)(Qw + d0 * 16); }
  DMA_K(0, 0);
#pragma unroll
  for (int g = 1; g < ADEPTH; ++g) { DMA_K(g, g); DMA_V(g - 1, g - 1); }
  float mhat = 0.f, l_reg = 0.f;
#pragma unroll
  for (int d = 0; d < 4; ++d) o[d] = f32x16{};
  f32x16 negm = f32x16{}; asm volatile("" : "+v"(negm));
  f32x16 S0, S1; u32x4 pw0, pw1, pw2, pw3;

  pw0 = pw1 = pw2 = pw3 = (u32x4){0u, 0u, 0u, 0u};
  A_WAITBAR(A_INFLIGHT);
  if (half == 1) A_LGKBAR();
  const unsigned kaddr0 = lds0 + LDS_K + hi * 1024 + r32 * 16;
  const unsigned vaddr0 = lds0 + LDS_V + ((lane >> 4) & 1) * 32 + (lane & 3) * 8 + (4 * hi + ((lane & 15) >> 2)) * 64;
#define A_KRD(dst, addr, off) asm volatile("ds_read_b128 %0, %1 offset:%2" : "=&v"(dst) : "v"(addr), "i"(off) : "memory")
#define A_VRD(dst, addr, off) asm volatile("ds_read_b64_tr_b16 %0, %1 offset:%2" : "=&v"(dst) : "v"(addr), "i"(off) : "memory")
#define A_VRD8(b, addr, d0) do { A_VRD(vl[b][0], addr, (d0) * 4096); A_VRD(vh[b][0], addr, (d0) * 4096 + 512); A_VRD(vl[b][1], addr, (d0) * 4096 + 1024); A_VRD(vh[b][1], addr, (d0) * 4096 + 1536); \
                                  A_VRD(vl[b][2], addr, (d0) * 4096 + 2048); A_VRD(vh[b][2], addr, (d0) * 4096 + 2560); A_VRD(vl[b][3], addr, (d0) * 4096 + 3072); A_VRD(vh[b][3], addr, (d0) * 4096 + 3584); } while (0)
#define A_LWAIT(n) do { asm volatile("s_waitcnt lgkmcnt(" #n ")" ::: "memory"); A_SBAR(); } while (0)
#define A_VFR(b, k) (bf16x8){vl[b][k][0], vl[b][k][1], vl[b][k][2], vl[b][k][3], vh[b][k][0], vh[b][k][1], vh[b][k][2], vh[b][k][3]}
#define A_PV4(od, b) do { od = __builtin_amdgcn_mfma_f32_32x32x16_bf16(__builtin_bit_cast(bf16x8, pw0), A_VFR(b, 0), od, 0, 0, 0); od = __builtin_amdgcn_mfma_f32_32x32x16_bf16(__builtin_bit_cast(bf16x8, pw1), A_VFR(b, 1), od, 0, 0, 0); \
                          od = __builtin_amdgcn_mfma_f32_32x32x16_bf16(__builtin_bit_cast(bf16x8, pw2), A_VFR(b, 2), od, 0, 0, 0); od = __builtin_amdgcn_mfma_f32_32x32x16_bf16(__builtin_bit_cast(bf16x8, pw3), A_VFR(b, 3), od, 0, 0, 0); } while (0)
#define A_QK8() do { S0 = __builtin_amdgcn_mfma_f32_32x32x16_bf16(kf[0], qr[0], negm, 0, 0, 0); S1 = __builtin_amdgcn_mfma_f32_32x32x16_bf16(kf[1], qr[0], negm, 0, 0, 0); \
    _Pragma("unroll") for (int d0 = 1; d0 < 4; ++d0) { S0 = __builtin_amdgcn_mfma_f32_32x32x16_bf16(kf[2 * d0], qr[d0], S0, 0, 0, 0); S1 = __builtin_amdgcn_mfma_f32_32x32x16_bf16(kf[2 * d0 + 1], qr[d0], S1, 0, 0, 0); } } while (0)
#define A_KRD8(addr) do { _Pragma("unroll") for (int d0 = 0; d0 < 4; ++d0) { A_KRD(kf[2 * d0], addr, d0 * 2048); A_KRD(kf[2 * d0 + 1], addr, d0 * 2048 + 512); } } while (0)
  const unsigned wsa = lds0 + LDS_WS + wid * 256 + hi * 16;
#define A_RESCALE_O() do { asm volatile("s_waitcnt lgkmcnt(0)" ::: "memory"); \
    _Pragma("unroll") for (int r4 = 0; r4 < 4; ++r4) { f32x4v w4_; asm volatile("ds_read_b128 %0, %1 offset:%2\n\ts_waitcnt lgkmcnt(0)" : "=&v"(w4_) : "v"(wsa), "i"(r4 * 32) : "memory"); \
      _Pragma("unroll") for (int d = 0; d < 4; ++d) _Pragma("unroll") for (int q = 0; q < 4; ++q) o[d][4 * r4 + q] *= w4_[q]; } } while (0)
#ifdef ATT_NOSTAGGER
#define A_END_M() do { } while (0)
#else
#define A_END_M() do { if (half == 1) { if (i + ADEPTH < NT) A_WAITBAR(A_INFLIGHT); else A_WAITBAR(0); } else A_LGKBAR(); } while (0)
#endif
#define A_MBLOCK(QK, PV) do { bf16x8 kf[8]; s16x4 vl[2][4], vh[2][4]; const unsigned ka = kaddr0 + s * KSLOT, va = vaddr0 + sK * VSLOT; \
    if (i + ADEPTH < NT) DMA_K(i + ADEPTH, sK); if (i + ADEPTH - 1 < NT) DMA_V(i + ADEPTH - 1, sV); \
    if (QK) A_KRD8(ka); \
    if (PV) A_VRD8(0, va, 0); \
    if (QK) { if (PV) A_LWAIT(8); else A_LWAIT(0); A_QK8(); A_SBAR(); } \
    if (PV) { A_VRD8(1, va, 1); A_LWAIT(8); A_PV4(o[0], 0); A_SBAR(); A_VRD8(0, va, 2); A_LWAIT(8); A_PV4(o[1], 1); A_SBAR(); A_VRD8(1, va, 3); A_LWAIT(8); A_PV4(o[2], 0); A_SBAR(); A_LWAIT(0); A_PV4(o[3], 1); } \
    A_END_M(); } while (0)
#define A_VBLOCK(FIRST) do { \
      float a = fmaxf(fmaxf(S0[0], S0[1]), S1[0]), b = fmaxf(fmaxf(S0[2], S0[3]), S1[1]); a = fmaxf(fmaxf(a, S1[2]), S1[3]); \
      _Pragma("unroll") for (int r = 4; r < 16; r += 4) { a = fmaxf(fmaxf(a, S0[r]), S0[r + 1]); b = fmaxf(fmaxf(b, S0[r + 2]), S0[r + 3]); a = fmaxf(fmaxf(a, S1[r]), S1[r + 1]); b = fmaxf(fmaxf(b, S1[r + 2]), S1[r + 3]); } \
      float rm = fmaxf(a, b); \
      { auto rr = __builtin_amdgcn_permlane32_swap(__float_as_uint(rm), __float_as_uint(rm), false, false); rm = fmaxf(__uint_as_float(rr[0]), __uint_as_float(rr[1])); } \
      bool resc = false; \
      if (FIRST || __builtin_expect(__any(rm > (float)THRL), 0)) { \
        const float dl = FIRST ? rm : fmaxf(rm, 0.f); mhat += dl; \
        _Pragma("unroll") for (int r = 0; r < 16; ++r) { S0[r] -= dl; S1[r] -= dl; } \
        _Pragma("unroll") for (int r = 0; r < 16; ++r) negm[r] = -mhat; \
        asm volatile("" : "+v"(negm)); \
        const float f = __builtin_amdgcn_exp2f(-dl); l_reg *= f; if (hi == 0) wsf[r32] = f; resc = !(FIRST); } \
      _Pragma("unroll") for (int r = 0; r < 16; ++r) { S0[r] = __builtin_amdgcn_exp2f(S0[r]); S1[r] = __builtin_amdgcn_exp2f(S1[r]); } \
      float sa = (S0[0] + S0[1]) + (S0[2] + S0[3]), sb = (S1[0] + S1[1]) + (S1[2] + S1[3]); \
      _Pragma("unroll") for (int r = 4; r < 16; r += 4) { sa += (S0[r] + S0[r + 1]) + (S0[r + 2] + S0[r + 3]); sb += (S1[r] + S1[r + 1]) + (S1[r + 2] + S1[r + 3]); } \
      l_reg += sa + sb; \
      pw0 = (u32x4){cvtpk(S0[0], S0[1]), cvtpk(S0[2], S0[3]), cvtpk(S0[4], S0[5]), cvtpk(S0[6], S0[7])}; \
      pw1 = (u32x4){cvtpk(S0[8], S0[9]), cvtpk(S0[10], S0[11]), cvtpk(S0[12], S0[13]), cvtpk(S0[14], S0[15])}; \
      pw2 = (u32x4){cvtpk(S1[0], S1[1]), cvtpk(S1[2], S1[3]), cvtpk(S1[4], S1[5]), cvtpk(S1[6], S1[7])}; \
      pw3 = (u32x4){cvtpk(S1[8], S1[9]), cvtpk(S1[10], S1[11]), cvtpk(S1[12], S1[13]), cvtpk(S1[14], S1[15])}; \
      if (resc) A_RESCALE_O(); \
      if (half == 0) { if (i + ADEPTH < NT) A_WAITBAR(A_INFLIGHT); else A_WAITBAR(0); } else A_LGKBAR(); } while (0)
#ifdef ATT_TRIG1
#define A_TRIG 1.0f
#else
#define A_TRIG (float)(1 << THRL)
#endif
#if defined(TPROBE)
#define A_TP_NOW() __builtin_readcyclecounter()
#define A_TP_DECL() unsigned long long tq0_ = 0, tq1_ = 0
#else
#define A_TP_DECL() do { } while (0)
#endif
#if defined(TPROBE) && TPROBE == 2
#define A_TP_TOP() do { } while (0)
#define A_TP_M8() do { } while (0)
#define A_TP_PRE() tq0_ = A_TP_NOW()
#define A_TP_POST() do { tq1_ = A_TP_NOW(); tpa_ += tq1_ - tq0_; } while (0)
#elif defined(TPROBE) && TPROBE == 3
#define A_TP_TOP() tq0_ = A_TP_NOW()
#define A_TP_M8() tq1_ = A_TP_NOW()
#define A_TP_PRE() do { } while (0)
#define A_TP_POST() tpa_ += tq1_ - tq0_
#elif defined(TPROBE) && TPROBE == 4
#define A_TP_TOP() do { } while (0)
#define A_TP_M8() tq0_ = A_TP_NOW()
#define A_TP_PRE() tq1_ = A_TP_NOW()
#define A_TP_POST() tpa_ += tq1_ - tq0_
#else
#define A_TP_TOP() do { } while (0)
#define A_TP_M8() do { } while (0)
#define A_TP_PRE() do { } while (0)
#define A_TP_POST() do { } while (0)
#endif
#if defined(TPROBE) && TPROBE == 2
#define A_TPB_PRE() const unsigned long long tb0_ = __builtin_readcyclecounter()
#define A_TPB_POST() do { const unsigned long long tb1_ = __builtin_readcyclecounter(); tpa_ += tb1_ - tb0_; } while (0)
#else
#define A_TPB_PRE() do { } while (0)
#define A_TPB_POST() do { } while (0)
#endif
#define A_SX(j) ((j) < 16 ? S0[(j) & 15] : S1[(j) & 15])
#define A_GAP(od, ks, b, w) do { od = __builtin_amdgcn_mfma_f32_32x32x16_bf16(__builtin_bit_cast(bf16x8, pw##ks), A_VFR(b, ks), od, 0, 0, 0); \
    { const float s0_ = A_SX(2 * (w)), s1_ = A_SX(2 * (w) + 1); \
      const float e0_ = __builtin_amdgcn_exp2f(s0_), e1_ = __builtin_amdgcn_exp2f(s1_); sa += e0_; sb += e1_; unsigned w_ = cvtpk_b(e0_, e1_); asm volatile("" : "+v"(w_), "+v"(sa), "+v"(sb)); pwn[(w) >> 2][(w) & 3] = w_; } A_SBAR(); } while (0)
#define A_PV4I(od, b, w0) do { A_GAP(od, 0, b, (w0)); A_GAP(od, 1, b, (w0) + 1); A_GAP(od, 2, b, (w0) + 2); A_GAP(od, 3, b, (w0) + 3); } while (0)
#define A_KRD8S() do { A_KRD(kf[0], ka, 0); A_KRD(kf[2], ka, 2048); A_KRD(kf[4], ka, 4096); A_KRD(kf[6], ka, 6144); } while (0)
#define A_KRD4B() do { A_KRD(kf[1], ka, 512); A_KRD(kf[3], ka, 2560); A_KRD(kf[5], ka, 4608); A_KRD(kf[7], ka, 6656); } while (0)
#define A_HEAD() do { __builtin_amdgcn_s_setprio(3); A_SBAR(); A_KRD8S(); } while (0)
#define A_TAIL(REISSUE) do { o[3] = __builtin_amdgcn_mfma_f32_32x32x16_bf16(__builtin_bit_cast(bf16x8, pw0), A_VFR(1, 0), o[3], 0, 0, 0); { sa += e22_; sb += e23_; unsigned w11_ = cvtpk_b(e22_, e23_); e26_ = __builtin_amdgcn_exp2f(S1[10]); e27_ = __builtin_amdgcn_exp2f(S1[11]); asm volatile("" : "+v"(sa), "+v"(sb), "+v"(w11_), "+v"(e26_), "+v"(e27_)); pwn[2][3] = w11_; } A_SBAR(); o[3] = __builtin_amdgcn_mfma_f32_32x32x16_bf16(__builtin_bit_cast(bf16x8, pw1), A_VFR(1, 1), o[3], 0, 0, 0); { sa += e24_; sb += e25_; unsigned w12_ = cvtpk_b(e24_, e25_); e28_ = __builtin_amdgcn_exp2f(S1[12]); e29_ = __builtin_amdgcn_exp2f(S1[13]); asm volatile("" : "+v"(sa), "+v"(sb), "+v"(w12_), "+v"(e28_), "+v"(e29_)); pwn[3][0] = w12_; } A_SBAR(); o[3] = __builtin_amdgcn_mfma_f32_32x32x16_bf16(__builtin_bit_cast(bf16x8, pw2), A_VFR(1, 2), o[3], 0, 0, 0); { sa += e26_; sb += e27_; unsigned w13_ = cvtpk_b(e26_, e27_); e30_ = __builtin_amdgcn_exp2f(S1[14]); e31_ = __builtin_amdgcn_exp2f(S1[15]); asm volatile("" : "+v"(sa), "+v"(sb), "+v"(w13_), "+v"(e30_), "+v"(e31_)); pwn[3][1] = w13_; } A_SBAR(); o[3] = __builtin_amdgcn_mfma_f32_32x32x16_bf16(__builtin_bit_cast(bf16x8, pw3), A_VFR(1, 3), o[3], 0, 0, 0); { sa += e28_; sb += e29_; unsigned w14_ = cvtpk_b(e28_, e29_); sa += e30_; sb += e31_; unsigned w15_ = cvtpk_b(e30_, e31_); asm volatile("" : "+v"(sa), "+v"(sb), "+v"(w14_), "+v"(w15_)); pwn[3][2] = w14_; pwn[3][3] = w15_; } A_SBAR(); \
      \
    float rm = sa + sb;                                     \
    { auto rr = __builtin_amdgcn_permlane32_swap(__float_as_uint(rm), __float_as_uint(rm), false, false); rm = __uint_as_float(rr[0]) + __uint_as_float(rr[1]); } \
    if (__builtin_expect(__any(rm > A_TRIG), 0)) { asm volatile("s_waitcnt lgkmcnt(0)" ::: "memory");     \
      const float dl = fmaxf(__builtin_amdgcn_logf(rm), 0.f); mhat += dl; \
      _Pragma("unroll") for (int r = 0; r < 16; ++r) negm[r] = -mhat; \
      asm volatile("" : "+v"(negm)); \
      const float f = __builtin_amdgcn_exp2f(-dl); l_reg *= f; sa *= f; sb *= f; \
      _Pragma("unroll") for (int q = 0; q < 4; ++q) _Pragma("unroll") for (int c = 0; c < 4; ++c) { const unsigned w_ = pwn[q][c]; pwn[q][c] = cvtpk_b(__uint_as_float(w_ << 16) * f, __uint_as_float(w_ & 0xffff0000u) * f); } \
      if (hi == 0) wsf[r32] = f; A_RESCALE_O(); REISSUE; } \
    l_reg += sa + sb; pw0 = pwn[0]; pw1 = pwn[1]; pw2 = pwn[2]; pw3 = pwn[3]; \
    sa = 0.f; sb = 0.f; } while (0)
#define A_BODY() do { A_KRD4B(); \
    A_LWAIT(7); S0 = __builtin_amdgcn_mfma_f32_32x32x16_bf16(kf[0], qr[0], negm, 0, 0, 0); A_SBAR(); if (i + ADEPTH < NT) DMA_K(i + ADEPTH, sK); A_SBAR(); \
    A_LWAIT(6); S0 = __builtin_amdgcn_mfma_f32_32x32x16_bf16(kf[2], qr[1], S0, 0, 0, 0); A_SBAR(); \
    A_LWAIT(5); S0 = __builtin_amdgcn_mfma_f32_32x32x16_bf16(kf[4], qr[2], S0, 0, 0, 0); A_SBAR(); if (i + ADEPTH - 1 < NT) DMA_VA(i + ADEPTH - 1, sV); A_SBAR(); \
    A_LWAIT(4); S0 = __builtin_amdgcn_mfma_f32_32x32x16_bf16(kf[6], qr[3], S0, 0, 0, 0); A_SBAR(); A_VRD8(0, va, 0); \
    A_LWAIT(11); S1 = __builtin_amdgcn_mfma_f32_32x32x16_bf16(kf[1], qr[0], negm, 0, 0, 0); A_SBAR(); if (i + ADEPTH - 1 < NT) DMA_VB(i + ADEPTH - 1, sV); A_SBAR(); __builtin_amdgcn_s_setprio(2); A_SBAR(); \
    A_LWAIT(10); S1 = __builtin_amdgcn_mfma_f32_32x32x16_bf16(kf[3], qr[1], S1, 0, 0, 0); A_SBAR(); { e0_ = __builtin_amdgcn_exp2f(S0[0]); e1_ = __builtin_amdgcn_exp2f(S0[1]); e2_ = __builtin_amdgcn_exp2f(S0[2]); asm volatile("" : "+v"(e0_), "+v"(e1_), "+v"(e2_)); } A_SBAR(); \
    A_LWAIT(9); S1 = __builtin_amdgcn_mfma_f32_32x32x16_bf16(kf[5], qr[2], S1, 0, 0, 0); A_SBAR(); { e3_ = __builtin_amdgcn_exp2f(S0[3]); sa += e0_; sb += e1_; unsigned w0_ = cvtpk_b(e0_, e1_); asm volatile("" : "+v"(e3_), "+v"(sa), "+v"(sb), "+v"(w0_)); pwn[0][0] = w0_; } A_SBAR(); \
    A_LWAIT(8); S1 = __builtin_amdgcn_mfma_f32_32x32x16_bf16(kf[7], qr[3], S1, 0, 0, 0); A_SBAR(); { e4_ = __builtin_amdgcn_exp2f(S0[4]); e5_ = __builtin_amdgcn_exp2f(S0[5]); sa += e2_; sb += e3_; asm volatile("" : "+v"(e4_), "+v"(e5_), "+v"(sa), "+v"(sb)); } A_SBAR(); \
    A_VRD8(1, va, 1); A_LWAIT(8); o[0] = __builtin_amdgcn_mfma_f32_32x32x16_bf16(__builtin_bit_cast(bf16x8, pw0), A_VFR(0, 0), o[0], 0, 0, 0); { unsigned w1_ = cvtpk_b(e2_, e3_); e6_ = __builtin_amdgcn_exp2f(S0[6]); e7_ = __builtin_amdgcn_exp2f(S0[7]); sa += e4_; asm volatile("" : "+v"(w1_), "+v"(e6_), "+v"(e7_), "+v"(sa)); pwn[0][1] = w1_; } A_SBAR(); o[0] = __builtin_amdgcn_mfma_f32_32x32x16_bf16(__builtin_bit_cast(bf16x8, pw1), A_VFR(0, 1), o[0], 0, 0, 0); { sb += e5_; unsigned w2_ = cvtpk_b(e4_, e5_); e8_ = __builtin_amdgcn_exp2f(S0[8]); e9_ = __builtin_amdgcn_exp2f(S0[9]); asm volatile("" : "+v"(sb), "+v"(w2_), "+v"(e8_), "+v"(e9_)); pwn[0][2] = w2_; } A_SBAR(); o[0] = __builtin_amdgcn_mfma_f32_32x32x16_bf16(__builtin_bit_cast(bf16x8, pw2), A_VFR(0, 2), o[0], 0, 0, 0); { sa += e6_; sb += e7_; unsigned w3_ = cvtpk_b(e6_, e7_); e10_ = __builtin_amdgcn_exp2f(S0[10]); asm volatile("" : "+v"(sa), "+v"(sb), "+v"(w3_), "+v"(e10_)); pwn[0][3] = w3_; } A_SBAR(); o[0] = __builtin_amdgcn_mfma_f32_32x32x16_bf16(__builtin_bit_cast(bf16x8, pw3), A_VFR(0, 3), o[0], 0, 0, 0); { e11_ = __builtin_amdgcn_exp2f(S0[11]); sa += e8_; sb += e9_; unsigned w4_ = cvtpk_b(e8_, e9_); asm volatile("" : "+v"(e11_), "+v"(sa), "+v"(sb), "+v"(w4_)); pwn[1][0] = w4_; } A_SBAR(); __builtin_amdgcn_s_setprio(1); A_SBAR(); \
    A_VRD8(0, va, 2); A_LWAIT(8); o[1] = __builtin_amdgcn_mfma_f32_32x32x16_bf16(__builtin_bit_cast(bf16x8, pw0), A_VFR(1, 0), o[1], 0, 0, 0); { e12_ = __builtin_amdgcn_exp2f(S0[12]); e13_ = __builtin_amdgcn_exp2f(S0[13]); sa += e10_; sb += e11_; asm volatile("" : "+v"(e12_), "+v"(e13_), "+v"(sa), "+v"(sb)); } A_SBAR(); o[1] = __builtin_amdgcn_mfma_f32_32x32x16_bf16(__builtin_bit_cast(bf16x8, pw1), A_VFR(1, 1), o[1], 0, 0, 0); { unsigned w5_ = cvtpk_b(e10_, e11_); e14_ = __builtin_amdgcn_exp2f(S0[14]); e15_ = __builtin_amdgcn_exp2f(S0[15]); sa += e12_; asm volatile("" : "+v"(w5_), "+v"(e14_), "+v"(e15_), "+v"(sa)); pwn[1][1] = w5_; } A_SBAR(); o[1] = __builtin_amdgcn_mfma_f32_32x32x16_bf16(__builtin_bit_cast(bf16x8, pw2), A_VFR(1, 2), o[1], 0, 0, 0); { sb += e13_; unsigned w6_ = cvtpk_b(e12_, e13_); e16_ = __builtin_amdgcn_exp2f(S1[0]); e17_ = __builtin_amdgcn_exp2f(S1[1]); asm volatile("" : "+v"(sb), "+v"(w6_), "+v"(e16_), "+v"(e17_)); pwn[1][2] = w6_; } A_SBAR(); o[1] = __builtin_amdgcn_mfma_f32_32x32x16_bf16(__builtin_bit_cast(bf16x8, pw3), A_VFR(1, 3), o[1], 0, 0, 0); { sa += e14_; sb += e15_; unsigned w7_ = cvtpk_b(e14_, e15_); e18_ = __builtin_amdgcn_exp2f(S1[2]); asm volatile("" : "+v"(sa), "+v"(sb), "+v"(w7_), "+v"(e18_)); pwn[1][3] = w7_; } A_SBAR(); \
    A_VRD8(1, va, 3); A_LWAIT(8); o[2] = __builtin_amdgcn_mfma_f32_32x32x16_bf16(__builtin_bit_cast(bf16x8, pw0), A_VFR(0, 0), o[2], 0, 0, 0); { e19_ = __builtin_amdgcn_exp2f(S1[3]); sa += e16_; sb += e17_; unsigned w8_ = cvtpk_b(e16_, e17_); asm volatile("" : "+v"(e19_), "+v"(sa), "+v"(sb), "+v"(w8_)); pwn[2][0] = w8_; } A_SBAR(); __builtin_amdgcn_s_setprio(0); A_SBAR(); o[2] = __builtin_amdgcn_mfma_f32_32x32x16_bf16(__builtin_bit_cast(bf16x8, pw1), A_VFR(0, 1), o[2], 0, 0, 0); { e20_ = __builtin_amdgcn_exp2f(S1[4]); e21_ = __builtin_amdgcn_exp2f(S1[5]); sa += e18_; sb += e19_; asm volatile("" : "+v"(e20_), "+v"(e21_), "+v"(sa), "+v"(sb)); } A_SBAR(); o[2] = __builtin_amdgcn_mfma_f32_32x32x16_bf16(__builtin_bit_cast(bf16x8, pw2), A_VFR(0, 2), o[2], 0, 0, 0); { unsigned w9_ = cvtpk_b(e18_, e19_); e22_ = __builtin_amdgcn_exp2f(S1[6]); e23_ = __builtin_amdgcn_exp2f(S1[7]); sa += e20_; asm volatile("" : "+v"(w9_), "+v"(e22_), "+v"(e23_), "+v"(sa)); pwn[2][1] = w9_; } A_SBAR(); o[2] = __builtin_amdgcn_mfma_f32_32x32x16_bf16(__builtin_bit_cast(bf16x8, pw3), A_VFR(0, 3), o[2], 0, 0, 0); { sb += e21_; unsigned w10_ = cvtpk_b(e20_, e21_); e24_ = __builtin_amdgcn_exp2f(S1[8]); e25_ = __builtin_amdgcn_exp2f(S1[9]); asm volatile("" : "+v"(sb), "+v"(w10_), "+v"(e24_), "+v"(e25_)); pwn[2][2] = w10_; } A_SBAR(); \
    A_TPB_PRE(); if (i + ADEPTH < NT) A_WAITBAR(A_INFLIGHT); else A_WAITBAR(0); A_TPB_POST(); } while (0)
#define A_ITER1() do { bf16x8 kf[8]; const unsigned ka = kaddr0 + s * KSLOT, va = vaddr0 + sK * VSLOT; A_HEAD(); A_BODY(); } while (0)
#define A_ITER() do { bf16x8 kf[8]; const unsigned ka = kaddr0 + s * KSLOT, va = vaddr0 + sK * VSLOT; A_HEAD(); A_TAIL(A_KRD8S()); A_BODY(); } while (0)
#define A_ITER0() do { bf16x8 kf[8]; s16x4 vl[2][4], vh[2][4]; const unsigned ka = kaddr0 + s * KSLOT, va = vaddr0 + sK * VSLOT; \
      \
    __builtin_amdgcn_s_setprio(3); A_SBAR(); A_KRD(kf[0], ka, 0); A_KRD(kf[2], ka, 2048); A_KRD(kf[4], ka, 4096); A_KRD(kf[6], ka, 6144); A_KRD(kf[1], ka, 512); A_KRD(kf[3], ka, 2560); A_KRD(kf[5], ka, 4608); A_KRD(kf[7], ka, 6656); \
    float sa = 0.f, sb = 0.f; u32x4 pwn[4]; float e0_, e1_, e2_, e3_, e4_, e5_, e6_, e7_, e8_, e9_, e10_, e11_, e12_, e13_, e14_, e15_, e16_, e17_, e18_, e19_, e20_, e21_, e22_, e23_, e24_, e25_, e26_, e27_, e28_, e29_, e30_, e31_; \
      \
    A_LWAIT(7); S0 = __builtin_amdgcn_mfma_f32_32x32x16_bf16(kf[0], qr[0], negm, 0, 0, 0); A_SBAR(); if (i + ADEPTH < NT) DMA_K(i + ADEPTH, sK); A_SBAR(); \
    A_LWAIT(6); S0 = __builtin_amdgcn_mfma_f32_32x32x16_bf16(kf[2], qr[1], S0, 0, 0, 0); A_SBAR(); \
    A_LWAIT(5); S0 = __builtin_amdgcn_mfma_f32_32x32x16_bf16(kf[4], qr[2], S0, 0, 0, 0); A_SBAR(); if (i + ADEPTH - 1 < NT) DMA_VA(i + ADEPTH - 1, sV); A_SBAR(); \
    A_LWAIT(4); S0 = __builtin_amdgcn_mfma_f32_32x32x16_bf16(kf[6], qr[3], S0, 0, 0, 0); A_SBAR(); A_VRD8(0, va, 0); \
    A_LWAIT(11); S1 = __builtin_amdgcn_mfma_f32_32x32x16_bf16(kf[1], qr[0], negm, 0, 0, 0); A_SBAR(); if (i + ADEPTH - 1 < NT) DMA_VB(i + ADEPTH - 1, sV); A_SBAR(); \
    A_LWAIT(10); S1 = __builtin_amdgcn_mfma_f32_32x32x16_bf16(kf[3], qr[1], S1, 0, 0, 0); A_SBAR(); { e0_ = __builtin_amdgcn_exp2f(S0[0]); e1_ = __builtin_amdgcn_exp2f(S0[1]); e2_ = __builtin_amdgcn_exp2f(S0[2]); asm volatile("" : "+v"(e0_), "+v"(e1_), "+v"(e2_)); } A_SBAR(); __builtin_amdgcn_s_setprio(2); A_SBAR(); \
    A_LWAIT(9); S1 = __builtin_amdgcn_mfma_f32_32x32x16_bf16(kf[5], qr[2], S1, 0, 0, 0); A_SBAR(); { e3_ = __builtin_amdgcn_exp2f(S0[3]); sa += e0_; sb += e1_; unsigned w0_ = cvtpk_b(e0_, e1_); asm volatile("" : "+v"(e3_), "+v"(sa), "+v"(sb), "+v"(w0_)); pwn[0][0] = w0_; } A_SBAR(); \
    A_LWAIT(8); S1 = __builtin_amdgcn_mfma_f32_32x32x16_bf16(kf[7], qr[3], S1, 0, 0, 0); A_SBAR(); { e4_ = __builtin_amdgcn_exp2f(S0[4]); e5_ = __builtin_amdgcn_exp2f(S0[5]); sa += e2_; sb += e3_; asm volatile("" : "+v"(e4_), "+v"(e5_), "+v"(sa), "+v"(sb)); } A_SBAR(); \
    A_VRD8(1, va, 1); A_LWAIT(8); o[0] = __builtin_amdgcn_mfma_f32_32x32x16_bf16(__builtin_bit_cast(bf16x8, pw0), A_VFR(0, 0), o[0], 0, 0, 0); { unsigned w1_ = cvtpk_b(e2_, e3_); e6_ = __builtin_amdgcn_exp2f(S0[6]); e7_ = __builtin_amdgcn_exp2f(S0[7]); sa += e4_; asm volatile("" : "+v"(w1_), "+v"(e6_), "+v"(e7_), "+v"(sa)); pwn[0][1] = w1_; } A_SBAR(); o[0] = __builtin_amdgcn_mfma_f32_32x32x16_bf16(__builtin_bit_cast(bf16x8, pw1), A_VFR(0, 1), o[0], 0, 0, 0); { sb += e5_; unsigned w2_ = cvtpk_b(e4_, e5_); e8_ = __builtin_amdgcn_exp2f(S0[8]); e9_ = __builtin_amdgcn_exp2f(S0[9]); asm volatile("" : "+v"(sb), "+v"(w2_), "+v"(e8_), "+v"(e9_)); pwn[0][2] = w2_; } A_SBAR(); o[0] = __builtin_amdgcn_mfma_f32_32x32x16_bf16(__builtin_bit_cast(bf16x8, pw2), A_VFR(0, 2), o[0], 0, 0, 0); { sa += e6_; sb += e7_; unsigned w3_ = cvtpk_b(e6_, e7_); e10_ = __builtin_amdgcn_exp2f(S0[10]); asm volatile("" : "+v"(sa), "+v"(sb), "+v"(w3_), "+v"(e10_)); pwn[0][3] = w3_; } A_SBAR(); o[0] = __builtin_amdgcn_mfma_f32_32x32x16_bf16(__builtin_bit_cast(bf16x8, pw3), A_VFR(0, 3), o[0], 0, 0, 0); { e11_ = __builtin_amdgcn_exp2f(S0[11]); sa += e8_; sb += e9_; unsigned w4_ = cvtpk_b(e8_, e9_); asm volatile("" : "+v"(e11_), "+v"(sa), "+v"(sb), "+v"(w4_)); pwn[1][0] = w4_; } A_SBAR(); __builtin_amdgcn_s_setprio(1); A_SBAR(); \
    A_VRD8(0, va, 2); A_LWAIT(8); o[1] = __builtin_amdgcn_mfma_f32_32x32x16_bf16(__builtin_bit_cast(bf16x8, pw0), A_VFR(1, 0), o[1], 0, 0, 0); { e12_ = __builtin_amdgcn_exp2f(S0[12]); e13_ = __builtin_amdgcn_exp2f(S0[13]); sa += e10_; sb += e11_; asm volatile("" : "+v"(e12_), "+v"(e13_), "+v"(sa), "+v"(sb)); } A_SBAR(); o[1] = __builtin_amdgcn_mfma_f32_32x32x16_bf16(__builtin_bit_cast(bf16x8, pw1), A_VFR(1, 1), o[1], 0, 0, 0); { unsigned w5_ = cvtpk_b(e10_, e11_); e14_ = __builtin_amdgcn_exp2f(S0[14]); e15_ = __builtin_amdgcn_exp2f(S0[15]); sa += e12_; asm volatile("" : "+v"(w5_), "+v"(e14_), "+v"(e15_), "+v"(sa)); pwn[1][1] = w5_; } A_SBAR(); o[1] = __builtin_amdgcn_mfma_f32_32x32x16_bf16(__builtin_bit_cast(bf16x8, pw2), A_VFR(1, 2), o[1], 0, 0, 0); { sb += e13_; unsigned w6_ = cvtpk_b(e12_, e13_); e16_ = __builtin_amdgcn_exp2f(S1[0]); e17_ = __builtin_amdgcn_exp2f(S1[1]); asm volatile("" : "+v"(sb), "+v"(w6_), "+v"(e16_), "+v"(e17_)); pwn[1][2] = w6_; } A_SBAR(); o[1] = __builtin_amdgcn_mfma_f32_32x32x16_bf16(__builtin_bit_cast(bf16x8, pw3), A_VFR(1, 3), o[1], 0, 0, 0); { sa += e14_; sb += e15_; unsigned w7_ = cvtpk_b(e14_, e15_); e18_ = __builtin_amdgcn_exp2f(S1[2]); asm volatile("" : "+v"(sa), "+v"(sb), "+v"(w7_), "+v"(e18_)); pwn[1][3] = w7_; } A_SBAR(); \
    A_VRD8(1, va, 3); A_LWAIT(8); o[2] = __builtin_amdgcn_mfma_f32_32x32x16_bf16(__builtin_bit_cast(bf16x8, pw0), A_VFR(0, 0), o[2], 0, 0, 0); { e19_ = __builtin_amdgcn_exp2f(S1[3]); sa += e16_; sb += e17_; unsigned w8_ = cvtpk_b(e16_, e17_); asm volatile("" : "+v"(e19_), "+v"(sa), "+v"(sb), "+v"(w8_)); pwn[2][0] = w8_; } A_SBAR(); o[2] = __builtin_amdgcn_mfma_f32_32x32x16_bf16(__builtin_bit_cast(bf16x8, pw1), A_VFR(0, 1), o[2], 0, 0, 0); { e20_ = __builtin_amdgcn_exp2f(S1[4]); e21_ = __builtin_amdgcn_exp2f(S1[5]); sa += e18_; sb += e19_; asm volatile("" : "+v"(e20_), "+v"(e21_), "+v"(sa), "+v"(sb)); } A_SBAR(); __builtin_amdgcn_s_setprio(0); A_SBAR(); o[2] = __builtin_amdgcn_mfma_f32_32x32x16_bf16(__builtin_bit_cast(bf16x8, pw2), A_VFR(0, 2), o[2], 0, 0, 0); { unsigned w9_ = cvtpk_b(e18_, e19_); e22_ = __builtin_amdgcn_exp2f(S1[6]); e23_ = __builtin_amdgcn_exp2f(S1[7]); sa += e20_; asm volatile("" : "+v"(w9_), "+v"(e22_), "+v"(e23_), "+v"(sa)); pwn[2][1] = w9_; } A_SBAR(); o[2] = __builtin_amdgcn_mfma_f32_32x32x16_bf16(__builtin_bit_cast(bf16x8, pw3), A_VFR(0, 3), o[2], 0, 0, 0); { sb += e21_; unsigned w10_ = cvtpk_b(e20_, e21_); e24_ = __builtin_amdgcn_exp2f(S1[8]); e25_ = __builtin_amdgcn_exp2f(S1[9]); asm volatile("" : "+v"(sb), "+v"(w10_), "+v"(e24_), "+v"(e25_)); pwn[2][2] = w10_; } A_SBAR(); \
    A_LWAIT(0); o[3] = __builtin_amdgcn_mfma_f32_32x32x16_bf16(__builtin_bit_cast(bf16x8, pw0), A_VFR(1, 0), o[3], 0, 0, 0); { sa += e22_; sb += e23_; unsigned w11_ = cvtpk_b(e22_, e23_); e26_ = __builtin_amdgcn_exp2f(S1[10]); e27_ = __builtin_amdgcn_exp2f(S1[11]); asm volatile("" : "+v"(sa), "+v"(sb), "+v"(w11_), "+v"(e26_), "+v"(e27_)); pwn[2][3] = w11_; } A_SBAR(); o[3] = __builtin_amdgcn_mfma_f32_32x32x16_bf16(__builtin_bit_cast(bf16x8, pw1), A_VFR(1, 1), o[3], 0, 0, 0); { sa += e24_; sb += e25_; unsigned w12_ = cvtpk_b(e24_, e25_); e28_ = __builtin_amdgcn_exp2f(S1[12]); e29_ = __builtin_amdgcn_exp2f(S1[13]); asm volatile("" : "+v"(sa), "+v"(sb), "+v"(w12_), "+v"(e28_), "+v"(e29_)); pwn[3][0] = w12_; } A_SBAR(); o[3] = __builtin_amdgcn_mfma_f32_32x32x16_bf16(__builtin_bit_cast(bf16x8, pw2), A_VFR(1, 2), o[3], 0, 0, 0); { sa += e26_; sb += e27_; unsigned w13_ = cvtpk_b(e26_, e27_); e30_ = __builtin_amdgcn_exp2f(S1[14]); e31_ = __builtin_amdgcn_exp2f(S1[15]); asm volatile("" : "+v"(sa), "+v"(sb), "+v"(w13_), "+v"(e30_), "+v"(e31_)); pwn[3][1] = w13_; } A_SBAR(); o[3] = __builtin_amdgcn_mfma_f32_32x32x16_bf16(__builtin_bit_cast(bf16x8, pw3), A_VFR(1, 3), o[3], 0, 0, 0); { sa += e28_; sb += e29_; unsigned w14_ = cvtpk_b(e28_, e29_); sa += e30_; sb += e31_; unsigned w15_ = cvtpk_b(e30_, e31_); asm volatile("" : "+v"(sa), "+v"(sb), "+v"(w14_), "+v"(w15_)); pwn[3][2] = w14_; pwn[3][3] = w15_; } A_SBAR(); \
      \
    float rm = sa + sb;                                     \
    { auto rr = __builtin_amdgcn_permlane32_swap(__float_as_uint(rm), __float_as_uint(rm), false, false); rm = __uint_as_float(rr[0]) + __uint_as_float(rr[1]); } \
    if (__builtin_expect(__any(rm > A_TRIG), 0)) { \
      const float dl = fmaxf(__builtin_amdgcn_logf(rm), 0.f); mhat += dl; \
      _Pragma("unroll") for (int r = 0; r < 16; ++r) negm[r] = -mhat; \
      asm volatile("" : "+v"(negm)); \
      const float f = __builtin_amdgcn_exp2f(-dl); l_reg *= f; sa *= f; sb *= f; \
      _Pragma("unroll") for (int q = 0; q < 4; ++q) _Pragma("unroll") for (int c = 0; c < 4; ++c) { const unsigned w_ = pwn[q][c]; pwn[q][c] = cvtpk_b(__uint_as_float(w_ << 16) * f, __uint_as_float(w_ & 0xffff0000u) * f); } \
      if (hi == 0) wsf[r32] = f; A_RESCALE_O(); } \
    l_reg += sa + sb; pw0 = pwn[0]; pw1 = pwn[1]; pw2 = pwn[2]; pw3 = pwn[3]; \
    if (i + ADEPTH < NT) A_WAITBAR(A_INFLIGHT); else A_WAITBAR(0); } while (0)
#define A_ROT() do { sV = sK; sK = s; s = (s == NSLOT - 1) ? 0 : s + 1; } while (0)
  int s = 0, sK = NSLOT - 1, sV = NSLOT - 2, i = 0;
  if (ROTL) {
  s16x4 vl[2][4], vh[2][4]; float sa = 0.f, sb = 0.f; u32x4 pwn[4]; float e0_, e1_, e2_, e3_, e4_, e5_, e6_, e7_, e8_, e9_, e10_, e11_, e12_, e13_, e14_, e15_, e16_, e17_, e18_, e19_, e20_, e21_, e22_, e23_, e24_, e25_, e26_, e27_, e28_, e29_, e30_, e31_;
  A_MBLOCK(true, false); A_VBLOCK(true); A_ROT();
#ifdef TPROBE
  unsigned long long tp0_ = __builtin_readcyclecounter(); unsigned long long tpa_ = 0;
#endif
  i = 1; A_ITER1(); A_ROT(); ++i;
#pragma unroll 1
  for (; i + 1 < NT; ) { A_ITER(); A_ROT(); ++i; A_ITER(); A_ROT(); ++i; }
  if (i < NT) { A_ITER(); A_ROT(); ++i; }
#ifdef TPROBE
  if (NT > 100 && blockIdx.x == 0 && wid == TP_WAVE) { const unsigned long long tp1_ = __builtin_readcyclecounter();
    if (lane == 0) g_tprobe = floorf(((float)(TPROBE == 1 ? tp1_ - tp0_ : tpa_) / (float)(NT - 1) - TP_OFF) * TP_SCALE * TP_Q + 0.5f) / TP_Q; }
#endif
  A_TAIL((void)0);
  __builtin_amdgcn_s_setprio(0);
  } else {
  A_MBLOCK(true, false); A_VBLOCK(true); A_ROT();
#pragma unroll 1
  for (i = 1; i < NT; ) { A_ITER0(); A_ROT(); ++i; }
  }
  A_MBLOCK(false, true);
#ifdef ATT_NOSTAGGER
  A_LGKBAR();
#endif
#undef A_KRD
#undef A_VRD
#undef A_VRD8
#undef A_LWAIT
#undef A_VFR
#undef A_PV4
#undef A_QK8
#undef A_KRD8
#undef A_RESCALE_O
#undef A_MBLOCK
#undef A_VBLOCK
#undef A_ROT
#undef A_SX
#undef A_TRIG
#undef A_GAP
#undef A_PV4I
#undef A_ITER
#undef A_ITER0
#undef A_ITER1
#undef A_HEAD
#undef A_TAIL
#undef A_BODY
#undef A_KRD8S
#undef A_KRD4B
#ifndef ATT_NOSTAGGER
  if (half == 0) A_LGKBAR();
#endif
  { auto rr = __builtin_amdgcn_permlane32_swap(__float_as_uint(l_reg), __float_as_uint(l_reg), false, false); l_out = __uint_as_float(rr[0]) + __uint_as_float(rr[1]); }
#undef DMA_K
#undef DMA_V
#undef DMA_VA
#undef DMA_VB
}

struct Tensors { const bf16_t* Q; const bf16_t* K; const bf16_t* V; bf16_t* MIX; float* scr; const float* g; float lam, oml; };
constexpr int MIXP = 2560, MIX_ATT = 1536, KTILES = 260;
template <bool ROTL> __device__ __forceinline__ void attn_unit(int h, int q0, int NT, const Tensors& T, char* lds) {
  int tid_ = threadIdx.x; asm volatile("" : "+v"(tid_));
  const int tid = tid_, wid = tid >> 6, lane = tid & 63, r32 = lane & 31, hi = lane >> 5;
  float* li_l = (float*)(lds + LDS_WS) + wid * 64 + 32;
  f32x16 o[4]; float l_reg;
  attn_pass<8, ROTL>(T.Q + (long)q0 * PITCH + h * 128 + 64, T.K + (size_t)(h * 2 + 1) * KTILES * 4096, T.V + (size_t)h * KTILES * 8192, NT, lds, o, l_reg);
  if (hi == 0) li_l[r32] = l_reg; asm volatile("s_waitcnt lgkmcnt(0)" ::: "memory");
  {
    float rli[16];
#pragma unroll
    for (int r = 0; r < 16; ++r) rli[r] = __builtin_amdgcn_rcpf(li_l[crow(r, hi)]);
    typedef float f4 __attribute__((ext_vector_type(4)));
    A_GAS f4* sp = (A_GAS f4*)(T.scr + (size_t)tid * 64);
#pragma unroll
    for (int d0 = 0; d0 < 4; ++d0)
#pragma unroll
      for (int r4 = 0; r4 < 4; ++r4) sp[d0 * 4 + r4] = (f4){o[d0][4 * r4] * rli[4 * r4], o[d0][4 * r4 + 1] * rli[4 * r4 + 1], o[d0][4 * r4 + 2] * rli[4 * r4 + 2], o[d0][4 * r4 + 3] * rli[4 * r4 + 3]};
  }
  asm volatile("s_waitcnt vmcnt(0) lgkmcnt(0)" ::: "memory");
  attn_pass<8, ROTL>(T.Q + (long)q0 * PITCH + h * 128, T.K + (size_t)(h * 2) * KTILES * 4096, T.V + (size_t)h * KTILES * 8192, NT, lds, o, l_reg);
  if (hi == 0) li_l[r32] = l_reg; asm volatile("s_waitcnt lgkmcnt(0)" ::: "memory");
  float ss[16];
#pragma unroll
  for (int r = 0; r < 16; ++r) ss[r] = 0.f;
  { typedef float f4 __attribute__((ext_vector_type(4)));
    const A_GAS f4* sp = (const A_GAS f4*)(T.scr + (size_t)tid * 64);
#pragma unroll
    for (int r4 = 0; r4 < 4; ++r4) { float rl[4];
#pragma unroll
      for (int q = 0; q < 4; ++q) rl[q] = __builtin_amdgcn_rcpf(li_l[crow(4 * r4 + q, hi)]);
#pragma unroll
      for (int d0 = 0; d0 < 4; ++d0) { const f4 p2 = sp[d0 * 4 + r4];
#pragma unroll
        for (int q = 0; q < 4; ++q) { const float v = o[d0][4 * r4 + q] * rl[q] - T.lam * p2[q]; o[d0][4 * r4 + q] = v; ss[4 * r4 + q] += v * v; } } } }
#pragma unroll
  for (int r = 0; r < 16; ++r) {
#pragma unroll
    for (int x = 1; x < 32; x <<= 1) ss[r] += __shfl_xor(ss[r], x);
    ss[r] = T.oml / sqrtf(ss[r] * (1.f / 128.f) + 1e-6f); }
  float gv[4];
#pragma unroll
  for (int d0 = 0; d0 < 4; ++d0) gv[d0] = ((const A_GAS float*)T.g)[d0 * 32 + r32];
  A_GAS bf16_t* Ow = (A_GAS bf16_t*)T.MIX + (long)(q0 + wid * QBLK) * MIXP + MIX_ATT + h * 128;
#pragma unroll
  for (int r = 0; r < 16; ++r) { const int orow = crow(r, hi);
#pragma unroll
    for (int d0 = 0; d0 < 4; ++d0) { const unsigned w = cvtpk(o[d0][r] * ss[r] * gv[d0], 0.f); Ow[(long)orow * MIXP + d0 * 32 + r32] = (bf16_t)(w & 0xffffu); } }
  asm volatile("s_waitcnt vmcnt(0) lgkmcnt(0)" ::: "memory");
  __syncthreads();
}
#undef A_WAITBAR
#undef A_LGKBAR
#undef A_SBAR
}
#define GAS __attribute__((address_space(1)))
#define LAS __attribute__((address_space(3)))
typedef unsigned short bf16;
typedef unsigned v4u __attribute__((ext_vector_type(4)));
typedef float f32x4 __attribute__((ext_vector_type(4)));
typedef short bf16x8 __attribute__((ext_vector_type(8)));
typedef GAS unsigned gu32;
typedef GAS unsigned long long gu64;
#define RLX_AGENT __ATOMIC_RELAXED, __HIP_MEMORY_SCOPE_AGENT
#define LDS_WAIT() asm volatile("s_waitcnt lgkmcnt(0)" ::: "memory")
#define VM_WAIT() asm volatile("s_waitcnt vmcnt(0)" ::: "memory")
__device__ __forceinline__ unsigned long long rt() { return __builtin_amdgcn_s_memrealtime(); }
__device__ __forceinline__ unsigned f2bf(float f) { unsigned u = __builtin_bit_cast(unsigned, f); return (u + 0x7fffu + ((u >> 16) & 1u)) >> 16; }
__device__ __forceinline__ unsigned pk2(float lo, float hi) { return f2bf(lo) | (f2bf(hi) << 16); }

#define XB_TMO      128
#define XB_XCNT(j)  (256  + 64 * (j))
#define XB_XSUB(j)  (1280 + 64 * (j))
#define XB_XGEN(j)  (2304 + 64 * (j))
#define XB_TOP      3328
#define XB_TOPGEN   3392
#define XCD_BAR_WORDS 3456
#define XB_SPIN_CAP (1u << 18)

__device__ __forceinline__ unsigned xb_ld(unsigned* p)              { return __hip_atomic_load(p, __ATOMIC_RELAXED, __HIP_MEMORY_SCOPE_AGENT); }
__device__ __forceinline__ unsigned xb_add(unsigned* p, unsigned v) { return __hip_atomic_fetch_add(p, v, __ATOMIC_RELAXED, __HIP_MEMORY_SCOPE_AGENT); }
__device__ __forceinline__ unsigned xb_xcc_id() { return (unsigned)__builtin_amdgcn_s_getreg((3 << 11) | 20) & 0xFu; }
#define XB_SPIN(cond, bar) do { unsigned _sp = 0; while (cond) { __builtin_amdgcn_s_sleep(1); \
    if ((++_sp & 255u) == 0u) { if (xb_ld(&(bar)[XB_TMO])) break; if (_sp > XB_SPIN_CAP) { atomicAdd(&(bar)[XB_TMO], 1u); break; } } } } while (0)

struct XcdBarrier {
    unsigned* bar; unsigned x;
    volatile LAS unsigned* st;
};

__device__ __forceinline__ XcdBarrier xcd_barrier_post(unsigned* bar, volatile LAS unsigned* st) {
    XcdBarrier b; b.bar = bar; b.x = xb_xcc_id(); b.st = st;
    if (threadIdx.x == 0) (void)xb_add(&bar[XB_XCNT(b.x)], 1u);
    return b;
}
__device__ __forceinline__ void xcd_barrier_complete(unsigned* bar, unsigned x, unsigned& nloc, unsigned& nx) {
    const unsigned G = gridDim.x * gridDim.y * gridDim.z;
    unsigned sum, cnt, mine, sp = 0u;
    for (;;) {
        sum = 0u; cnt = 0u; mine = 0u;
#pragma unroll
        for (unsigned j = 0; j < 16; ++j) { const unsigned c = xb_ld(&bar[XB_XCNT(j)]); sum += c; cnt += (c > 0u) ? 1u : 0u; mine = (j == x) ? c : mine; }
        if (sum == G) break;
        __builtin_amdgcn_s_sleep(1);
        if ((++sp & 255u) == 0u) { if (xb_ld(&bar[XB_TMO])) break; if (sp > XB_SPIN_CAP) { atomicAdd(&bar[XB_TMO], 1u); break; } }
    }
    nloc = mine > 0u ? mine : 1u; nx = cnt > 0u ? cnt : 1u;
}

__device__ __forceinline__ void xcd_barrier(const XcdBarrier& b) {
    asm volatile("s_waitcnt vmcnt(0)" ::: "memory");
    __syncthreads();
    if (threadIdx.x == 0) {
        unsigned* bar = b.bar;
        __builtin_amdgcn_s_waitcnt(0);
        unsigned nloc = b.st[0], nx = b.st[1];
        if (nloc == 0u) { xcd_barrier_complete(bar, b.x, nloc, nx); b.st[0] = nloc; b.st[1] = nx; }
        const unsigned old = xb_add(&bar[XB_XSUB(b.x)], 1u);
        const unsigned gen = old / nloc;
        if (old + 1u == (gen + 1u) * nloc) {
            __builtin_amdgcn_fence(__ATOMIC_RELEASE, "agent");
            asm volatile("s_waitcnt vmcnt(0)" ::: "memory");
            const unsigned og = xb_add(&bar[XB_TOP], 1u);
            const unsigned tg = og / nx;
            if (og + 1u == (tg + 1u) * nx) xb_add(&bar[XB_TOPGEN], 1u);
            else XB_SPIN(xb_ld(&bar[XB_TOPGEN]) == tg, bar);
            __builtin_amdgcn_fence(__ATOMIC_ACQUIRE, "agent");
            xb_add(&bar[XB_XGEN(b.x)], 1u);
            asm volatile("s_waitcnt vmcnt(0)" ::: "memory");
        } else {
            XB_SPIN(xb_ld(&bar[XB_XGEN(b.x)]) == gen, bar);
            __builtin_amdgcn_fence(__ATOMIC_ACQUIRE, "agent");
            asm volatile("s_waitcnt vmcnt(0)" ::: "memory");
        }
    }
    __syncthreads();
}
constexpr int DM = 2048, SEQ = 16384, CTXL = 256, ROWS = SEQ + CTXL, NMT = ROWS / 256;
constexpr int DIN = 4608, NMODV = 6 * DM, DEPTH = 2, NE = 32, DE = 512, NIN = 31;
constexpr int MIXP = 2560;
constexpr float LN_EPS = 1e-6f, ALPHA = 1.4142135623730951f;
constexpr float QSCALE = 0.125f * 1.4426950408889634f;
constexpr int LCAP = ROWS;
constexpr int NPH = 2 + 9 * DEPTH;

constexpr size_t MiB = 1u << 20, KiB = 1024;
constexpr size_t WS_CTL = 0, CTL_ZERO_BYTES = 128 * KiB;
constexpr size_t WS_MOD = 1 * MiB;
constexpr size_t WS_SMALL = 2 * MiB;
constexpr size_t WS_BINP = WS_SMALL, WS_ROPE = WS_SMALL + 64 * KiB, WS_BTA = WS_SMALL + 128 * KiB, WS_BTB = WS_SMALL + 192 * KiB, WS_F256 = WS_SMALL + 320 * KiB,
                 WS_LAMV = WS_SMALL + 576 * KiB, WS_CS128 = WS_SMALL + 640 * KiB  ;
constexpr size_t WS_WRT = 3 * MiB;
constexpr size_t WS_MODP = 4 * MiB;
constexpr size_t WS_WOT = 10 * MiB;
constexpr size_t WS_HB = 18 * MiB, WS_PWB = 21 * MiB;
constexpr size_t WS_WCAT = 26 * MiB;
constexpr size_t WS_WIN = 46 * MiB;
constexpr size_t WS_WGU = 82 * MiB;
constexpr size_t WS_WD = 210 * MiB;
constexpr size_t WS_XN = 274 * MiB;
constexpr size_t QKV_BYTES = (size_t)ROWS * 1024 * 2;
constexpr size_t WS_Q = 339 * MiB, WS_K = WS_Q + QKV_BYTES, WS_V = WS_K + QKV_BYTES, WS_AG = WS_V + QKV_BYTES;
constexpr size_t WS_YK = WS_Q;
constexpr size_t WS_UF = 469 * MiB, WS_UFC = 485 * MiB, WS_PF2 = 486 * MiB;
constexpr size_t WS_MIX = 518 * MiB;
constexpr size_t WS_T = 600 * MiB;
constexpr size_t WS_X2 = 730 * MiB;
constexpr size_t WS_ACT = 860 * MiB;
constexpr size_t WS_DMIX = WS_ACT;
constexpr size_t WS_O2N = 902 * MiB;
static_assert(WS_DMIX + (size_t)ROWS * DM * 2 <= 934 * MiB, "Dmix overlays ACT | O2N");
constexpr size_t WS_LIST = 934 * MiB;
constexpr size_t WS_WTOK = 939 * MiB;
constexpr size_t WS_END = 940 * MiB;
static_assert(WS_AG + QKV_BYTES <= WS_UF && WS_XN + (size_t)ROWS * DM * 2 <= WS_Q && WS_MIX + (size_t)ROWS * MIXP * 2 <= WS_T && WS_T + (size_t)ROWS * DM * 4 <= WS_X2 && WS_X2 + (size_t)ROWS * DM * 4 <= WS_ACT, "ws map");
static_assert(WS_WIN + (size_t)2 * DIN * DM * 2 <= WS_WGU && WS_WGU + (size_t)NE * 1024 * DM * 2 <= WS_WD && WS_WD + (size_t)NE * DM * DE * 2 <= WS_XN && WS_WCAT + (size_t)2 * DM * MIXP * 2 <= WS_WIN, "ws map 2");
constexpr int CW_TMO = 0, CW_CODE = 1, CW_BAR = 4096, CW_CNT = 16384;
static_assert((size_t)(CW_CNT + 2 * 32 * 64) * 4 <= CTL_ZERO_BYTES, "control words inside the per-call memset");

constexpr int RING_OFF = 0, RING_BYTES = 139264;
constexpr int LDSCTL_OFF = RING_BYTES, MISC_OFF = LDSCTL_OFF + 320;
constexpr int LDS_BYTES = 147456;
constexpr int NWAVES = 8;

typedef float f32x2v __attribute__((ext_vector_type(2)));
typedef unsigned u32x2v __attribute__((ext_vector_type(2)));
using pg8::Unit;

__device__ __forceinline__ unsigned cvtpk(float lo, float hi) { unsigned r; asm volatile("v_cvt_pk_bf16_f32 %0, %1, %2" : "=v"(r) : "v"(lo), "v"(hi)); return r; }
__device__ __forceinline__ bf16 bf1(float x) { return (bf16)(cvtpk(x, 0.f) & 0xffffu); }
__device__ __forceinline__ float bf2f(unsigned short b) { return __uint_as_float((unsigned)b << 16); }
__device__ __forceinline__ float wave_sum(float v) {
#pragma unroll
    for (int o = 1; o < 64; o <<= 1) v += __shfl_xor(v, o);
    return v;
}
__device__ __forceinline__ float silu_f(float x) { return x / (1.f + __expf(-x)); }

struct Frame {
    LAS unsigned char* lds;
    volatile LAS unsigned* MISC;
    gu32* ctl;
    int tid, lane, wave;
    int vcu, G;
    const float* const* in; float* out; unsigned char* ws;
};

struct SchedWin { pg8::GridOrder go;
    __device__ __forceinline__ bool next(int i, Unit& u) const { return go.next(i, u); }
    __device__ __forceinline__ int arow(const Unit& u, int R) const { return (u.pn < 2 && u.pm >= 1) ? CTXL + 128 * (R & 127) + 2 * (u.pm - 1) + (R >> 7) : u.pm * 256 + R; }
    __device__ __forceinline__ int brow(const Unit& u) const { return u.pn * 256; } };
struct SchedNat { pg8::GridOrder go; int pmoff;
    __device__ __forceinline__ bool next(int i, Unit& u) const { if (!go.next(i, u)) return false; u.pm += pmoff; return true; }
    __device__ __forceinline__ int arow(const Unit& u, int R) const { return u.pm * 256 + R; }
    __device__ __forceinline__ int brow(const Unit& u) const { return u.pn * 256; } };
struct SchedFA { pg8::GridOrder go;
    __device__ __forceinline__ bool next(int i, Unit& u) const { return go.next(i, u); }
    __device__ __forceinline__ int arow(const Unit& u, int R) const { return (u.pm & 255) * 256 + R; }
    __device__ __forceinline__ int brow(const Unit&) const { return 0; } };
struct SchedFB { pg8::GridOrder go;
    __device__ __forceinline__ bool next(int i, Unit& u) const { return go.next(i, u); }
    __device__ __forceinline__ int arow(const Unit& u, int R) const { return (16 * (u.pm >> 3) + (R & 15)) * 128 + 16 * (u.pm & 7) + (R >> 4); }
    __device__ __forceinline__ int brow(const Unit&) const { return 0; } };
template <int WHICH> struct SchedMoe {
    const LAS int* tstart; const LAS int* cnt; const int* list; int G, c;
    static constexpr int NPN = WHICH == 1 ? 4 : 8;
    __device__ __forceinline__ bool next(int i, Unit& u) const {
        int L = i * G + c; const int nun = tstart[NE] * NPN; u.hb = -1;
        if (WHICH == 1 && nun > 2 * G && nun - 2 * G <= G / 2) {
            if (i == 2) { if (c >= 2 * (nun - 2 * G)) return false; L = 2 * G + (c >> 1); u.hb = c & 1; } else if (i > 2) return false; }
        const int gt = L / NPN; if (gt >= tstart[NE]) return false;
        int e = 0; while (tstart[e + 1] <= gt) ++e;
        u.pm = gt; u.pn = L % NPN; u.e = e; u.rt = gt - tstart[e]; return true; }
    __device__ __forceinline__ int arow(const Unit& u, int R) const {
        if (WHICH == 2) return u.pm * 256 + R;
        const int slot = u.rt * 256 + R; return slot < cnt[u.e] ? (((const GAS int*)list)[u.e * LCAP + slot] >> 1) : 0; }
    __device__ __forceinline__ int brow(const Unit& u) const { return WHICH == 1 ? u.e * 1024 + u.pn * 256 : u.e * DM + u.pn * 256; } };

struct EpiWin {
    static constexpr bool PERM = true;
    bf16 *Uf, *UfC, *AG, *Q, *Kb, *V; const float* bias; const f32x2v* rope;
    __device__ __forceinline__ void operator()(const f32x4 (&acc)[2][2][4][2], const Unit& u, int wr, int wc, int fr, int fq) const {
        const int pn = u.pn, pm = u.pm, c0 = wc * 32 + 8 * fq;
        f32x4 bv[2][2];
#pragma unroll
        for (int bj = 0; bj < 2; ++bj)
#pragma unroll
            for (int n = 0; n < 2; ++n) bv[bj][n] = *(const GAS f32x4*)(bias + pn * 256 + bj * 128 + c0 + 4 * n);
        if (pn < 2) {
#pragma unroll
            for (int ai = 0; ai < 2; ++ai)
#pragma unroll
                for (int m = 0; m < 4; ++m)
#pragma unroll
                    for (int bj = 0; bj < 2; ++bj) {
                        const f32x4 v0 = acc[ai][bj][m][0] + bv[bj][0], v1 = acc[ai][bj][m][1] + bv[bj][1];
                        const int ch = pn * 256 + bj * 128 + c0, a = wr * 64 + m * 16 + fr;
                        GAS bf16* dst; size_t st;
                        if (pm == 0) { dst = (GAS bf16*)UfC + (size_t)ch * 256 + (ai * 128 + a); st = 256; }
                        else { dst = (GAS bf16*)Uf + ((size_t)ch * 128 + (2 * (pm - 1) + ai)) * 128 + a; st = 128 * 128; }
                        dst[0] = bf1(v0[0]); dst[st] = bf1(v0[1]); dst[2 * st] = bf1(v0[2]); dst[3 * st] = bf1(v0[3]);
                        dst[4 * st] = bf1(v1[0]); dst[5 * st] = bf1(v1[1]); dst[6 * st] = bf1(v1[2]); dst[7 * st] = bf1(v1[3]);
                    }
        } else if (pn < 6) {
            bf16* base = AG; const int colt = (pn - 2) * 256;
#pragma unroll
            for (int ai = 0; ai < 2; ++ai)
#pragma unroll
                for (int m = 0; m < 4; ++m) { bf16* rowp = base + (size_t)(pm * 256 + ai * 128 + wr * 64 + m * 16 + fr) * 1024 + colt + c0;
#pragma unroll
                    for (int bj = 0; bj < 2; ++bj) { const f32x4 v0 = acc[ai][bj][m][0] + bv[bj][0], v1 = acc[ai][bj][m][1] + bv[bj][1];
                        v4u w; w.x = cvtpk(v0[0], v0[1]); w.y = cvtpk(v0[2], v0[3]); w.z = cvtpk(v1[0], v1[1]); w.w = cvtpk(v1[2], v1[3]);
                        *(GAS v4u*)(rowp + bj * 128) = w; } }
        } else if (pn >= 14) {
#pragma unroll
            for (int ai = 0; ai < 2; ++ai)
#pragma unroll
                for (int m = 0; m < 4; ++m) { const int row = pm * 256 + ai * 128 + wr * 64 + m * 16 + fr, t = row >> 6, key = row & 63;
#pragma unroll
                    for (int bj = 0; bj < 2; ++bj) { const f32x4 v0 = acc[ai][bj][m][0] + bv[bj][0], v1 = acc[ai][bj][m][1] + bv[bj][1];
                        v4u w; w.x = cvtpk(v0[0], v0[1]); w.y = cvtpk(v0[2], v0[3]); w.z = cvtpk(v1[0], v1[1]); w.w = cvtpk(v1[2], v1[3]);
                        const int h = 2 * (pn - 14) + bj;
                        *(GAS v4u*)(V + ((((size_t)h * 260 + t) * 16 + (c0 >> 5) * 4 + (key >> 4)) * 16 + (key & 15)) * 32 + (c0 & 31)) = w; } }
        } else {
            const bool isq = pn < 10; const int colt = (pn - (isq ? 6 : 10)) * 256; const float sc = isq ? QSCALE : 1.f;
#pragma unroll
            for (int ai = 0; ai < 2; ++ai)
#pragma unroll
                for (int m = 0; m < 4; ++m) { const int row = pm * 256 + ai * 128 + wr * 64 + m * 16 + fr;
                    f32x4 cs0 = (f32x4){1.f, 0.f, 1.f, 0.f}, cs1 = cs0;
                    if (pm > 0) { const int pos = row - CTXL; const int t = (wc & 1) ? 256 + (pos & 63) : (pos >> 6);
                        const GAS f32x4* rp = (const GAS f32x4*)(rope + t * 16 + 4 * fq); cs0 = rp[0]; cs1 = rp[1]; }
#pragma unroll
                    for (int bj = 0; bj < 2; ++bj) { const f32x4 v0 = acc[ai][bj][m][0] + bv[bj][0], v1 = acc[ai][bj][m][1] + bv[bj][1];
                        const float o0 = (v0[0] * cs0[0] - v0[1] * cs0[1]) * sc, o1 = (v0[0] * cs0[1] + v0[1] * cs0[0]) * sc;
                        const float o2 = (v0[2] * cs0[2] - v0[3] * cs0[3]) * sc, o3 = (v0[2] * cs0[3] + v0[3] * cs0[2]) * sc;
                        const float o4 = (v1[0] * cs1[0] - v1[1] * cs1[1]) * sc, o5 = (v1[0] * cs1[1] + v1[1] * cs1[0]) * sc;
                        const float o6 = (v1[2] * cs1[2] - v1[3] * cs1[3]) * sc, o7 = (v1[2] * cs1[3] + v1[3] * cs1[2]) * sc;
                        v4u w; w.x = cvtpk(o0, o1); w.y = cvtpk(o2, o3); w.z = cvtpk(o4, o5); w.w = cvtpk(o6, o7);
                        if (isq) *(GAS v4u*)(Q + (size_t)row * 1024 + colt + bj * 128 + c0) = w;
                        else {
                            const int h = (colt >> 7) + bj, t = row >> 6, key = row & 63;
                            *(GAS v4u*)(Kb + (((((size_t)(h * 2 + (c0 >> 6))) * 260 + t) * 8 + ((c0 & 63) >> 3)) * 64 + key) * 8) = w; } } }
        }
    }
};
struct EpiFA {
    static constexpr bool PERM = false;
    bf16* Pf2;
    __device__ __forceinline__ void operator()(const f32x4 (&acc)[2][2][4][2], const Unit& u, int wr, int wc, int fr, int fq) const {
#pragma unroll
        for (int m = 0; m < 4; ++m) { const int b = wr * 64 + m * 16 + fr;
#pragma unroll
            for (int n = 0; n < 2; ++n)
#pragma unroll
                for (int j = 0; j < 4; ++j) { const int klo = 32 * wc + 16 * n + 4 * fq + j;
                    const float f = (float)((b * klo) & 16383) * (1.f / 16384.f);
                    const float c = __builtin_amdgcn_cosf(f), s = __builtin_amdgcn_sinf(f);
#pragma unroll
                    for (int ai = 0; ai < 2; ++ai) { const float re = acc[ai][0][m][n][j], im = acc[ai][1][m][n][j];
                        GAS bf16* d = (GAS bf16*)Pf2 + (size_t)((2 * (u.pm & 255) + ai) * 128 + klo) * 256 + b;
                        d[0] = bf1(re * c + im * s); d[128] = bf1(im * c - re * s); } }
            asm volatile("" ::: "memory"); }
    }
};
struct EpiFB {
    static constexpr bool PERM = false;
    bf16* MIX;
    __device__ __forceinline__ void operator()(const f32x4 (&acc)[2][2][4][2], const Unit& u, int wr, int wc, int fr, int fq) const {
        const int ch = 16 * (u.pm >> 3) + fr;
#pragma unroll
        for (int ai = 0; ai < 2; ++ai)
#pragma unroll
            for (int m = 0; m < 4; ++m) { const int klo = 16 * (u.pm & 7) + 8 * ai + 4 * wr + m;
#pragma unroll
                for (int bj = 0; bj < 2; ++bj)
#pragma unroll
                    for (int n = 0; n < 2; ++n)
#pragma unroll
                        for (int j = 0; j < 4; ++j) { const int khi = 32 * wc + 16 * n + 4 * fq + j;
                            ((GAS bf16*)MIX)[(size_t)(CTXL + klo + 128 * khi) * MIXP + bj * 512 + ch] = bf1(acc[ai][bj][m][n][j]); }
                asm volatile("" ::: "memory"); }
    }
};
struct EpiCtxF {
    static constexpr bool PERM = false;
    bf16* MIX;
    __device__ __forceinline__ void operator()(const f32x4 (&acc)[2][2][4][2], const Unit& u, int wr, int wc, int fr, int fq) const {
#pragma unroll
        for (int ai = 0; ai < 2; ++ai)
#pragma unroll
            for (int m = 0; m < 4; ++m) { const int k = ai * 128 + wr * 64 + m * 16 + fr;
#pragma unroll
                for (int bj = 0; bj < 2; ++bj)
#pragma unroll
                    for (int n = 0; n < 2; ++n) { const f32x4 v = acc[ai][bj][m][n]; u32x2v w; w.x = cvtpk(v[0], v[1]); w.y = cvtpk(v[2], v[3]);
                        *(GAS u32x2v*)(MIX + (size_t)k * MIXP + u.pm * 512 + u.pn * 256 + bj * 128 + wc * 32 + 16 * n + 4 * fq) = w; }
                asm volatile("" ::: "memory"); }
    }
};
struct EpiWout {
    static constexpr bool PERM = true;
    const float* mod; bf16* Dm;
    __device__ __forceinline__ void operator()(const f32x4 (&acc)[2][2][4][2], const Unit& u, int wr, int wc, int fr, int fq) const {
        const int col0 = u.pn * 256 + wc * 32 + 8 * fq;
        const float* gp = mod + (u.pm == 0 ? NMODV : 0) + 2 * DM + col0;
        f32x4 gv[2][2];
#pragma unroll
        for (int bj = 0; bj < 2; ++bj)
#pragma unroll
            for (int n = 0; n < 2; ++n) gv[bj][n] = *(const GAS f32x4*)(gp + bj * 128 + 4 * n);
#pragma unroll
        for (int ai = 0; ai < 2; ++ai)
#pragma unroll
            for (int m = 0; m < 4; ++m) { bf16* rowp = Dm + (size_t)(u.pm * 256 + ai * 128 + wr * 64 + m * 16 + fr) * DM + col0;
#pragma unroll
                for (int bj = 0; bj < 2; ++bj) { const f32x4 v0 = acc[ai][bj][m][0] * gv[bj][0], v1 = acc[ai][bj][m][1] * gv[bj][1];
                    v4u w; w.x = cvtpk(v0[0], v0[1]); w.y = cvtpk(v0[2], v0[3]); w.z = cvtpk(v1[0], v1[1]); w.w = cvtpk(v1[2], v1[3]);
                    *(GAS v4u*)(rowp + bj * 128) = w; } }
    }
};
struct EpiFold {
    static constexpr bool PERM = true;
    bf16* out; int col0;
    __device__ __forceinline__ void operator()(const f32x4 (&acc)[2][2][4][2], const Unit& u, int wr, int wc, int fr, int fq) const {
        const int c0 = col0 + u.pn * 256 + wc * 32 + 8 * fq;
#pragma unroll
        for (int ai = 0; ai < 2; ++ai)
#pragma unroll
            for (int m = 0; m < 4; ++m) { bf16* rowp = out + (size_t)(u.pm * 256 + ai * 128 + wr * 64 + m * 16 + fr) * MIXP + c0;
#pragma unroll
                for (int bj = 0; bj < 2; ++bj) { const f32x4 v0 = acc[ai][bj][m][0], v1 = acc[ai][bj][m][1];
                    v4u w; w.x = cvtpk(v0[0], v0[1]); w.y = cvtpk(v0[2], v0[3]); w.z = cvtpk(v1[0], v1[1]); w.w = cvtpk(v1[2], v1[3]);
                    *(GAS v4u*)(rowp + bj * 128) = w; } }
    }
};
struct EpiMoe1 {
    static constexpr bool PERM = true;
    bf16* ACT;
    __device__ __forceinline__ void operator()(const f32x4 (&acc)[2][2][4][2], const Unit& u, int wr, int wc, int fr, int fq) const {
#pragma unroll
        for (int ai = 0; ai < 2; ++ai)
#pragma unroll
            for (int m = 0; m < 4; ++m) { bf16* rowp = ACT + (size_t)(u.pm * 256 + ai * 128 + wr * 64 + m * 16 + fr) * DE + u.pn * 128 + wc * 16 + 4 * fq;
#pragma unroll
                for (int bj = 0; bj < 2; ++bj) { if (u.hb >= 0 && u.hb != bj) continue;
                    const f32x4 v0 = acc[ai][bj][m][0], v1 = acc[ai][bj][m][1];
                    u32x2v w; w.x = cvtpk(silu_f(v0[0]) * v0[1], silu_f(v0[2]) * v0[3]); w.y = cvtpk(silu_f(v1[0]) * v1[1], silu_f(v1[2]) * v1[3]);
                    *(GAS u32x2v*)(rowp + bj * 64) = w; } }
    }
};
struct EpiMoe2 {
    static constexpr bool PERM = true;
    const LAS int* cnt; const int* list; const float* wtok; bf16* YK;
    __device__ __forceinline__ void operator()(const f32x4 (&acc)[2][2][4][2], const Unit& u, int wr, int wc, int fr, int fq) const {
        const int n = cnt[u.e];
#pragma unroll
        for (int ai = 0; ai < 2; ++ai)
#pragma unroll
            for (int m = 0; m < 4; ++m) { const int slot = u.rt * 256 + ai * 128 + wr * 64 + m * 16 + fr;
                if (slot < n) { const int tk = ((const GAS int*)list)[u.e * LCAP + slot]; const float w8 = ((const GAS float*)wtok)[tk];
                    bf16* rowp = YK + (size_t)tk * DM + u.pn * 256 + wc * 32 + 8 * fq;
#pragma unroll
                    for (int bj = 0; bj < 2; ++bj) { const f32x4 v0 = acc[ai][bj][m][0] * w8, v1 = acc[ai][bj][m][1] * w8;
                        v4u w; w.x = cvtpk(v0[0], v0[1]); w.y = cvtpk(v0[2], v0[3]); w.z = cvtpk(v1[0], v1[1]); w.w = cvtpk(v1[2], v1[3]);
                        *(GAS v4u*)(rowp + bj * 128) = w; } } }
    }
};
template <int MODE> __device__ __forceinline__ int t_rowmap(int n) {
    if (MODE == 2) return 2 * n; if (MODE == 3) return 2 * n + 1;
    if (MODE == 1) { if (n >= 1536 && n < 3584) { const int q = n - 1536, d = q & 63; return 1536 + (q & ~63) + (d < 32 ? 2 * d : 2 * (d - 32) + 1); } return n; }
    return n; }
struct TrLoad { f32x4 v[16]; };
__device__ __forceinline__ void tr_load(TrLoad& t, const float* W, int ldw, int nblk  , int item, int lane) {
    const int kb = item / nblk, nb = item % nblk, k0 = 64 * kb, n0 = 64 * nb, lr = lane >> 4, lc = (lane & 15) * 4;
#pragma unroll
    for (int i = 0; i < 16; ++i) t.v[i] = *(const GAS f32x4*)(W + (size_t)(k0 + 4 * i + lr) * ldw + n0 + lc);
}
template <int MODE> __device__ __forceinline__ void tr_finish(const TrLoad& t, int nblk, bf16* WT, int dpitch, int dcol0, LAS float* scr, int item, int lane) {
    const int kb = item / nblk, nb = item % nblk, k0 = 64 * kb, n0 = 64 * nb, lr = lane >> 4, lc = (lane & 15) * 4;
#pragma unroll
    for (int i = 0; i < 16; ++i) { LAS float* d = scr + (4 * i + lr) * 65 + lc; d[0] = t.v[i][0]; d[1] = t.v[i][1]; d[2] = t.v[i][2]; d[3] = t.v[i][3]; }
    LDS_WAIT(); asm volatile("" ::: "memory");
    const int c = lane & 7;
#pragma unroll
    for (int j = 0; j < 8; ++j) { const int n = (lane >> 3) + 8 * j; const LAS float* s = scr + (8 * c) * 65 + n;
        v4u o; o.x = pk2(s[0 * 65], s[1 * 65]); o.y = pk2(s[2 * 65], s[3 * 65]); o.z = pk2(s[4 * 65], s[5 * 65]); o.w = pk2(s[6 * 65], s[7 * 65]);
        *(GAS v4u*)(WT + (size_t)t_rowmap<MODE>(n0 + n) * dpitch + dcol0 + k0 + 8 * c) = o; }
    LDS_WAIT(); asm volatile("" ::: "memory");
}
template <int MODE> __device__ __forceinline__ void transpose_item(const float* W, int ldw, int nblk, bf16* WT, int dpitch, int dcol0, LAS float* scr, int item, int lane) {
    TrLoad t; tr_load(t, W, ldw, nblk, item, lane); tr_finish<MODE>(t, nblk, WT, dpitch, dcol0, scr, item, lane);
}
__device__ __forceinline__ void convert_experts(Frame& F, int l, LAS float* scr) {
    const int gw = F.vcu * NWAVES + F.wave, NGW = F.G * NWAVES;
    bf16* WGU = (bf16*)(F.ws + WS_WGU); bf16* WD = (bf16*)(F.ws + WS_WD);
    for (int it = gw; it < NE * 768; it += NGW) { const int e = it / 768, r = it % 768;
        if (r < 256) transpose_item<2>(F.in[26] + (size_t)(l * NE + e) * DM * DE, DE, 8, WGU + (size_t)e * 1024 * DM, DM, 0, scr, r, F.lane);
        else if (r < 512) transpose_item<3>(F.in[27] + (size_t)(l * NE + e) * DM * DE, DE, 8, WGU + (size_t)e * 1024 * DM, DM, 0, scr, r - 256, F.lane);
        else transpose_item<0>(F.in[28] + (size_t)(l * NE + e) * DE * DM, DM, 32, WD + (size_t)e * DM * DE, DE, 0, scr, r - 512, F.lane); }
}
__device__ __forceinline__ void f32gemm_tile(const float* A, int lda, const float* B, int ldb, int Kd, int mb, int nb, int lane, f32x4 (&acc)[4]) {
    const int n = nb * 256 + lane * 4;
#pragma unroll
    for (int i = 0; i < 4; ++i) acc[i] = (f32x4){0.f, 0.f, 0.f, 0.f};
    const float* a0 = A + (size_t)(mb * 4) * lda;
#pragma unroll 8
    for (int k = 0; k < Kd; ++k) { const f32x4 b = *(const GAS f32x4*)(B + (size_t)k * ldb + n);
#pragma unroll
        for (int i = 0; i < 4; ++i) acc[i] += b * ((const GAS float*)a0)[(size_t)i * lda + k]; }
}

__device__ __forceinline__ void ph_prologue_a(Frame& F) {
    const int gw = F.vcu * NWAVES + F.wave, NGW = F.G * NWAVES;
    if (F.tid < 128) { float s_, c_; sincospif(2.0f * (float)F.tid / 128.0f, &s_, &c_); LAS float* cst = (LAS float*)(F.lds + LDSCTL_OFF + 2048); cst[F.tid] = c_; cst[128 + F.tid] = s_; }
    { LAS float* sil = (LAS float*)(F.lds + RING_OFF);
      for (int i = F.tid; i < 2 * DM; i += NWAVES * 64) { const float x = i < DM ? F.in[1][i] : F.in[3][i - DM]; sil[i] = silu_f(x); }
      __syncthreads();
      float* MODP = (float*)(F.ws + WS_T);
      for (int it = F.vcu; it < 64 * 12; it += F.G) { const int kc = it & 63, rest = it >> 6, l = rest / 6, jb = rest % 6, j = jb * 2048 + F.tid * 4;
          const float* W = F.in[4] + ((size_t)l * DM + kc * 32) * NMODV + j; f32x4 s0 = (f32x4){0.f, 0.f, 0.f, 0.f}, s1 = s0;
#pragma unroll 8
          for (int k = 0; k < 32; ++k) { const f32x4 w = *(const GAS f32x4*)(W + (size_t)k * NMODV); s0 += w * sil[kc * 32 + k]; s1 += w * sil[DM + kc * 32 + k]; }
          *(GAS f32x4*)(MODP + ((size_t)(kc * 2 + l) * 2 + 0) * NMODV + j) = s0; *(GAS f32x4*)(MODP + ((size_t)(kc * 2 + l) * 2 + 1) * NMODV + j) = s1; }
      __syncthreads(); }
    LAS float* scr = (LAS float*)(F.lds + RING_OFF + F.wave * 16896);
    for (int it = gw; it < 2 * 2304 + 2 * 512 + 2 * 512; it += NGW) {
        if (it < 4608) { const int l = it / 2304, r = it % 2304; transpose_item<1>(F.in[6] + (size_t)l * DM * DIN, DIN, 72, (bf16*)(F.ws + WS_WIN) + (size_t)l * DIN * DM, DM, 0, scr, r, F.lane); }
        else if (it < 5632) { const int q = it - 4608, l = q / 512, r = q % 512; transpose_item<0>(F.in[19] + (size_t)l * DM * DM + (size_t)1024 * DM, DM, 32, (bf16*)(F.ws + WS_WCAT) + (size_t)l * DM * MIXP, MIXP, 1536, scr, r, F.lane); }
        else { const int q = it - 5632, l = q / 512, r = q % 512; transpose_item<0>(F.in[19] + (size_t)l * DM * DM, DM, 32, (bf16*)(F.ws + WS_WOT) + (size_t)l * DM * 1024, 1024, 0, scr, r, F.lane); } }
    convert_experts(F, 0, scr);
    { const LAS float* cst = (const LAS float*)(F.lds + LDSCTL_OFF + 2048);
      for (int wt = gw; wt < 2 * 8 * 64; wt += NGW) { const int sel = wt >> 6, l = sel >> 3, part = (sel >> 2) & 1, g = sel & 3, r = wt & 63, mb = r >> 1, nb = r & 1;
          const float* B = F.in[8] + (size_t)l * 512 * 512 + (size_t)(128 * g) * 512; const int n = nb * 256 + F.lane * 4;
          f32x4 acc[4];
#pragma unroll
          for (int i = 0; i < 4; ++i) acc[i] = (f32x4){0.f, 0.f, 0.f, 0.f};
#pragma unroll 8
          for (int j = 0; j < 128; ++j) { const f32x4 b = *(const GAS f32x4*)(B + (size_t)j * 512 + n);
#pragma unroll
              for (int i = 0; i < 4; ++i) acc[i] += b * cst[part * 128 + (((mb * 4 + i) * j) & 127)]; }
          bf16* HB = (bf16*)(F.ws + WS_HB) + (size_t)l * 1024 * 512; const float sc = 0.08838834764831845f;
#pragma unroll
          for (int i = 0; i < 4; ++i) { u32x2v w; w.x = cvtpk(acc[i][0] * sc, acc[i][1] * sc); w.y = cvtpk(acc[i][2] * sc, acc[i][3] * sc);
              *(GAS u32x2v*)(HB + (size_t)(part * 512 + g * 128 + mb * 4 + i) * 512 + n) = w; } }
      const int gt = F.vcu * NWAVES * 64 + F.tid, NTH = F.G * NWAVES * 64;
      for (int idx = gt; idx < 2 * 512 * 512 / 4; idx += NTH) { const f32x4 v = *(const GAS f32x4*)(F.in[13] + (size_t)idx * 4);
          u32x2v w; w.x = cvtpk(v[0], v[1]); w.y = cvtpk(v[2], v[3]); *(GAS u32x2v*)((bf16*)(F.ws + WS_PWB) + (size_t)idx * 4) = w; } }
    { const int gt = F.vcu * NWAVES * 64 + F.tid, NT = F.G * NWAVES * 64;
      constexpr int R0 = 9216, R1 = R0 + 5120, R2 = R1 + 32768, R3 = R2 + 65536, R4 = R3 + 131072, R5 = R4 + 32768, R6 = R5 + 49152, R7 = R6 + 2;
      for (int idx = gt; idx < R7; idx += NT) {
          if (idx < R0) { const int l = idx / DIN, c = idx % DIN; int src = c;
              if (c >= 1536 && c < 3584) { const int q = c - 1536, p = q & 63; src = 1536 + (q & ~63) + (p & 1) * 32 + (p >> 1); }
              ((float*)(F.ws + WS_BINP))[idx] = F.in[7][l * DIN + src]; }
          else if (idx < R1) { const int q = idx - R0, t = q >> 4, i = q & 15, p = t < 256 ? t : t - 256;
              const float inv = 1.0f / powf(10000.0f, (float)i / 16.0f), ang = (float)p * inv; float s, c; sincosf(ang, &s, &c);
              ((f32x2v*)(F.ws + WS_ROPE))[q] = (f32x2v){c, s}; }
          else if (idx < R2) { const int q = idx - R1, np = q >> 7, a = q & 127, kk = np & 127; float s, c; sincospif(2.0f * (float)((a * kk) & 127) / 128.0f, &s, &c);
              ((bf16*)(F.ws + WS_BTA))[q] = bf1((np < 128 ? c : -s) * 0.08838834764831845f); }
          else if (idx < R3) { const int q = idx - R2, np = q >> 8, k = q & 255, khi = np & 127, b = k & 127; float s, c; sincospif(2.0f * (float)((b * khi) & 127) / 128.0f, &s, &c);
              const float v = np < 128 ? (k < 128 ? c : s) : (k < 128 ? -s : c); ((bf16*)(F.ws + WS_BTB))[q] = bf1(v * 0.08838834764831845f); }
          else if (idx < R4) { const int q = idx - R3, r = q >> 8, n = q & 255, k = r & 255; float s, c; sincospif(2.0f * (float)((k * n) & 255) / 256.0f, &s, &c);
              ((bf16*)(F.ws + WS_F256))[q] = bf1((r < 256 ? c : -s) * 0.0625f); }
          else if (idx < R5) { const int q = idx - R4, part = q >> 14, m = (q >> 7) & 127, j = q & 127; float s, c; sincospif(2.0f * (float)((m * j) & 127) / 128.0f, &s, &c);
              ((float*)(F.ws + WS_CS128))[q] = part ? s : c; }
          else if (idx < R6) { const int q = idx - R5, l = q / 24576, r = q % 24576, hl = r / 12288, r2 = r % 12288, ks = r2 / 192, nt = (r2 / 64) % 3, ln = r2 & 63;
              const int n = 16 * nt + (ln & 15), k0 = 32 * ks + 8 * (ln >> 4); unsigned short o[8];
#pragma unroll
              for (int j = 0; j < 8; ++j) { const int k = k0 + j; float w = 0.f;
                  if (n < 4) w = F.in[22][((size_t)l * DM + k) * 4 + n]; else if (n < 36) w = F.in[24][((size_t)l * DM + k) * 32 + (n - 4)];
                  const unsigned short h = bf1(w); o[j] = hl ? bf1(w - bf2f(h)) : h; }
              v4u w4; w4.x = o[0] | ((unsigned)o[1] << 16); w4.y = o[2] | ((unsigned)o[3] << 16); w4.z = o[4] | ((unsigned)o[5] << 16); w4.w = o[6] | ((unsigned)o[7] << 16);
              ((v4u*)(F.ws + WS_WRT))[q] = w4; }
          else { const int l = idx - R6; float a = 0.f, b = 0.f;
              for (int i = 0; i < 64; ++i) { a += F.in[14][l * 64 + i] * F.in[15][l * 64 + i]; b += F.in[16][l * 64 + i] * F.in[17][l * 64 + i]; }
              const float lam_init = 0.8f - 0.6f * expf(-0.3f * (float)l);
              ((float*)(F.ws + WS_LAMV))[l] = expf(a) - expf(b) + lam_init; }
      } }
}
__device__ __forceinline__ void ph_prologue_b(Frame& F) {
    const int gw = F.vcu * NWAVES + F.wave, NGW = F.G * NWAVES;
    { const int gt = F.vcu * NWAVES * 64 + F.tid, NT = F.G * NWAVES * 64; const float* MODP = (const float*)(F.ws + WS_T); float* MOD = (float*)(F.ws + WS_MOD);
      for (int idx = gt; idx < 4 * NMODV; idx += NT) { const int lv = idx / NMODV, j = idx % NMODV, l = lv >> 1; float s = F.in[5][l * NMODV + j];
          for (int kc = 0; kc < 64; ++kc) s += MODP[((size_t)kc * 4 + lv) * NMODV + j];
          MOD[idx] = s; } }
#pragma unroll 1
    for (int l = 0; l < DEPTH; ++l) {
        { pg8::Gemm g{(const bf16*)(F.ws + WS_WOT) + (size_t)l * DM * 1024, (const bf16*)(F.ws + WS_HB) + (size_t)l * 1024 * 512, 512, 1024};
          SchedNat S; S.go.init(8, 4, F.G, (int)((blockIdx.x + F.G - 48 * l) % F.G)); S.pmoff = 0; EpiFold E{(bf16*)(F.ws + WS_WCAT) + (size_t)l * DM * MIXP, 0};
          pg8::gemm_phase<EpiFold, SchedNat>(F.lds + RING_OFF, g, S, E); }
        { pg8::Gemm g{(const bf16*)(F.ws + WS_WOT) + (size_t)l * DM * 1024 + 512, (const bf16*)(F.ws + WS_PWB) + (size_t)l * 512 * 512, 512, 1024};
          SchedNat S; S.go.init(8, 2, F.G, (int)((blockIdx.x + F.G - 48 * l - 32) % F.G)); S.pmoff = 0; EpiFold E{(bf16*)(F.ws + WS_WCAT) + (size_t)l * DM * MIXP, 1024};
          pg8::gemm_phase<EpiFold, SchedNat>(F.lds + RING_OFF, g, S, E); } }
}

struct RowV { f32x4 v[8]; };
__device__ __forceinline__ void row_load(RowV& r, const float* p, int lane) {
#pragma unroll
    for (int j = 0; j < 4; ++j) { r.v[2 * j] = *(const GAS f32x4*)(p + 512 * j + 8 * lane); r.v[2 * j + 1] = *(const GAS f32x4*)(p + 512 * j + 8 * lane + 4); } }
__device__ __forceinline__ void row_load_bf16(RowV& r, const bf16* p, int lane) {
#pragma unroll
    for (int j = 0; j < 4; ++j) { const v4u d = *(const GAS v4u*)(p + 512 * j + 8 * lane);
        r.v[2 * j] = (f32x4){__uint_as_float(d.x << 16), __uint_as_float(d.x & 0xffff0000u), __uint_as_float(d.y << 16), __uint_as_float(d.y & 0xffff0000u)};
        r.v[2 * j + 1] = (f32x4){__uint_as_float(d.z << 16), __uint_as_float(d.z & 0xffff0000u), __uint_as_float(d.w << 16), __uint_as_float(d.w & 0xffff0000u)}; } }
__device__ __forceinline__ void row_store(const RowV& r, float* p, int lane) {
#pragma unroll
    for (int j = 0; j < 4; ++j) { *(GAS f32x4*)(p + 512 * j + 8 * lane) = r.v[2 * j]; *(GAS f32x4*)(p + 512 * j + 8 * lane + 4) = r.v[2 * j + 1]; } }
__device__ __forceinline__ void row_norm(RowV& r) {
    float s = 0.f;
#pragma unroll
    for (int i = 0; i < 8; ++i) s += (r.v[i][0] + r.v[i][1]) + (r.v[i][2] + r.v[i][3]);
    const float mean = wave_sum(s) * (1.f / DM); float q = 0.f;
#pragma unroll
    for (int i = 0; i < 8; ++i) { r.v[i] = r.v[i] - mean; q += (r.v[i][0] * r.v[i][0] + r.v[i][1] * r.v[i][1]) + (r.v[i][2] * r.v[i][2] + r.v[i][3] * r.v[i][3]); }
    const float rstd = 1.f / sqrtf(wave_sum(q) * (1.f / DM) + LN_EPS);
#pragma unroll
    for (int i = 0; i < 8; ++i) r.v[i] = r.v[i] * rstd; }
__device__ __forceinline__ void row_affine(RowV& r, const float* mulp, float madd, const float* addp, int lane) {
#pragma unroll
    for (int j = 0; j < 4; ++j)
#pragma unroll
        for (int h = 0; h < 2; ++h) { const f32x4 m = *(const GAS f32x4*)(mulp + 512 * j + 8 * lane + 4 * h), a = *(const GAS f32x4*)(addp + 512 * j + 8 * lane + 4 * h);
            r.v[2 * j + h] = r.v[2 * j + h] * (m + madd) + a; } }
__device__ __forceinline__ void row_store_bf16(const RowV& r, bf16* p, int lane) {
#pragma unroll
    for (int j = 0; j < 4; ++j) { v4u w; w.x = cvtpk(r.v[2 * j][0], r.v[2 * j][1]); w.y = cvtpk(r.v[2 * j][2], r.v[2 * j][3]); w.z = cvtpk(r.v[2 * j + 1][0], r.v[2 * j + 1][1]); w.w = cvtpk(r.v[2 * j + 1][2], r.v[2 * j + 1][3]);
        *(GAS v4u*)(p + 512 * j + 8 * lane) = w; } }

__device__ __forceinline__ void ph_ln1(Frame& F, int l, const float* xc, const float* xl) {
    const int gw = F.vcu * NWAVES + F.wave, NGW = F.G * NWAVES; const float* MOD = (const float*)(F.ws + WS_MOD) + (size_t)l * 2 * NMODV; bf16* XN = (bf16*)(F.ws + WS_XN);
    for (int r = gw; r < ROWS; r += NGW) { const float* xp = r < CTXL ? xc + (size_t)r * DM : xl + (size_t)(r - CTXL) * DM; const float* mp = MOD + (r < CTXL ? NMODV : 0);
        RowV v; row_load(v, xp, F.lane); row_norm(v); row_affine(v, mp + DM, 1.f, mp, F.lane); row_store_bf16(v, XN + (size_t)r * DM, F.lane); }
}

__device__ __forceinline__ void conv_unit(Frame& F, int l, int ub) {
    const int row0 = 32 * ub, lo = row0 < CTXL ? 0 : CTXL, hi = row0 < CTXL ? CTXL : ROWS;
    const bf16* AG = (const bf16*)(F.ws + WS_AG); bf16* MIX = (bf16*)(F.ws + WS_MIX);
    LAS bf16* U = (LAS bf16*)(F.lds + RING_OFF);
    LAS float* Y = (LAS float*)(F.lds + RING_OFF + 65536);
    for (int it = F.tid; it < 62 * 64; it += NWAVES * 64) { const int t = it >> 6, c8 = (it & 63) * 8, gr = row0 - 15 + t;
        v4u o = (v4u){0u, 0u, 0u, 0u};
        if (gr >= lo && gr < hi) { const v4u a = *(const GAS v4u*)(AG + (size_t)gr * 1024 + c8), g = *(const GAS v4u*)(AG + (size_t)gr * 1024 + 512 + c8);
            const unsigned aw[4] = {a.x, a.y, a.z, a.w}, gw[4] = {g.x, g.y, g.z, g.w}; unsigned ow[4];
#pragma unroll
            for (int q = 0; q < 4; ++q) { const float a0 = __uint_as_float(aw[q] << 16), a1 = __uint_as_float(aw[q] & 0xffff0000u), g0 = __uint_as_float(gw[q] << 16), g1 = __uint_as_float(gw[q] & 0xffff0000u);
                ow[q] = cvtpk(a0 / (1.f + __expf(-g0)), a1 / (1.f + __expf(-g1))); }
            o = (v4u){ow[0], ow[1], ow[2], ow[3]}; }
        *(LAS v4u*)(U + t * 512 + c8) = o; }
    __syncthreads();
    { const int c = F.tid; float w[31];
#pragma unroll
      for (int j = 0; j < 31; ++j) w[j] = ((const GAS float*)F.in[9])[((size_t)l * 31 + j) * 512 + c];
      const float cb = F.in[10][l * 512 + c];
#pragma unroll
      for (int half = 0; half < 2; ++half) { float u[46];
#pragma unroll
          for (int t = 0; t < 46; ++t) u[t] = bf2f(U[(half * 16 + t) * 512 + c]);
#pragma unroll
          for (int n = 0; n < 16; ++n) { float s = cb;
#pragma unroll
              for (int j = 0; j < 31; ++j) s += u[n + j] * w[j];
              Y[(half * 16 + n) * 512 + c] = s; } } }
    __syncthreads();
    { const float* lg = F.in[11] + l * 512 + 8 * F.lane; const float* lb = F.in[12] + l * 512 + 8 * F.lane;
      const f32x4 g0 = *(const f32x4*)lg, g1 = *(const GAS f32x4*)(lg + 4), b0 = *(const f32x4*)lb, b1 = *(const GAS f32x4*)(lb + 4);
#pragma unroll
      for (int i = 0; i < 4; ++i) { const int n = 4 * F.wave + i; f32x4 y0 = *(LAS f32x4*)(Y + n * 512 + 8 * F.lane), y1 = *(LAS f32x4*)(Y + n * 512 + 8 * F.lane + 4);
          const float mean = wave_sum((y0[0] + y0[1]) + (y0[2] + y0[3]) + (y1[0] + y1[1]) + (y1[2] + y1[3])) * (1.f / 512.f);
          y0 = y0 - mean; y1 = y1 - mean;
          const float var = wave_sum((y0[0] * y0[0] + y0[1] * y0[1]) + (y0[2] * y0[2] + y0[3] * y0[3]) + (y1[0] * y1[0] + y1[1] * y1[1]) + (y1[2] * y1[2] + y1[3] * y1[3])) * (1.f / 512.f);
          const float rstd = 1.f / sqrtf(var + LN_EPS);
          y0 = y0 * rstd * g0 + b0; y1 = y1 * rstd * g1 + b1;
          v4u w4; w4.x = cvtpk(silu_f(y0[0]), silu_f(y0[1])); w4.y = cvtpk(silu_f(y0[2]), silu_f(y0[3])); w4.z = cvtpk(silu_f(y1[0]), silu_f(y1[1])); w4.w = cvtpk(silu_f(y1[2]), silu_f(y1[3]));
          *(GAS v4u*)(MIX + (size_t)(row0 + n) * MIXP + 1024 + 8 * F.lane) = w4; } }
    __syncthreads();
}
constexpr int HP = DM + 8;
template <bool XBF> __device__ __forceinline__ void ph_ln_router(Frame& F, int l, const void* xcv, const void* xlv) {
    const float* MOD = (const float*)(F.ws + WS_MOD) + (size_t)l * 2 * NMODV; bf16* T = (bf16*)(F.ws + WS_T); bf16* XN = (bf16*)(F.ws + WS_XN); const bf16* DMX = (const bf16*)(F.ws + WS_DMIX);
    const float* ga = F.in[20] + (size_t)l * DM; const float* ba = F.in[21] + (size_t)l * DM;
    const v4u* WRT = (const v4u*)(F.ws + WS_WRT) + (size_t)l * 24576;
    int* LIST = (int*)(F.ws + WS_LIST) + (size_t)l * NE * LCAP; float* WTOK = (float*)(F.ws + WS_WTOK) + (size_t)l * 2 * ROWS;
    LAS bf16* HHI = (LAS bf16*)(F.lds + RING_OFF); LAS bf16* HLO = HHI + 16 * HP;
    LAS float* PART = (LAS float*)(F.lds + RING_OFF);
    LAS float* LOGI = (LAS float*)(F.lds + RING_OFF + 32768);
    const int fr = F.lane & 15, fq = F.lane >> 4;
    const int blk0 = (l + 1 < DEPTH) ? 0 : CTXL / 16;
    for (int blk = blk0 + F.vcu; blk < ROWS / 16; blk += F.G) {
        RowV vv[2];
#pragma unroll
        for (int i = 0; i < 2; ++i) { const int r = blk * 16 + 2 * F.wave + i;
            if (XBF) row_load_bf16(vv[i], r < CTXL ? (const bf16*)xcv + (size_t)r * DM : (const bf16*)xlv + (size_t)(r - CTXL) * DM, F.lane);
            else row_load(vv[i], r < CTXL ? (const float*)xcv + (size_t)r * DM : (const float*)xlv + (size_t)(r - CTXL) * DM, F.lane);
#pragma unroll
            for (int j = 0; j < 4; ++j) { const v4u d = *(const GAS v4u*)(DMX + (size_t)r * DM + 512 * j + 8 * F.lane);
                vv[i].v[2 * j] = vv[i].v[2 * j] * ALPHA + (f32x4){__uint_as_float(d.x << 16), __uint_as_float(d.x & 0xffff0000u), __uint_as_float(d.y << 16), __uint_as_float(d.y & 0xffff0000u)};
                vv[i].v[2 * j + 1] = vv[i].v[2 * j + 1] * ALPHA + (f32x4){__uint_as_float(d.z << 16), __uint_as_float(d.z & 0xffff0000u), __uint_as_float(d.w << 16), __uint_as_float(d.w & 0xffff0000u)}; } }
#pragma unroll
        for (int i = 0; i < 2; ++i) { const int rl = 2 * F.wave + i, r = blk * 16 + rl; const float* mp = MOD + (r < CTXL ? NMODV : 0);
            RowV& v = vv[i]; row_norm(v); row_affine(v, ga, 0.f, ba, F.lane); row_store_bf16(v, T + (size_t)r * DM, F.lane);
            row_norm(v); row_affine(v, mp + 4 * DM, 1.f, mp + 3 * DM, F.lane);
#pragma unroll
            for (int j = 0; j < 4; ++j) { unsigned hw[4], lw[4];
#pragma unroll
                for (int q = 0; q < 4; ++q) { const float a = v.v[2 * j + (q >> 1)][(q & 1) * 2], b = v.v[2 * j + (q >> 1)][(q & 1) * 2 + 1];
                    const unsigned h = cvtpk(a, b); hw[q] = h; lw[q] = cvtpk(a - __uint_as_float(h << 16), b - __uint_as_float(h & 0xffff0000u)); }
                const v4u h4 = (v4u){hw[0], hw[1], hw[2], hw[3]}, l4 = (v4u){lw[0], lw[1], lw[2], lw[3]};
                *(GAS v4u*)(XN + (size_t)r * DM + 512 * j + 8 * F.lane) = h4;
                *(LAS v4u*)(HHI + rl * HP + 512 * j + 8 * F.lane) = h4; *(LAS v4u*)(HLO + rl * HP + 512 * j + 8 * F.lane) = l4; } }
        __syncthreads();
        f32x4 acc[3];
#pragma unroll
        for (int n = 0; n < 3; ++n) acc[n] = (f32x4){0.f, 0.f, 0.f, 0.f};
#pragma unroll 2
        for (int s = 0; s < 8; ++s) { const int ks = 8 * F.wave + s;
            const bf16x8 xh = *(const LAS bf16x8*)(HHI + fr * HP + ks * 32 + fq * 8), xl = *(const LAS bf16x8*)(HLO + fr * HP + ks * 32 + fq * 8);
#pragma unroll
            for (int n = 0; n < 3; ++n) { const v4u wh4 = ((const GAS v4u*)WRT)[((size_t)(0 * 64 + ks) * 3 + n) * 64 + F.lane], wl4 = ((const GAS v4u*)WRT)[((size_t)(1 * 64 + ks) * 3 + n) * 64 + F.lane];
                const bf16x8 wh = __builtin_bit_cast(bf16x8, wh4), wl = __builtin_bit_cast(bf16x8, wl4);
                acc[n] = __builtin_amdgcn_mfma_f32_16x16x32_bf16(wh, xh, acc[n], 0, 0, 0);
                acc[n] = __builtin_amdgcn_mfma_f32_16x16x32_bf16(wh, xl, acc[n], 0, 0, 0);
                acc[n] = __builtin_amdgcn_mfma_f32_16x16x32_bf16(wl, xh, acc[n], 0, 0, 0); } }
        __syncthreads();
#pragma unroll
        for (int n = 0; n < 3; ++n)
#pragma unroll
            for (int i = 0; i < 4; ++i) PART[(F.wave * 16 + fr) * 48 + 16 * n + 4 * fq + i] = acc[n][i];
        __syncthreads();
        for (int t = F.tid; t < 16 * 36; t += NWAVES * 64) { const int m = t / 36, n = t % 36; float s = n < 4 ? F.in[23][l * 4 + n] : F.in[25][l * 32 + (n - 4)];
#pragma unroll
            for (int w = 0; w < 8; ++w) s += PART[(w * 16 + m) * 48 + n];
            LOGI[m * 36 + n] = s; }
        __syncthreads();
        if (F.tid < 16) { const int r = blk * 16 + F.tid; const LAS float* lg = LOGI + F.tid * 36;
            int gi = 0; float gm = lg[0];
#pragma unroll
            for (int j = 1; j < 4; ++j) if (lg[j] > gm) { gm = lg[j]; gi = j; }
            float gs = 0.f;
#pragma unroll
            for (int j = 0; j < 4; ++j) gs += __expf(lg[j] - gm);
            const float wg = 1.f / gs;
            const LAS float* le = lg + 4 + gi * 8; int i1 = 0; float m1 = le[0];
#pragma unroll
            for (int j = 1; j < 8; ++j) if (le[j] > m1) { m1 = le[j]; i1 = j; }
            int i2 = -1; float m2 = -3.0e38f;
#pragma unroll
            for (int j = 0; j < 8; ++j) if (j != i1 && le[j] > m2) { m2 = le[j]; i2 = j; }
            const float e2 = __expf(m2 - m1), w1 = wg / (1.f + e2), w2 = wg * e2 / (1.f + e2);
            const int ea = gi * 8 + i1, eb = gi * 8 + i2;
            const int sa = (int)__hip_atomic_fetch_add(F.ctl + CW_CNT + (l * NE + ea) * 64, 1u, RLX_AGENT), sb = (int)__hip_atomic_fetch_add(F.ctl + CW_CNT + (l * NE + eb) * 64, 1u, RLX_AGENT);
            ((GAS int*)LIST)[ea * LCAP + sa] = r * 2; ((GAS int*)LIST)[eb * LCAP + sb] = r * 2 + 1; ((GAS float*)WTOK)[r * 2] = w1; ((GAS float*)WTOK)[r * 2 + 1] = w2; }
        __syncthreads();
    }
}
__device__ __forceinline__ void moe_setup(Frame& F, int l, LAS int* tstart, LAS int* cnt) {
    if (F.tid < NE) cnt[F.tid] = (int)__hip_atomic_load(F.ctl + CW_CNT + (l * NE + F.tid) * 64, RLX_AGENT);
    __syncthreads();
    if (F.tid == 0) { int s = 0; for (int e = 0; e < NE; ++e) { tstart[e] = s; s += (cnt[e] + 255) >> 8; } tstart[NE] = s; }
    __syncthreads();
}
template <bool FUSE_NEXT> __device__ __forceinline__ void ph_ln_final(Frame& F, int l, void* outcv, void* outlv) {
    const int gw = F.vcu * NWAVES + F.wave, NGW = F.G * NWAVES;
    const float* MOD = (const float*)(F.ws + WS_MOD) + (size_t)l * 2 * NMODV; const bf16* X1 = (const bf16*)(F.ws + WS_T); const bf16* YK = (const bf16*)(F.ws + WS_YK);
    const float* gf = F.in[29] + (size_t)l * DM; const float* bfp = F.in[30] + (size_t)l * DM;
    for (int r = gw; r < ROWS; r += NGW) { if (r < CTXL && outcv == nullptr) continue;
        const float* mp = MOD + (r < CTXL ? NMODV : 0) + 5 * DM;
        RowV v; row_load_bf16(v, X1 + (size_t)r * DM, F.lane);
#pragma unroll
        for (int j = 0; j < 4; ++j) { const v4u a = *(const GAS v4u*)(YK + (size_t)(2 * r) * DM + 512 * j + 8 * F.lane), b = *(const GAS v4u*)(YK + (size_t)(2 * r + 1) * DM + 512 * j + 8 * F.lane);
            const f32x4 g0 = *(const GAS f32x4*)(mp + 512 * j + 8 * F.lane), g1 = *(const GAS f32x4*)(mp + 512 * j + 8 * F.lane + 4);
            const f32x4 y0 = (f32x4){__uint_as_float(a.x << 16) + __uint_as_float(b.x << 16), __uint_as_float(a.x & 0xffff0000u) + __uint_as_float(b.x & 0xffff0000u),
                                     __uint_as_float(a.y << 16) + __uint_as_float(b.y << 16), __uint_as_float(a.y & 0xffff0000u) + __uint_as_float(b.y & 0xffff0000u)};
            const f32x4 y1 = (f32x4){__uint_as_float(a.z << 16) + __uint_as_float(b.z << 16), __uint_as_float(a.z & 0xffff0000u) + __uint_as_float(b.z & 0xffff0000u),
                                     __uint_as_float(a.w << 16) + __uint_as_float(b.w << 16), __uint_as_float(a.w & 0xffff0000u) + __uint_as_float(b.w & 0xffff0000u)};
            v.v[2 * j] = v.v[2 * j] * ALPHA + g0 * y0; v.v[2 * j + 1] = v.v[2 * j + 1] * ALPHA + g1 * y1; }
        row_norm(v); row_affine(v, gf, 0.f, bfp, F.lane);
#ifdef TPROBE
        if (!FUSE_NEXT) { const float tsc_ = 1.f + *(const volatile float*)&g_tprobe;
#pragma unroll
            for (int q = 0; q < 8; ++q) v.v[q] = v.v[q] * tsc_; }
#endif
        if (FUSE_NEXT) row_store_bf16(v, r < CTXL ? (bf16*)outcv + (size_t)r * DM : (bf16*)outlv + (size_t)(r - CTXL) * DM, F.lane);
        else row_store(v, r < CTXL ? (float*)outcv + (size_t)r * DM : (float*)outlv + (size_t)(r - CTXL) * DM, F.lane);
        if (FUSE_NEXT) { const float* mn = (const float*)(F.ws + WS_MOD) + (size_t)(l + 1) * 2 * NMODV + (r < CTXL ? NMODV : 0);
            row_norm(v); row_affine(v, mn + DM, 1.f, mn, F.lane); row_store_bf16(v, (bf16*)(F.ws + WS_XN) + (size_t)r * DM, F.lane); } }
}

#ifndef MK_ONE_LAUNCH
#define MK_ONE_LAUNCH 0
#endif
struct Args { const float* in[NIN]; float* out; unsigned char* ws; int ph_lo, ph_hi, pad0, pad1; };
__global__ void __launch_bounds__(NWAVES * 64, 2) mk_fwd(Args args) {
    extern __shared__ __attribute__((aligned(16))) unsigned char lds[];
    Frame F;
    F.lds = (LAS unsigned char*)lds;
    F.MISC = (volatile LAS unsigned*)(F.lds + MISC_OFF);
    F.tid = threadIdx.x; F.lane = F.tid & 63; F.wave = __builtin_amdgcn_readfirstlane(F.tid >> 6);
    F.G = gridDim.x; { const int bx = blockIdx.x; F.vcu = (F.G % 8 == 0) ? (bx % 8) * (F.G / 8) + bx / 8 : bx; }
    F.ws = args.ws; F.out = args.out; F.ctl = (gu32*)(args.ws + WS_CTL);
    F.in = args.in;
    for (int u = F.tid; u < (LDS_BYTES - LDSCTL_OFF) / 4; u += NWAVES * 64) ((LAS unsigned*)(F.lds + LDSCTL_OFF))[u] = 0u;
    __syncthreads();
#if MK_ONE_LAUNCH
    XcdBarrier bar = xcd_barrier_post((unsigned*)(F.ctl + CW_BAR), F.MISC + 8);
#define GRID_BAR() xcd_barrier(bar)
#else
#define GRID_BAR() do { } while (0)
#endif
    const int lo = args.ph_lo, hi = args.ph_hi;
#ifdef ONLY_REL
#define IN(k) (lo <= (k) && (k) < hi && ((k) < 2 ? (k) == ONLY_REL - 100 : ((k) - 2) % 9 == ONLY_REL))
#else
#define IN(k) (lo <= (k) && (k) < hi)
#endif
#ifndef REPEAT_REL
#define REPEAT_REL -1
#endif
#ifndef REPEAT_N
#define REPEAT_N 2
#endif
#ifndef REPEAT_MASK
#define REPEAT_MASK 0
#endif
#define REP(r) for (int rep_ = 0; rep_ < (((r) == REPEAT_REL || ((r) < 32 && ((REPEAT_MASK >> (r)) & 1))) ? REPEAT_N : 1); ++rep_)
#ifdef PROBE_PHASE
#ifndef PROBE_MULT
#define PROBE_MULT 3
#endif
    unsigned long long tprev_ = __builtin_amdgcn_s_memrealtime();
#define SEAM(k) do { if (IN(k) && IN((k) + 1)) { GRID_BAR(); const unsigned long long tn_ = __builtin_amdgcn_s_memrealtime(); \
        if ((k) == PROBE_PHASE) { const unsigned long long until_ = tn_ + PROBE_MULT * (tn_ - tprev_); while (__builtin_amdgcn_s_memrealtime() < until_) __builtin_amdgcn_s_sleep(8); } \
        tprev_ = __builtin_amdgcn_s_memrealtime(); } } while (0)
#else
#define SEAM(k) do { if (IN(k) && IN((k) + 1)) GRID_BAR(); } while (0)
#endif
#define PHASE_BEGIN() do { unsigned char* w_ = args.ws; float* o_ = args.out; asm volatile("" : "+s"(w_), "+s"(o_)); F.ws = w_; F.out = o_; F.ctl = (gu32*)(w_ + WS_CTL); \
        int t_ = threadIdx.x; asm volatile("" : "+v"(t_)); F.tid = t_; F.lane = t_ & 63; F.wave = __builtin_amdgcn_readfirstlane(t_ >> 6); } while (0)
    LAS int* tstart = (LAS int*)(F.lds + LDSCTL_OFF); LAS int* ecnt = (LAS int*)(F.lds + LDSCTL_OFF + 136);
    char* ldsg = (char*)lds + RING_OFF;

    if (IN(0)) REP(100) { PHASE_BEGIN(); ph_prologue_a(F); } SEAM(0);
    if (IN(1)) REP(101) { PHASE_BEGIN(); ph_prologue_b(F); } SEAM(1);
#pragma unroll 1
    for (int l = 0; l < DEPTH; ++l) {
        const int P = 2 + 9 * l;
        const float* xc = F.in[2]; const float* xl = F.in[0];
        const float* MODL = (const float*)(F.ws + WS_MOD) + (size_t)l * 2 * NMODV;
        if (l == 0) { if (IN(P + 0)) REP(0) { PHASE_BEGIN(); ph_ln1(F, l, xc, xl); } SEAM(P + 0); }
        if (IN(P + 1)) REP(1) { PHASE_BEGIN();
            pg8::Gemm g{(const bf16*)(F.ws + WS_XN), (const bf16*)(F.ws + WS_WIN) + (size_t)l * DIN * DM, DM, DM};
            SchedWin S; S.go.init(NMT, DIN / 256, F.G, (int)blockIdx.x);
            EpiWin E{(bf16*)(F.ws + WS_UF), (bf16*)(F.ws + WS_UFC), (bf16*)(F.ws + WS_AG), (bf16*)(F.ws + WS_Q), (bf16*)(F.ws + WS_K), (bf16*)(F.ws + WS_V),
                     (const float*)(F.ws + WS_BINP) + l * DIN, (const f32x2v*)(F.ws + WS_ROPE)};
            pg8::gemm_phase<EpiWin, SchedWin>(F.lds + RING_OFF, g, S, E);
        } SEAM(P + 1);
        if (IN(P + 2)) REP(2) { PHASE_BEGIN();
            attn::Tensors AT{(const bf16*)(F.ws + WS_Q), (const bf16*)(F.ws + WS_K), (const bf16*)(F.ws + WS_V), (bf16*)(F.ws + WS_MIX),
                             (float*)(F.ws + WS_O2N) + (size_t)blockIdx.x * 64 * 512, F.in[18] + l * 128, ((const float*)(F.ws + WS_LAMV))[l], 1.f - (0.8f - 0.6f * expf(-0.3f * (float)l))};
#ifndef NO_ATT
#ifndef REPEAT_ATT_N
#define REPEAT_ATT_N 1
#endif
            for (int u = F.vcu; u < 512 * REPEAT_ATT_N; u += F.G) attn::attn_unit<true>((u & 511) >> 6, 256 * (1 + (u & 63)), ROWS / 64, AT, ldsg);
            for (int u = F.vcu; u < 8; u += F.G) attn::attn_unit<false>(u, 0, CTXL / 64, AT, ldsg);
#endif
#ifndef NO_CONV
#ifndef REPEAT_CONV_N
#define REPEAT_CONV_N 1
#endif
            for (int u = F.vcu; u < (ROWS / 32) * REPEAT_CONV_N; u += F.G) conv_unit(F, l, u % (ROWS / 32));
#endif
#ifndef NO_FA
            { pg8::Gemm g{(const bf16*)(F.ws + WS_UF), (const bf16*)(F.ws + WS_BTA), 128, 128};
#ifndef REPEAT_FA_N
#define REPEAT_FA_N 1
#endif
              SchedFA S; S.go.init(256 * REPEAT_FA_N, 1, F.G, (int)blockIdx.x); EpiFA E{(bf16*)(F.ws + WS_PF2)};
#ifndef REPEAT_FA_N
#define REPEAT_FA_N 1
#endif
              pg8::gemm_phase<EpiFA, SchedFA>(F.lds + RING_OFF, g, S, E); }
#endif
#ifndef NO_CTXF
            { pg8::Gemm g{(const bf16*)(F.ws + WS_F256), (const bf16*)(F.ws + WS_UFC), 256, 256};
              SchedNat S; S.go.init(2, 2, F.G, (int)((blockIdx.x + 128) % F.G)); S.pmoff = 0; EpiCtxF E{(bf16*)(F.ws + WS_MIX)};
              pg8::gemm_phase<EpiCtxF, SchedNat>(F.lds + RING_OFF, g, S, E); }
#endif
        } SEAM(P + 2);
        if (IN(P + 3)) REP(3) { PHASE_BEGIN();
            pg8::Gemm g{(const bf16*)(F.ws + WS_PF2), (const bf16*)(F.ws + WS_BTB), 256, 256};
            SchedFB S; S.go.init(256, 1, F.G, (int)blockIdx.x); EpiFB E{(bf16*)(F.ws + WS_MIX)};
            pg8::gemm_phase<EpiFB, SchedFB>(F.lds + RING_OFF, g, S, E);
            if (l + 1 < DEPTH) {
                pg8::Gemm g2{(const bf16*)(F.ws + WS_MIX), (const bf16*)(F.ws + WS_WCAT) + (size_t)l * DM * MIXP, MIXP, MIXP};
                SchedNat S2; S2.go.init(1, DM / 256, F.G, (int)((blockIdx.x + 96) % F.G)); S2.pmoff = 0; EpiWout E2{MODL, (bf16*)(F.ws + WS_DMIX)};
                pg8::gemm_phase<EpiWout, SchedNat>(F.lds + RING_OFF, g2, S2, E2); }
        } SEAM(P + 3);
        if (IN(P + 4)) REP(4) { PHASE_BEGIN();
            pg8::Gemm g{(const bf16*)(F.ws + WS_MIX), (const bf16*)(F.ws + WS_WCAT) + (size_t)l * DM * MIXP, MIXP, MIXP};
            SchedNat S; S.go.init(NMT - 1, DM / 256, F.G, (int)blockIdx.x); S.pmoff = 1; EpiWout E{MODL, (bf16*)(F.ws + WS_DMIX)};
            pg8::gemm_phase<EpiWout, SchedNat>(F.lds + RING_OFF, g, S, E);
        } SEAM(P + 4);
        if (IN(P + 5)) REP(5) { PHASE_BEGIN(); if (l == 0) ph_ln_router<false>(F, l, xc, xl); else ph_ln_router<true>(F, l, F.ws + WS_X2, (bf16*)(F.ws + WS_X2) + (size_t)CTXL * DM); } SEAM(P + 5);
        if (IN(P + 6)) REP(6) { PHASE_BEGIN();
            moe_setup(F, l, tstart, ecnt);
            pg8::Gemm g{(const bf16*)(F.ws + WS_XN), (const bf16*)(F.ws + WS_WGU), DM, DM};
            SchedMoe<1> S{tstart, ecnt, (const int*)(F.ws + WS_LIST) + (size_t)l * NE * LCAP, F.G, (int)F.vcu}; EpiMoe1 E{(bf16*)(F.ws + WS_ACT)};
            pg8::gemm_phase<EpiMoe1, SchedMoe<1>>(F.lds + RING_OFF, g, S, E);
        } SEAM(P + 6);
        if (IN(P + 7)) REP(7) { PHASE_BEGIN();
            moe_setup(F, l, tstart, ecnt);
            pg8::Gemm g{(const bf16*)(F.ws + WS_ACT), (const bf16*)(F.ws + WS_WD), DE, DE};
            SchedMoe<2> S{tstart, ecnt, (const int*)(F.ws + WS_LIST) + (size_t)l * NE * LCAP, F.G, (int)F.vcu};
            EpiMoe2 E{ecnt, (const int*)(F.ws + WS_LIST) + (size_t)l * NE * LCAP, (const float*)(F.ws + WS_WTOK) + (size_t)l * 2 * ROWS, (bf16*)(F.ws + WS_YK)};
            pg8::gemm_phase<EpiMoe2, SchedMoe<2>>(F.lds + RING_OFF, g, S, E);
        } SEAM(P + 7);
        if (IN(P + 8)) REP(8) { PHASE_BEGIN();
            if (l == 0) { ph_ln_final<true>(F, l, F.ws + WS_X2, (bf16*)(F.ws + WS_X2) + (size_t)CTXL * DM);
                          convert_experts(F, 1, (LAS float*)(F.lds + RING_OFF + F.wave * 16896)); }
            else ph_ln_final<false>(F, l, nullptr, F.out);
        }
        if (l + 1 < DEPTH) SEAM(P + 8);
    }
#undef IN
#undef SEAM
}

extern "C" void kernel_launch(void* const* d_in, const int* in_sizes, int n_in, void* d_out, int out_size, void* d_ws, size_t ws_size, hipStream_t stream) {
    static int grid = 0;
    if (grid == 0) {
        if (n_in != NIN || in_sizes[0] != SEQ * DM || out_size != SEQ * DM || ws_size < WS_END) { fprintf(stderr, "kernel_launch: shape mismatch (n_in %d, in0 %d, out %d, ws %zu < %zu?)\n", n_in, n_in > 0 ? in_sizes[0] : -1, out_size, ws_size, (size_t)WS_END); grid = -1; return; }
        int dev = 0, cus = 0, per_cu = 0;
        if (hipGetDevice(&dev) != hipSuccess || hipDeviceGetAttribute(&cus, hipDeviceAttributeMultiprocessorCount, dev) != hipSuccess) { grid = -1; return; }
        if (hipFuncSetAttribute((const void*)mk_fwd, hipFuncAttributeMaxDynamicSharedMemorySize, LDS_BYTES) != hipSuccess) { fprintf(stderr, "kernel_launch: hipFuncSetAttribute failed\n"); grid = -1; return; }
        if (hipOccupancyMaxActiveBlocksPerMultiprocessor(&per_cu, (const void*)mk_fwd, NWAVES * 64, LDS_BYTES) != hipSuccess || per_cu < 1)
            fprintf(stderr, "kernel_launch: note: occupancy query reports %d workgroups per CU\n", per_cu);
        (void)hipGetLastError();
        grid = cus;
        if (grid > 256) grid = 256;
    }
    if (grid < 0) return;
    if (hipMemsetAsync((char*)d_ws + WS_CTL, 0, CTL_ZERO_BYTES, stream) != hipSuccess) { fprintf(stderr, "kernel_launch: memset failed\n"); return; }
    Args a{};
    for (int i = 0; i < NIN; ++i) a.in[i] = (const float*)d_in[i];
    a.out = (float*)d_out; a.ws = (unsigned char*)d_ws;
#if MK_ONE_LAUNCH
    a.ph_lo = 0; a.ph_hi = NPH;
    hipLaunchKernelGGL(mk_fwd, dim3(grid), dim3(NWAVES * 64), LDS_BYTES, stream, a);
#else
    for (int p = 0; p < NPH; ++p) { a.ph_lo = p; a.ph_hi = p + 1; hipLaunchKernelGGL(mk_fwd, dim3(grid), dim3(NWAVES * 64), LDS_BYTES, stream, a); }
#endif
    const hipError_t le = hipPeekAtLastError();
    if (le != hipSuccess) fprintf(stderr, "kernel_launch: launch failed: %s\n", hipGetErrorName(le));
}
```

```cpp
#include <hip/hip_runtime.h>
#include <cstdio>
#include <cstdint>
#include <cmath>
#ifndef MK_ONE_LAUNCH
#define MK_ONE_LAUNCH 1
#endif
namespace pg8 {
#define PG8_LAS __attribute__((address_space(3)))
typedef unsigned short bf16_t;
typedef short bf16x8 __attribute__((ext_vector_type(8)));
typedef float f32x4 __attribute__((ext_vector_type(4)));
typedef float f32x2 __attribute__((ext_vector_type(2)));
typedef unsigned u32x4 __attribute__((ext_vector_type(4)));
typedef unsigned u32x2 __attribute__((ext_vector_type(2)));
constexpr int BM = 256, BK = 64, HALF = 128, HTB = HALF * BK * 2  , STAGE_BYTES = 8 * HTB, NXCD = 8, WGM = 8;

__host__ __device__ __forceinline__ int lds_byte(int r, int c) { const int st = (r >> 4) * 2 + (c >> 5), rr = r & 15, cc = c & 31, ob = rr * 64 + cc * 2; return st * 1024 + (ob ^ (((ob >> 9) & 1) << 5)); }
__host__ __device__ __forceinline__ void stage_rc(int b, int& R, int& C) { const int st = b / 1024, sb = b % 1024, swz = sb ^ (((sb >> 9) & 1) << 5); R = (st >> 1) * 16 + swz / 64; C = (st & 1) * 32 + (swz % 64) / 2; }
__host__ __device__ __forceinline__ int perm32(int rho) { const int n = rho >> 4, i = rho & 15; return 8 * (i >> 2) + 4 * n + (i & 3); }

struct Unit { int pm, pn, e, rt, hb; };
struct Gemm { const bf16_t* A; const bf16_t* Bt; int K, lda; };

struct GridOrder {
    int nM, nN, nwg, G, c;
    __device__ void init(int nM_, int nN_, int G_, int c_) { nM = nM_; nN = nN_; nwg = nM * nN; G = G_; c = c_; }
    __device__ bool next(int i, Unit& u) const {
        const long L = (long)i * G + c; if (L >= nwg) return false;
        int wgid = (int)L; { const int q = nwg / NXCD, r = nwg % NXCD, xcd = wgid % NXCD, off = wgid / NXCD; wgid = (xcd < r ? xcd * (q + 1) : r * (q + 1) + (xcd - r) * q) + off; }
        const int nig = WGM * nN, gid = wgid / nig, fm = gid * WGM, gsz = (nM - fm) < WGM ? (nM - fm) : WGM;
        u.pm = fm + ((wgid % nig) % gsz); u.pn = (wgid % nig) / gsz; u.e = 0; u.rt = 0; u.hb = -1; return true;
    }
};

__device__ __forceinline__ unsigned cvt_pk_bf16(float lo, float hi) { unsigned r; asm volatile("v_cvt_pk_bf16_f32 %0, %1, %2" : "=v"(r) : "v"(lo), "v"(hi)); return r; }

template <class Epi, class Sched>
__device__ __forceinline__ void gemm_phase(PG8_LAS unsigned char* lds, const Gemm g, const Sched& S, const Epi& E) {
    int tid_ = threadIdx.x; asm volatile("" : "+v"(tid_));
    const int tid = tid_, wid = __builtin_amdgcn_readfirstlane(tid >> 6), lane = tid & 63, wr = wid >> 2, wc = wid & 3, fr = lane & 15, fq = lane >> 4;
    int K_ = g.K; asm volatile("" : "+s"(K_));
    const int K = K_, nt = K / BK;
    unsigned voffB[2];
#pragma unroll
    for (int i = 0; i < 2; ++i) { int R, C; stage_rc(tid * 16 + i * 8192, R, C); const int Rb = Epi::PERM ? ((R & ~31) + perm32(R & 31)) : R;
        voffB[i] = (unsigned)(Rb * K + C) * 2u; }
    const size_t kstep = (size_t)(BK * 2);
    const size_t hstepB = (size_t)HALF * K * 2;
    const unsigned pitchA = (unsigned)g.lda * 2u;
    const unsigned ldsw = (unsigned)wid * 1024u;
    const int aoff = lds_byte(wr * 64 + fr, fq * 8), boff = lds_byte(wc * 32 + fr, fq * 8);
    const char* gA = (const char*)g.A;
#define PG8_SA(b, h) (((b) * 2 + (h)) * HTB)
#define PG8_SB(b, h) ((4 + (b) * 2 + (h)) * HTB)
#define PG8_STAGEB(bufoff, gbase) do { _Pragma("unroll") for (int _i = 0; _i < 2; ++_i) \
        __builtin_amdgcn_global_load_lds((const unsigned*)((const char*)(gbase) + voffB[_i]), (PG8_LAS unsigned*)(lds + (bufoff) + ldsw + _i * 8192), 16, 0, 0); } while (0)
#define PG8_STAGEA(bufoff, koff, vo) do { _Pragma("unroll") for (int _i = 0; _i < 2; ++_i) \
        __builtin_amdgcn_global_load_lds((const unsigned*)(gA + (koff) + (vo)[_i]), (PG8_LAS unsigned*)(lds + (bufoff) + ldsw + _i * 8192), 16, 0, 0); } while (0)
#define PG8_MKA(dst, u) do { _Pragma("unroll") for (int _i = 0; _i < 2; ++_i) { int R_, C_; stage_rc(tid * 16 + _i * 8192, R_, C_); _Pragma("unroll") for (int _h = 0; _h < 2; ++_h) \
        dst[_h][_i] = (unsigned)S.arow(u, _h * HALF + R_) * pitchA + (unsigned)C_ * 2u; } } while (0)
#define PG8_LDA(dst, b, h) do { _Pragma("unroll") for (int m = 0; m < 4; ++m) _Pragma("unroll") for (int k = 0; k < 2; ++k) dst[m][k] = *(const PG8_LAS bf16x8*)(lds + PG8_SA(b, h) + aoff + m * 2048 + k * 1024); } while (0)
#define PG8_LDB(dst, b, h) do { _Pragma("unroll") for (int n = 0; n < 2; ++n) _Pragma("unroll") for (int k = 0; k < 2; ++k) dst[n][k] = *(const PG8_LAS bf16x8*)(lds + PG8_SB(b, h) + boff + n * 2048 + k * 1024); } while (0)
#define PG8_MMA(ai, bj, At, Bt) do { __builtin_amdgcn_s_setprio(1); _Pragma("unroll") for (int m = 0; m < 4; ++m) _Pragma("unroll") for (int n = 0; n < 2; ++n) _Pragma("unroll") for (int k = 0; k < 2; ++k) \
        acc[ai][bj][m][n] = __builtin_amdgcn_mfma_f32_16x16x32_bf16(Bt[n][k], At[m][k], acc[ai][bj][m][n], 0, 0, 0); __builtin_amdgcn_s_setprio(0); } while (0)
#define PG8_WAIT_V(n) asm volatile("s_waitcnt vmcnt(" #n ")" ::: "memory")
#define PG8_WAIT_L(n) asm volatile("s_waitcnt lgkmcnt(" #n ")" ::: "memory")
#define PG8_BAR __builtin_amdgcn_s_barrier()
#define PG8_SCHED __builtin_amdgcn_sched_barrier(0)
    Unit cur, nxt; int ui = 0;
    if (!S.next(0, cur)) return;
    f32x4 acc[2][2][4][2];
#pragma unroll
    for (int a = 0; a < 2; ++a)
#pragma unroll
        for (int b = 0; b < 2; ++b)
#pragma unroll
            for (int m = 0; m < 4; ++m)
#pragma unroll
                for (int n = 0; n < 2; ++n) acc[a][b][m][n] = (f32x4){0.f, 0.f, 0.f, 0.f};
    bf16x8 At[4][2], B0[2][2], B1[2][2];
    unsigned cvA[2][2], nvA[2][2];
    PG8_MKA(cvA, cur);
    const char* cB = (const char*)g.Bt + (size_t)S.brow(cur) * K * 2;
    PG8_STAGEB(PG8_SB(0, 0), cB); PG8_STAGEB(PG8_SB(0, 1), cB + hstepB); PG8_STAGEA(PG8_SA(0, 0), 0, cvA[0]); PG8_STAGEA(PG8_SA(0, 1), 0, cvA[1]);
    if (wr == 1) PG8_BAR;
    PG8_WAIT_V(2); PG8_BAR;
    PG8_STAGEB(PG8_SB(1, 0), cB + kstep); PG8_STAGEA(PG8_SA(1, 0), kstep, cvA[0]); PG8_STAGEB(PG8_SB(1, 1), cB + hstepB + kstep);
    PG8_WAIT_V(6); PG8_BAR;
    for (;;) {
        const bool has_next = S.next(ui + 1, nxt); const int hb = cur.hb;
        const char* nB = cB;
        if (has_next) { PG8_MKA(nvA, nxt); nB = (const char*)g.Bt + (size_t)S.brow(nxt) * K * 2; }
        else {
#pragma unroll
            for (int h = 0; h < 2; ++h)
#pragma unroll
                for (int i = 0; i < 2; ++i) nvA[h][i] = cvA[h][i]; }
        for (int t = 0; t < nt; t += 2) {
            const bool last = (t == nt - 2);
            const size_t ka1 = (size_t)(t + 1) * kstep;
            const size_t ka2 = last ? (size_t)0 : (size_t)(t + 2) * kstep; const char* b2 = last ? nB : cB + (size_t)(t + 2) * kstep;
            const size_t ka3 = ka2 + kstep; const char* b3 = b2 + kstep;
            unsigned a2v[2][2];
#pragma unroll
            for (int h = 0; h < 2; ++h)
#pragma unroll
                for (int i = 0; i < 2; ++i) a2v[h][i] = last ? nvA[h][i] : cvA[h][i];
            PG8_LDB(B0, 0, 0); PG8_LDB(B1, 0, 1); PG8_SCHED; PG8_LDA(At, 0, 0); PG8_STAGEA(PG8_SA(1, 1), ka1, cvA[1]);
            PG8_WAIT_V(8); PG8_WAIT_L(0); PG8_BAR; if (hb != 1) PG8_MMA(0, 0, At, B0); if (hb != 0) PG8_MMA(0, 1, At, B1); PG8_BAR; PG8_SCHED;
            PG8_LDA(At, 0, 1); PG8_STAGEB(PG8_SB(0, 0), b2); PG8_STAGEB(PG8_SB(0, 1), b2 + hstepB); PG8_STAGEA(PG8_SA(0, 0), ka2, a2v[0]);
            PG8_WAIT_V(8); PG8_WAIT_L(0); PG8_BAR; if (hb != 1) PG8_MMA(1, 0, At, B0); if (hb != 0) PG8_MMA(1, 1, At, B1); PG8_BAR; PG8_SCHED;
            PG8_LDB(B0, 1, 0); PG8_LDB(B1, 1, 1); PG8_SCHED; PG8_LDA(At, 1, 0); PG8_STAGEA(PG8_SA(0, 1), ka2, a2v[1]);
            PG8_WAIT_V(8); PG8_WAIT_L(0); PG8_BAR; if (hb != 1) PG8_MMA(0, 0, At, B0); if (hb != 0) PG8_MMA(0, 1, At, B1); PG8_BAR; PG8_SCHED;
            PG8_LDA(At, 1, 1); PG8_STAGEB(PG8_SB(1, 0), b3); PG8_STAGEB(PG8_SB(1, 1), b3 + hstepB); PG8_STAGEA(PG8_SA(1, 0), ka3, a2v[0]);
            PG8_WAIT_V(8); PG8_WAIT_L(0); PG8_BAR; if (hb != 1) PG8_MMA(1, 0, At, B0); if (hb != 0) PG8_MMA(1, 1, At, B1); PG8_BAR; PG8_SCHED;
        }
        if (wr == 0) PG8_BAR;
        { int fr_ = fr, fq_ = fq, wr_ = wr, wc_ = wc; asm volatile("" : "+v"(fr_), "+v"(fq_), "+s"(wr_), "+s"(wc_));
          E(acc, cur, wr_, wc_, fr_, fq_); }
        if (!has_next) break;
#pragma unroll
        for (int a = 0; a < 2; ++a)
#pragma unroll
            for (int b = 0; b < 2; ++b)
#pragma unroll
                for (int m = 0; m < 4; ++m)
#pragma unroll
                    for (int n = 0; n < 2; ++n) acc[a][b][m][n] = (f32x4){0.f, 0.f, 0.f, 0.f};
        cur = nxt; cB = nB; ++ui;
#pragma unroll
        for (int h = 0; h < 2; ++h)
#pragma unroll
            for (int i = 0; i < 2; ++i) cvA[h][i] = nvA[h][i];
        if (wr == 1) PG8_BAR;
    }
    PG8_WAIT_V(0);
    PG8_BAR;
#undef PG8_SA
#undef PG8_SB
#undef PG8_STAGEA
#undef PG8_STAGEB
#undef PG8_MKA
#undef PG8_LDA
#undef PG8_LDB
#undef PG8_MMA
#undef PG8_WAIT_V
#undef PG8_WAIT_L
#undef PG8_BAR
#undef PG8_SCHED
}
}
#ifndef ATT_D
#define ATT_D 4
#endif
#ifndef ATT_STAGGER
#define ATT_NOSTAGGER 1
#endif
#if ATT_D == 2
#define A_INFLIGHT 3
#elif ATT_D == 3
#define A_INFLIGHT 6
#elif ATT_D == 4
#ifdef ATT_LDR4
#define A_INFLIGHT 18
#else
#define A_INFLIGHT 9
#endif
#else
#error ATT_D
#endif
#define A_GAS __attribute__((address_space(1)))
#ifdef TPROBE
__device__ float g_tprobe;
#ifndef TP_WAVE
#define TP_WAVE 0
#endif
#ifndef TP_Q
#define TP_Q 50.f
#endif
#ifndef TP_OFF
#define TP_OFF 0.f
#endif
#ifndef TP_SCALE
#define TP_SCALE 1e-4f
#endif
#endif
namespace attn {
using bf16x8 = __attribute__((ext_vector_type(8))) short;
using s16x4  = __attribute__((ext_vector_type(4))) short;
using f32x16 = __attribute__((ext_vector_type(16))) float;
using u32x4  = __attribute__((ext_vector_type(4))) unsigned;
using f32x4v = __attribute__((ext_vector_type(4))) float;
typedef unsigned short bf16_t;
constexpr int NW = 8, QBLK = 32, KVBLK = 64, PITCH = 1024;
#ifndef ATT_D
#define ATT_D 4
#endif
constexpr int ADEPTH = ATT_D;
constexpr int NSLOT = ADEPTH + 1, KSLOT = 8192, VSLOT = 16384;
constexpr int LDS_K = 0, LDS_V = NSLOT * KSLOT, LDS_WS = LDS_V + NSLOT * VSLOT, SHM_ATTN = LDS_WS + NW * 64 * 4;
__device__ __forceinline__ int crow(int r, int hi) { return (r & 3) + 8 * (r >> 2) + 4 * hi; }
__device__ __forceinline__ unsigned cvtpk(float lo, float hi) { unsigned r; asm volatile("v_cvt_pk_bf16_f32 %0, %1, %2" : "=v"(r) : "v"(lo), "v"(hi)); return r; }
typedef float f32x2_t __attribute__((ext_vector_type(2))); typedef __bf16 bf16x2_t __attribute__((ext_vector_type(2)));
__device__ __forceinline__ unsigned cvtpk_b(float lo, float hi) { f32x2_t v = {lo, hi}; bf16x2_t b = __builtin_convertvector(v, bf16x2_t); return __builtin_bit_cast(unsigned, b); }
__device__ __forceinline__ void glds16(const void* gsrc, unsigned lds_dst) { unsigned keep;
  asm volatile("s_mov_b32 %0, m0\n\ts_mov_b32 m0, %2\n\ts_nop 0\n\tglobal_load_lds_dwordx4 %1, off\n\ts_mov_b32 m0, %0" : "=&s"(keep) : "v"(gsrc), "s"(lds_dst) : "memory"); }
typedef __attribute__((address_space(3))) const char* lds_cptr;
typedef short v4i16_t __attribute__((ext_vector_type(4)));
__device__ __forceinline__ s16x4 vtr(lds_cptr p) { return __builtin_bit_cast(s16x4, __builtin_amdgcn_ds_read_tr16_b64_v4i16((__attribute__((address_space(3))) v4i16_t*)p)); }
#define A_WAITBAR_(V) asm volatile("s_waitcnt vmcnt(" #V ") lgkmcnt(0)\n\ts_barrier" ::: "memory")
#define A_WAITBAR(V) A_WAITBAR_(V)
#define A_LGKBAR() asm volatile("s_waitcnt lgkmcnt(0)\n\ts_barrier" ::: "memory")
#define A_SBAR() __builtin_amdgcn_sched_barrier(0)

template <int THRL, bool ROTL>
__device__ __forceinline__ void attn_pass(const bf16_t* __restrict__ Qb, const bf16_t* __restrict__ Kh, const bf16_t* __restrict__ Vh, int NT, char* shm, f32x16 (&o)[4], float& l_out) {
  int tid_ = threadIdx.x; asm volatile("" : "+v"(tid_));
  const int tid = tid_, lane = tid & 63, r32 = lane & 31, hi = lane >> 5; const int wid = __builtin_amdgcn_readfirstlane(tid >> 6);
#ifdef ATT_NOSTAGGER
  const int half = 0;
#else
#ifdef ATT_PARITY
  const int half = wid & 1;
#else
  const int half = wid >> 2;
#endif
#endif
  const unsigned lds0 = (unsigned)(uintptr_t)shm;
  float* wsf = (float*)(shm + LDS_WS) + wid * 64;
  const bf16_t* ksrc = Kh + wid * 512 + lane * 8;
  const bf16_t* vsrc = Vh + wid * 512 + lane * 8;
  const unsigned kdst = lds0 + LDS_K + wid * 1024, vdst = lds0 + LDS_V + wid * 1024;
#ifdef ATT_LDR4
#define A_RFL(x) (unsigned)__builtin_amdgcn_readfirstlane(x)
#define DMA_K(t, s) do { if (wid < 4) { glds16(ksrc + (long)(t) * 4096, A_RFL(kdst + (s) * KSLOT)); glds16(ksrc + (long)(t) * 4096 + 2048, A_RFL(kdst + (s) * KSLOT + 4096)); } } while (0)
#define DMA_VA(t, s) do { if (wid < 4) { glds16(vsrc + (long)(t) * 8192, A_RFL(vdst + (s) * VSLOT)); glds16(vsrc + (long)(t) * 8192 + 2048, A_RFL(vdst + (s) * VSLOT + 4096)); } } while (0)
#define DMA_VB(t, s) do { if (wid < 4) { glds16(vsrc + (long)(t) * 8192 + 4096, A_RFL(vdst + (s) * VSLOT + 8192)); glds16(vsrc + (long)(t) * 8192 + 6144, A_RFL(vdst + (s) * VSLOT + 12288)); } } while (0)
#else
#define DMA_K(t, s) glds16(ksrc + (long)(t) * 4096, (unsigned)__builtin_amdgcn_readfirstlane(kdst + (s) * KSLOT))
#define DMA_VA(t, s) glds16(vsrc + (long)(t) * 8192, (unsigned)__builtin_amdgcn_readfirstlane(vdst + (s) * VSLOT))
#define DMA_VB(t, s) glds16(vsrc + (long)(t) * 8192 + 4096, (unsigned)__builtin_amdgcn_readfirstlane(vdst + (s) * VSLOT + 8192))
#endif
#define DMA_V(t, s) do { DMA_VA(t, s); DMA_VB(t, s); } while (0)
  bf16x8 qr[4];
  { const bf16_t* Qw = Qb + (long)(wid * QBLK + r32) * PITCH + hi * 8;
#pragma unroll
    for (int d0 = 0; d0 < 4; ++d0) qr[d0] = *(const A_GAS bf16x8*)(Qw + d0 * 16); }
  DMA_K(0, 0);
#pragma unroll
  for (int g = 1; g < ADEPTH; ++g) { DMA_K(g, g); DMA_V(g - 1, g - 1); }
  float mhat = 0.f, l_reg = 0.f;
#pragma unroll
  for (int d = 0; d < 4; ++d) o[d] = f32x16{};
  f32x16 negm = f32x16{}; asm volatile("" : "+v"(negm));
  f32x16 S0, S1; u32x4 pw0, pw1, pw2, pw3;

  pw0 = pw1 = pw2 = pw3 = (u32x4){0u, 0u, 0u, 0u};
  A_WAITBAR(A_INFLIGHT);
  if (half == 1) A_LGKBAR();
  const unsigned kaddr0 = lds0 + LDS_K + hi * 1024 + r32 * 16;
  const unsigned vaddr0 = lds0 + LDS_V + ((lane >> 4) & 1) * 32 + (lane & 3) * 8 + (4 * hi + ((lane & 15) >> 2)) * 64;
#define A_KRD(dst, addr, off) asm volatile("ds_read_b128 %0, %1 offset:%2" : "=&v"(dst) : "v"(addr), "i"(off) : "memory")
#define A_VRD(dst, addr, off) asm volatile("ds_read_b64_tr_b16 %0, %1 offset:%2" : "=&v"(dst) : "v"(addr), "i"(off) : "memory")
#define A_VRD8(b, addr, d0) do { A_VRD(vl[b][0], addr, (d0) * 4096); A_VRD(vh[b][0], addr, (d0) * 4096 + 512); A_VRD(vl[b][1], addr, (d0) * 4096 + 1024); A_VRD(vh[b][1], addr, (d0) * 4096 + 1536); \
                                  A_VRD(vl[b][2], addr, (d0) * 4096 + 2048); A_VRD(vh[b][2], addr, (d0) * 4096 + 2560); A_VRD(vl[b][3], addr, (d0) * 4096 + 3072); A_VRD(vh[b][3], addr, (d0) * 4096 + 3584); } while (0)
#define A_LWAIT(n) do { asm volatile("s_waitcnt lgkmcnt(" #n ")" ::: "memory"); A_SBAR(); } while (0)
#define A_VFR(b, k) (bf16x8){vl[b][k][0], vl[b][k][1], vl[b][k][2], vl[b][k][3], vh[b][k][0], vh[b][k][1], vh[b][k][2], vh[b][k][3]}
#define A_PV4(od, b) do { od = __builtin_amdgcn_mfma_f32_32x32x16_bf16(__builtin_bit_cast(bf16x8, pw0), A_VFR(b, 0), od, 0, 0, 0); od = __builtin_amdgcn_mfma_f32_32x32x16_bf16(__builtin_bit_cast(bf16x8, pw1), A_VFR(b, 1), od, 0, 0, 0); \
                          od = __builtin_amdgcn_mfma_f32_32x32x16_bf16(__builtin_bit_cast(bf16x8, pw2), A_VFR(b, 2), od, 0, 0, 0); od = __builtin_amdgcn_mfma_f32_32x32x16_bf16(__builtin_bit_cast(bf16x8, pw3), A_VFR(b, 3), od, 0, 0, 0); } while (0)
#define A_QK8() do { S0 = __builtin_amdgcn_mfma_f32_32x32x16_bf16(kf[0], qr[0], negm, 0, 0, 0); S1 = __builtin_amdgcn_mfma_f32_32x32x16_bf16(kf[1], qr[0], negm, 0, 0, 0); \
    _Pragma("unroll") for (int d0 = 1; d0 < 4; ++d0) { S0 = __builtin_amdgcn_mfma_f32_32x32x16_bf16(kf[2 * d0], qr[d0], S0, 0, 0, 0); S1 = __builtin_amdgcn_mfma_f32_32x32x16_bf16(kf[2 * d0 + 1], qr[d0], S1, 0, 0, 0); } } while (0)
#define A_KRD8(addr) do { _Pragma("unroll") for (int d0 = 0; d0 < 4; ++d0) { A_KRD(kf[2 * d0], addr, d0 * 2048); A_KRD(kf[2 * d0 + 1], addr, d0 * 2048 + 512); } } while (0)
  const unsigned wsa = lds0 + LDS_WS + wid * 256 + hi * 16;
#define A_RESCALE_O() do { asm volatile("s_waitcnt lgkmcnt(0)" ::: "memory"); \
    _Pragma("unroll") for (int r4 = 0; r4 < 4; ++r4) { f32x4v w4_; asm volatile("ds_read_b128 %0, %1 offset:%2\n\ts_waitcnt lgkmcnt(0)" : "=&v"(w4_) : "v"(wsa), "i"(r4 * 32) : "memory"); \
      _Pragma("unroll") for (int d = 0; d < 4; ++d) _Pragma("unroll") for (int q = 0; q < 4; ++q) o[d][4 * r4 + q] *= w4_[q]; } } while (0)
#ifdef ATT_NOSTAGGER
#define A_END_M() do { } while (0)
#else
#define A_END_M() do { if (half == 1) { if (i + ADEPTH < NT) A_WAITBAR(A_INFLIGHT); else A_WAITBAR(0); } else A_LGKBAR(); } while (0)
#endif
#define A_MBLOCK(QK, PV) do { bf16x8 kf[8]; s16x4 vl[2][4], vh[2][4]; const unsigned ka = kaddr0 + s * KSLOT, va = vaddr0 + sK * VSLOT; \
    if (i + ADEPTH < NT) DMA_K(i + ADEPTH, sK); if (i + ADEPTH - 1 < NT) DMA_V(i + ADEPTH - 1, sV); \
    if (QK) A_KRD8(ka); \
    if (PV) A_VRD8(0, va, 0); \
    if (QK) { if (PV) A_LWAIT(8); else A_LWAIT(0); A_QK8(); A_SBAR(); } \
    if (PV) { A_VRD8(1, va, 1); A_LWAIT(8); A_PV4(o[0], 0); A_SBAR(); A_VRD8(0, va, 2); A_LWAIT(8); A_PV4(o[1], 1); A_SBAR(); A_VRD8(1, va, 3); A_LWAIT(8); A_PV4(o[2], 0); A_SBAR(); A_LWAIT(0); A_PV4(o[3], 1); } \
    A_END_M(); } while (0)
#define A_VBLOCK(FIRST) do { \
      float a = fmaxf(fmaxf(S0[0], S0[1]), S1[0]), b = fmaxf(fmaxf(S0[2], S0[3]), S1[1]); a = fmaxf(fmaxf(a, S1[2]), S1[3]); \
      _Pragma("unroll") for (int r = 4; r < 16; r += 4) { a = fmaxf(fmaxf(a, S0[r]), S0[r + 1]); b = fmaxf(fmaxf(b, S0[r + 2]), S0[r + 3]); a = fmaxf(fmaxf(a, S1[r]), S1[r + 1]); b = fmaxf(fmaxf(b, S1[r + 2]), S1[r + 3]); } \
      float rm = fmaxf(a, b); \
      { auto rr = __builtin_amdgcn_permlane32_swap(__float_as_uint(rm), __float_as_uint(rm), false, false); rm = fmaxf(__uint_as_float(rr[0]), __uint_as_float(rr[1])); } \
      bool resc = false; \
      if (FIRST || __builtin_expect(__any(rm > (float)THRL), 0)) { \
        const float dl = FIRST ? rm : fmaxf(rm, 0.f); mhat += dl; \
        _Pragma("unroll") for (int r = 0; r < 16; ++r) { S0[r] -= dl; S1[r] -= dl; } \
        _Pragma("unroll") for (int r = 0; r < 16; ++r) negm[r] = -mhat; \
        asm volatile("" : "+v"(negm)); \
        const float f = __builtin_amdgcn_exp2f(-dl); l_reg *= f; if (hi == 0) wsf[r32] = f; resc = !(FIRST); } \
      _Pragma("unroll") for (int r = 0; r < 16; ++r) { S0[r] = __builtin_amdgcn_exp2f(S0[r]); S1[r] = __builtin_amdgcn_exp2f(S1[r]); } \
      float sa = (S0[0] + S0[1]) + (S0[2] + S0[3]), sb = (S1[0] + S1[1]) + (S1[2] + S1[3]); \
      _Pragma("unroll") for (int r = 4; r < 16; r += 4) { sa += (S0[r] + S0[r + 1]) + (S0[r + 2] + S0[r + 3]); sb += (S1[r] + S1[r + 1]) + (S1[r + 2] + S1[r + 3]); } \
      l_reg += sa + sb; \
      pw0 = (u32x4){cvtpk(S0[0], S0[1]), cvtpk(S0[2], S0[3]), cvtpk(S0[4], S0[5]), cvtpk(S0[6], S0[7])}; \
      pw1 = (u32x4){cvtpk(S0[8], S0[9]), cvtpk(S0[10], S0[11]), cvtpk(S0[12], S0[13]), cvtpk(S0[14], S0[15])}; \
      pw2 = (u32x4){cvtpk(S1[0], S1[1]), cvtpk(S1[2], S1[3]), cvtpk(S1[4], S1[5]), cvtpk(S1[6], S1[7])}; \
      pw3 = (u32x4){cvtpk(S1[8], S1[9]), cvtpk(S1[10], S1[11]), cvtpk(S1[12], S1[13]), cvtpk(S1[14], S1[15])}; \
      if (resc) A_RESCALE_O(); \
      if (half == 0) { if (i + ADEPTH < NT) A_WAITBAR(A_INFLIGHT); else A_WAITBAR(0); } else A_LGKBAR(); } while (0)
#ifdef ATT_TRIG1
#define A_TRIG 1.0f
#else
#define A_TRIG (float)(1 << THRL)
#endif
#if defined(TPROBE)
#define A_TP_NOW() __builtin_readcyclecounter()
#define A_TP_DECL() unsigned long long tq0_ = 0, tq1_ = 0
#else
#define A_TP_DECL() do { } while (0)
#endif
#if defined(TPROBE) && TPROBE == 2
#define A_TP_TOP() do { } while (0)
#define A_TP_M8() do { } while (0)
#define A_TP_PRE() tq0_ = A_TP_NOW()
#define A_TP_POST() do { tq1_ = A_TP_NOW(); tpa_ += tq1_ - tq0_; } while (0)
#elif defined(TPROBE) && TPROBE == 3
#define A_TP_TOP() tq0_ = A_TP_NOW()
#define A_TP_M8() tq1_ = A_TP_NOW()
#define A_TP_PRE() do { } while (0)
#define A_TP_POST() tpa_ += tq1_ - tq0_
#elif defined(TPROBE) && TPROBE == 4
#define A_TP_TOP() do { } while (0)
#define A_TP_M8() tq0_ = A_TP_NOW()
#define A_TP_PRE() tq1_ = A_TP_NOW()
#define A_TP_POST() tpa_ += tq1_ - tq0_
#else
#define A_TP_TOP() do { } while (0)
#define A_TP_M8() do { } while (0)
#define A_TP_PRE() do { } while (0)
#define A_TP_POST() do { } while (0)
#endif
#if defined(TPROBE) && TPROBE == 2
#define A_TPB_PRE() const unsigned long long tb0_ = __builtin_readcyclecounter()
#define A_TPB_POST() do { const unsigned long long tb1_ = __builtin_readcyclecounter(); tpa_ += tb1_ - tb0_; } while (0)
#else
#define A_TPB_PRE() do { } while (0)
#define A_TPB_POST() do { } while (0)
#endif
#define A_SX(j) ((j) < 16 ? S0[(j) & 15] : S1[(j) & 15])
#define A_GAP(od, ks, b, w) do { od = __builtin_amdgcn_mfma_f32_32x32x16_bf16(__builtin_bit_cast(bf16x8, pw##ks), A_VFR(b, ks), od, 0, 0, 0); \
    { const float s0_ = A_SX(2 * (w)), s1_ = A_SX(2 * (w) + 1); \
      const float e0_ = __builtin_amdgcn_exp2f(s0_), e1_ = __builtin_amdgcn_exp2f(s1_); sa += e0_; sb += e1_; unsigned w_ = cvtpk_b(e0_, e1_); asm volatile("" : "+v"(w_), "+v"(sa), "+v"(sb)); pwn[(w) >> 2][(w) & 3] = w_; } A_SBAR(); } while (0)
#define A_PV4I(od, b, w0) do { A_GAP(od, 0, b, (w0)); A_GAP(od, 1, b, (w0) + 1); A_GAP(od, 2, b, (w0) + 2); A_GAP(od, 3, b, (w0) + 3); } while (0)
#define A_KRD8S() do { A_KRD(kf[0], ka, 0); A_KRD(kf[2], ka, 2048); A_KRD(kf[4], ka, 4096); A_KRD(kf[6], ka, 6144); } while (0)
#define A_KRD4B() do { A_KRD(kf[1], ka, 512); A_KRD(kf[3], ka, 2560); A_KRD(kf[5], ka, 4608); A_KRD(kf[7], ka, 6656); } while (0)
#define A_HEAD() do { __builtin_amdgcn_s_setprio(3); A_SBAR(); A_KRD8S(); } while (0)
#define A_TAIL(REISSUE) do { o[3] = __builtin_amdgcn_mfma_f32_32x32x16_bf16(__builtin_bit_cast(bf16x8, pw0), A_VFR(1, 0), o[3], 0, 0, 0); { sa += e22_; sb += e23_; unsigned w11_ = cvtpk_b(e22_, e23_); e26_ = __builtin_amdgcn_exp2f(S1[10]); e27_ = __builtin_amdgcn_exp2f(S1[11]); asm volatile("" : "+v"(sa), "+v"(sb), "+v"(w11_), "+v"(e26_), "+v"(e27_)); pwn[2][3] = w11_; } A_SBAR(); o[3] = __builtin_amdgcn_mfma_f32_32x32x16_bf16(__builtin_bit_cast(bf16x8, pw1), A_VFR(1, 1), o[3], 0, 0, 0); { sa += e24_; sb += e25_; unsigned w12_ = cvtpk_b(e24_, e25_); e28_ = __builtin_amdgcn_exp2f(S1[12]); e29_ = __builtin_amdgcn_exp2f(S1[13]); asm volatile("" : "+v"(sa), "+v"(sb), "+v"(w12_), "+v"(e28_), "+v"(e29_)); pwn[3][0] = w12_; } A_SBAR(); o[3] = __builtin_amdgcn_mfma_f32_32x32x16_bf16(__builtin_bit_cast(bf16x8, pw2), A_VFR(1, 2), o[3], 0, 0, 0); { sa += e26_; sb += e27_; unsigned w13_ = cvtpk_b(e26_, e27_); e30_ = __builtin_amdgcn_exp2f(S1[14]); e31_ = __builtin_amdgcn_exp2f(S1[15]); asm volatile("" : "+v"(sa), "+v"(sb), "+v"(w13_), "+v"(e30_), "+v"(e31_)); pwn[3][1] = w13_; } A_SBAR(); o[3] = __builtin_amdgcn_mfma_f32_32x32x16_bf16(__builtin_bit_cast(bf16x8, pw3), A_VFR(1, 3), o[3], 0, 0, 0); { sa += e28_; sb += e29_; unsigned w14_ = cvtpk_b(e28_, e29_); sa += e30_; sb += e31_; unsigned w15_ = cvtpk_b(e30_, e31_); asm volatile("" : "+v"(sa), "+v"(sb), "+v"(w14_), "+v"(w15_)); pwn[3][2] = w14_; pwn[3][3] = w15_; } A_SBAR(); \
      \
    float rm = sa + sb;                                     \
    { auto rr = __builtin_amdgcn_permlane32_swap(__float_as_uint(rm), __float_as_uint(rm), false, false); rm = __uint_as_float(rr[0]) + __uint_as_float(rr[1]); } \
    if (__builtin_expect(__any(rm > A_TRIG), 0)) { asm volatile("s_waitcnt lgkmcnt(0)" ::: "memory");     \
      const float dl = fmaxf(__builtin_amdgcn_logf(rm), 0.f); mhat += dl; \
      _Pragma("unroll") for (int r = 0; r < 16; ++r) negm[r] = -mhat; \
      asm volatile("" : "+v"(negm)); \
      const float f = __builtin_amdgcn_exp2f(-dl); l_reg *= f; sa *= f; sb *= f; \
      _Pragma("unroll") for (int q = 0; q < 4; ++q) _Pragma("unroll") for (int c = 0; c < 4; ++c) { const unsigned w_ = pwn[q][c]; pwn[q][c] = cvtpk_b(__uint_as_float(w_ << 16) * f, __uint_as_float(w_ & 0xffff0000u) * f); } \
      if (hi == 0) wsf[r32] = f; A_RESCALE_O(); REISSUE; } \
    l_reg += sa + sb; pw0 = pwn[0]; pw1 = pwn[1]; pw2 = pwn[2]; pw3 = pwn[3]; \
    sa = 0.f; sb = 0.f; } while (0)
#define A_BODY() do { A_KRD4B(); \
    A_LWAIT(7); S0 = __builtin_amdgcn_mfma_f32_32x32x16_bf16(kf[0], qr[0], negm, 0, 0, 0); A_SBAR(); if (i + ADEPTH < NT) DMA_K(i + ADEPTH, sK); A_SBAR(); \
    A_LWAIT(6); S0 = __builtin_amdgcn_mfma_f32_32x32x16_bf16(kf[2], qr[1], S0, 0, 0, 0); A_SBAR(); \
    A_LWAIT(5); S0 = __builtin_amdgcn_mfma_f32_32x32x16_bf16(kf[4], qr[2], S0, 0, 0, 0); A_SBAR(); if (i + ADEPTH - 1 < NT) DMA_VA(i + ADEPTH - 1, sV); A_SBAR(); \
    A_LWAIT(4); S0 = __builtin_amdgcn_mfma_f32_32x32x16_bf16(kf[6], qr[3], S0, 0, 0, 0); A_SBAR(); A_VRD8(0, va, 0); \
    A_LWAIT(11); S1 = __builtin_amdgcn_mfma_f32_32x32x16_bf16(kf[1], qr[0], negm, 0, 0, 0); A_SBAR(); if (i + ADEPTH - 1 < NT) DMA_VB(i + ADEPTH - 1, sV); A_SBAR(); __builtin_amdgcn_s_setprio(2); A_SBAR(); \
    A_LWAIT(10); S1 = __builtin_amdgcn_mfma_f32_32x32x16_bf16(kf[3], qr[1], S1, 0, 0, 0); A_SBAR(); { e0_ = __builtin_amdgcn_exp2f(S0[0]); e1_ = __builtin_amdgcn_exp2f(S0[1]); e2_ = __builtin_amdgcn_exp2f(S0[2]); asm volatile("" : "+v"(e0_), "+v"(e1_), "+v"(e2_)); } A_SBAR(); \
    A_LWAIT(9); S1 = __builtin_amdgcn_mfma_f32_32x32x16_bf16(kf[5], qr[2], S1, 0, 0, 0); A_SBAR(); { e3_ = __builtin_amdgcn_exp2f(S0[3]); sa += e0_; sb += e1_; unsigned w0_ = cvtpk_b(e0_, e1_); asm volatile("" : "+v"(e3_), "+v"(sa), "+v"(sb), "+v"(w0_)); pwn[0][0] = w0_; } A_SBAR(); \
    A_LWAIT(8); S1 = __builtin_amdgcn_mfma_f32_32x32x16_bf16(kf[7], qr[3], S1, 0, 0, 0); A_SBAR(); { e4_ = __builtin_amdgcn_exp2f(S0[4]); e5_ = __builtin_amdgcn_exp2f(S0[5]); sa += e2_; sb += e3_; asm volatile("" : "+v"(e4_), "+v"(e5_), "+v"(sa), "+v"(sb)); } A_SBAR(); \
    A_VRD8(1, va, 1); A_LWAIT(8); o[0] = __builtin_amdgcn_mfma_f32_32x32x16_bf16(__builtin_bit_cast(bf16x8, pw0), A_VFR(0, 0), o[0], 0, 0, 0); { unsigned w1_ = cvtpk_b(e2_, e3_); e6_ = __builtin_amdgcn_exp2f(S0[6]); e7_ = __builtin_amdgcn_exp2f(S0[7]); sa += e4_; asm volatile("" : "+v"(w1_), "+v"(e6_), "+v"(e7_), "+v"(sa)); pwn[0][1] = w1_; } A_SBAR(); o[0] = __builtin_amdgcn_mfma_f32_32x32x16_bf16(__builtin_bit_cast(bf16x8, pw1), A_VFR(0, 1), o[0], 0, 0, 0); { sb += e5_; unsigned w2_ = cvtpk_b(e4_, e5_); e8_ = __builtin_amdgcn_exp2f(S0[8]); e9_ = __builtin_amdgcn_exp2f(S0[9]); asm volatile("" : "+v"(sb), "+v"(w2_), "+v"(e8_), "+v"(e9_)); pwn[0][2] = w2_; } A_SBAR(); o[0] = __builtin_amdgcn_mfma_f32_32x32x16_bf16(__builtin_bit_cast(bf16x8, pw2), A_VFR(0, 2), o[0], 0, 0, 0); { sa += e6_; sb += e7_; unsigned w3_ = cvtpk_b(e6_, e7_); e10_ = __builtin_amdgcn_exp2f(S0[10]); asm volatile("" : "+v"(sa), "+v"(sb), "+v"(w3_), "+v"(e10_)); pwn[0][3] = w3_; } A_SBAR(); o[0] = __builtin_amdgcn_mfma_f32_32x32x16_bf16(__builtin_bit_cast(bf16x8, pw3), A_VFR(0, 3), o[0], 0, 0, 0); { e11_ = __builtin_amdgcn_exp2f(S0[11]); sa += e8_; sb += e9_; unsigned w4_ = cvtpk_b(e8_, e9_); asm volatile("" : "+v"(e11_), "+v"(sa), "+v"(sb), "+v"(w4_)); pwn[1][0] = w4_; } A_SBAR(); __builtin_amdgcn_s_setprio(1); A_SBAR(); \
    A_VRD8(0, va, 2); A_LWAIT(8); o[1] = __builtin_amdgcn_mfma_f32_32x32x16_bf16(__builtin_bit_cast(bf16x8, pw0), A_VFR(1, 0), o[1], 0, 0, 0); { e12_ = __builtin_amdgcn_exp2f(S0[12]); e13_ = __builtin_amdgcn_exp2f(S0[13]); sa += e10_; sb += e11_; asm volatile("" : "+v"(e12_), "+v"(e13_), "+v"(sa), "+v"(sb)); } A_SBAR(); o[1] = __builtin_amdgcn_mfma_f32_32x32x16_bf16(__builtin_bit_cast(bf16x8, pw1), A_VFR(1, 1), o[1], 0, 0, 0); { unsigned w5_ = cvtpk_b(e10_, e11_); e14_ = __builtin_amdgcn_exp2f(S0[14]); e15_ = __builtin_amdgcn_exp2f(S0[15]); sa += e12_; asm volatile("" : "+v"(w5_), "+v"(e14_), "+v"(e15_), "+v"(sa)); pwn[1][1] = w5_; } A_SBAR(); o[1] = __builtin_amdgcn_mfma_f32_32x32x16_bf16(__builtin_bit_cast(bf16x8, pw2), A_VFR(1, 2), o[1], 0, 0, 0); { sb += e13_; unsigned w6_ = cvtpk_b(e12_, e13_); e16_ = __builtin_amdgcn_exp2f(S1[0]); e17_ = __builtin_amdgcn_exp2f(S1[1]); asm volatile("" : "+v"(sb), "+v"(w6_), "+v"(e16_), "+v"(e17_)); pwn[1][2] = w6_; } A_SBAR(); o[1] = __builtin_amdgcn_mfma_f32_32x32x16_bf16(__builtin_bit_cast(bf16x8, pw3), A_VFR(1, 3), o[1], 0, 0, 0); { sa += e14_; sb += e15_; unsigned w7_ = cvtpk_b(e14_, e15_); e18_ = __builtin_amdgcn_exp2f(S1[2]); asm volatile("" : "+v"(sa), "+v"(sb), "+v"(w7_), "+v"(e18_)); pwn[1][3] = w7_; } A_SBAR(); \
    A_VRD8(1, va, 3); A_LWAIT(8); o[2] = __builtin_amdgcn_mfma_f32_32x32x16_bf16(__builtin_bit_cast(bf16x8, pw0), A_VFR(0, 0), o[2], 0, 0, 0); { e19_ = __builtin_amdgcn_exp2f(S1[3]); sa += e16_; sb += e17_; unsigned w8_ = cvtpk_b(e16_, e17_); asm volatile("" : "+v"(e19_), "+v"(sa), "+v"(sb), "+v"(w8_)); pwn[2][0] = w8_; } A_SBAR(); __builtin_amdgcn_s_setprio(0); A_SBAR(); o[2] = __builtin_amdgcn_mfma_f32_32x32x16_bf16(__builtin_bit_cast(bf16x8, pw1), A_VFR(0, 1), o[2], 0, 0, 0); { e20_ = __builtin_amdgcn_exp2f(S1[4]); e21_ = __builtin_amdgcn_exp2f(S1[5]); sa += e18_; sb += e19_; asm volatile("" : "+v"(e20_), "+v"(e21_), "+v"(sa), "+v"(sb)); } A_SBAR(); o[2] = __builtin_amdgcn_mfma_f32_32x32x16_bf16(__builtin_bit_cast(bf16x8, pw2), A_VFR(0, 2), o[2], 0, 0, 0); { unsigned w9_ = cvtpk_b(e18_, e19_); e22_ = __builtin_amdgcn_exp2f(S1[6]); e23_ = __builtin_amdgcn_exp2f(S1[7]); sa += e20_; asm volatile("" : "+v"(w9_), "+v"(e22_), "+v"(e23_), "+v"(sa)); pwn[2][1] = w9_; } A_SBAR(); o[2] = __builtin_amdgcn_mfma_f32_32x32x16_bf16(__builtin_bit_cast(bf16x8, pw3), A_VFR(0, 3), o[2], 0, 0, 0); { sb += e21_; unsigned w10_ = cvtpk_b(e20_, e21_); e24_ = __builtin_amdgcn_exp2f(S1[8]); e25_ = __builtin_amdgcn_exp2f(S1[9]); asm volatile("" : "+v"(sb), "+v"(w10_), "+v"(e24_), "+v"(e25_)); pwn[2][2] = w10_; } A_SBAR(); \
    A_TPB_PRE(); if (i + ADEPTH < NT) A_WAITBAR(A_INFLIGHT); else A_WAITBAR(0); A_TPB_POST(); } while (0)
#define A_ITER1() do { bf16x8 kf[8]; const unsigned ka = kaddr0 + s * KSLOT, va = vaddr0 + sK * VSLOT; A_HEAD(); A_BODY(); } while (0)
#define A_ITER() do { bf16x8 kf[8]; const unsigned ka = kaddr0 + s * KSLOT, va = vaddr0 + sK * VSLOT; A_HEAD(); A_TAIL(A_KRD8S()); A_BODY(); } while (0)
#define A_ITER0() do { bf16x8 kf[8]; s16x4 vl[2][4], vh[2][4]; const unsigned ka = kaddr0 + s * KSLOT, va = vaddr0 + sK * VSLOT; \
      \
    __builtin_amdgcn_s_setprio(3); A_SBAR(); A_KRD(kf[0], ka, 0); A_KRD(kf[2], ka, 2048); A_KRD(kf[4], ka, 4096); A_KRD(kf[6], ka, 6144); A_KRD(kf[1], ka, 512); A_KRD(kf[3], ka, 2560); A_KRD(kf[5], ka, 4608); A_KRD(kf[7], ka, 6656); \
    float sa = 0.f, sb = 0.f; u32x4 pwn[4]; float e0_, e1_, e2_, e3_, e4_, e5_, e6_, e7_, e8_, e9_, e10_, e11_, e12_, e13_, e14_, e15_, e16_, e17_, e18_, e19_, e20_, e21_, e22_, e23_, e24_, e25_, e26_, e27_, e28_, e29_, e30_, e31_; \
      \
    A_LWAIT(7); S0 = __builtin_amdgcn_mfma_f32_32x32x16_bf16(kf[0], qr[0], negm, 0, 0, 0); A_SBAR(); if (i + ADEPTH < NT) DMA_K(i + ADEPTH, sK); A_SBAR(); \
    A_LWAIT(6); S0 = __builtin_amdgcn_mfma_f32_32x32x16_bf16(kf[2], qr[1], S0, 0, 0, 0); A_SBAR(); \
    A_LWAIT(5); S0 = __builtin_amdgcn_mfma_f32_32x32x16_bf16(kf[4], qr[2], S0, 0, 0, 0); A_SBAR(); if (i + ADEPTH - 1 < NT) DMA_VA(i + ADEPTH - 1, sV); A_SBAR(); \
    A_LWAIT(4); S0 = __builtin_amdgcn_mfma_f32_32x32x16_bf16(kf[6], qr[3], S0, 0, 0, 0); A_SBAR(); A_VRD8(0, va, 0); \
    A_LWAIT(11); S1 = __builtin_amdgcn_mfma_f32_32x32x16_bf16(kf[1], qr[0], negm, 0, 0, 0); A_SBAR(); if (i + ADEPTH - 1 < NT) DMA_VB(i + ADEPTH - 1, sV); A_SBAR(); \
    A_LWAIT(10); S1 = __builtin_amdgcn_mfma_f32_32x32x16_bf16(kf[3], qr[1], S1, 0, 0, 0); A_SBAR(); { e0_ = __builtin_amdgcn_exp2f(S0[0]); e1_ = __builtin_amdgcn_exp2f(S0[1]); e2_ = __builtin_amdgcn_exp2f(S0[2]); asm volatile("" : "+v"(e0_), "+v"(e1_), "+v"(e2_)); } A_SBAR(); __builtin_amdgcn_s_setprio(2); A_SBAR(); \
    A_LWAIT(9); S1 = __builtin_amdgcn_mfma_f32_32x32x16_bf16(kf[5], qr[2], S1, 0, 0, 0); A_SBAR(); { e3_ = __builtin_amdgcn_exp2f(S0[3]); sa += e0_; sb += e1_; unsigned w0_ = cvtpk_b(e0_, e1_); asm volatile("" : "+v"(e3_), "+v"(sa), "+v"(sb), "+v"(w0_)); pwn[0][0] = w0_; } A_SBAR(); \
    A_LWAIT(8); S1 = __builtin_amdgcn_mfma_f32_32x32x16_bf16(kf[7], qr[3], S1, 0, 0, 0); A_SBAR(); { e4_ = __builtin_amdgcn_exp2f(S0[4]); e5_ = __builtin_amdgcn_exp2f(S0[5]); sa += e2_; sb += e3_; asm volatile("" : "+v"(e4_), "+v"(e5_), "+v"(sa), "+v"(sb)); } A_SBAR(); \
    A_VRD8(1, va, 1); A_LWAIT(8); o[0] = __builtin_amdgcn_mfma_f32_32x32x16_bf16(__builtin_bit_cast(bf16x8, pw0), A_VFR(0, 0), o[0], 0, 0, 0); { unsigned w1_ = cvtpk_b(e2_, e3_); e6_ = __builtin_amdgcn_exp2f(S0[6]); e7_ = __builtin_amdgcn_exp2f(S0[7]); sa += e4_; asm volatile("" : "+v"(w1_), "+v"(e6_), "+v"(e7_), "+v"(sa)); pwn[0][1] = w1_; } A_SBAR(); o[0] = __builtin_amdgcn_mfma_f32_32x32x16_bf16(__builtin_bit_cast(bf16x8, pw1), A_VFR(0, 1), o[0], 0, 0, 0); { sb += e5_; unsigned w2_ = cvtpk_b(e4_, e5_); e8_ = __builtin_amdgcn_exp2f(S0[8]); e9_ = __builtin_amdgcn_exp2f(S0[9]); asm volatile("" : "+v"(sb), "+v"(w2_), "+v"(e8_), "+v"(e9_)); pwn[0][2] = w2_; } A_SBAR(); o[0] = __builtin_amdgcn_mfma_f32_32x32x16_bf16(__builtin_bit_cast(bf16x8, pw2), A_VFR(0, 2), o[0], 0, 0, 0); { sa += e6_; sb += e7_; unsigned w3_ = cvtpk_b(e6_, e7_); e10_ = __builtin_amdgcn_exp2f(S0[10]); asm volatile("" : "+v"(sa), "+v"(sb), "+v"(w3_), "+v"(e10_)); pwn[0][3] = w3_; } A_SBAR(); o[0] = __builtin_amdgcn_mfma_f32_32x32x16_bf16(__builtin_bit_cast(bf16x8, pw3), A_VFR(0, 3), o[0], 0, 0, 0); { e11_ = __builtin_amdgcn_exp2f(S0[11]); sa += e8_; sb += e9_; unsigned w4_ = cvtpk_b(e8_, e9_); asm volatile("" : "+v"(e11_), "+v"(sa), "+v"(sb), "+v"(w4_)); pwn[1][0] = w4_; } A_SBAR(); __builtin_amdgcn_s_setprio(1); A_SBAR(); \
    A_VRD8(0, va, 2); A_LWAIT(8); o[1] = __builtin_amdgcn_mfma_f32_32x32x16_bf16(__builtin_bit_cast(bf16x8, pw0), A_VFR(1, 0), o[1], 0, 0, 0); { e12_ = __builtin_amdgcn_exp2f(S0[12]); e13_ = __builtin_amdgcn_exp2f(S0[13]); sa += e10_; sb += e11_; asm volatile("" : "+v"(e12_), "+v"(e13_), "+v"(sa), "+v"(sb)); } A_SBAR(); o[1] = __builtin_amdgcn_mfma_f32_32x32x16_bf16(__builtin_bit_cast(bf16x8, pw1), A_VFR(1, 1), o[1], 0, 0, 0); { unsigned w5_ = cvtpk_b(e10_, e11_); e14_ = __builtin_amdgcn_exp2f(S0[14]); e15_ = __builtin_amdgcn_exp2f(S0[15]); sa += e12_; asm volatile("" : "+v"(w5_), "+v"(e14_), "+v"(e15_), "+v"(sa)); pwn[1][1] = w5_; } A_SBAR(); o[1] = __builtin_amdgcn_mfma_f32_32x32x16_bf16(__builtin_bit_cast(bf16x8, pw2), A_VFR(1, 2), o[1], 0, 0, 0); { sb += e13_; unsigned w6_ = cvtpk_b(e12_, e13_); e16_ = __builtin_amdgcn_exp2f(S1[0]); e17_ = __builtin_amdgcn_exp2f(S1[1]); asm volatile("" : "+v"(sb), "+v"(w6_), "+v"(e16_), "+v"(e17_)); pwn[1][2] = w6_; } A_SBAR(); o[1] = __builtin_amdgcn_mfma_f32_32x32x16_bf16(__builtin_bit_cast(bf16x8, pw3), A_VFR(1, 3), o[1], 0, 0, 0); { sa += e14_; sb += e15_; unsigned w7_ = cvtpk_b(e14_, e15_); e18_ = __builtin_amdgcn_exp2f(S1[2]); asm volatile("" : "+v"(sa), "+v"(sb), "+v"(w7_), "+v"(e18_)); pwn[1][3] = w7_; } A_SBAR(); \
    A_VRD8(1, va, 3); A_LWAIT(8); o[2] = __builtin_amdgcn_mfma_f32_32x32x16_bf16(__builtin_bit_cast(bf16x8, pw0), A_VFR(0, 0), o[2], 0, 0, 0); { e19_ = __builtin_amdgcn_exp2f(S1[3]); sa += e16_; sb += e17_; unsigned w8_ = cvtpk_b(e16_, e17_); asm volatile("" : "+v"(e19_), "+v"(sa), "+v"(sb), "+v"(w8_)); pwn[2][0] = w8_; } A_SBAR(); o[2] = __builtin_amdgcn_mfma_f32_32x32x16_bf16(__builtin_bit_cast(bf16x8, pw1), A_VFR(0, 1), o[2], 0, 0, 0); { e20_ = __builtin_amdgcn_exp2f(S1[4]); e21_ = __builtin_amdgcn_exp2f(S1[5]); sa += e18_; sb += e19_; asm volatile("" : "+v"(e20_), "+v"(e21_), "+v"(sa), "+v"(sb)); } A_SBAR(); __builtin_amdgcn_s_setprio(0); A_SBAR(); o[2] = __builtin_amdgcn_mfma_f32_32x32x16_bf16(__builtin_bit_cast(bf16x8, pw2), A_VFR(0, 2), o[2], 0, 0, 0); { unsigned w9_ = cvtpk_b(e18_, e19_); e22_ = __builtin_amdgcn_exp2f(S1[6]); e23_ = __builtin_amdgcn_exp2f(S1[7]); sa += e20_; asm volatile("" : "+v"(w9_), "+v"(e22_), "+v"(e23_), "+v"(sa)); pwn[2][1] = w9_; } A_SBAR(); o[2] = __builtin_amdgcn_mfma_f32_32x32x16_bf16(__builtin_bit_cast(bf16x8, pw3), A_VFR(0, 3), o[2], 0, 0, 0); { sb += e21_; unsigned w10_ = cvtpk_b(e20_, e21_); e24_ = __builtin_amdgcn_exp2f(S1[8]); e25_ = __builtin_amdgcn_exp2f(S1[9]); asm volatile("" : "+v"(sb), "+v"(w10_), "+v"(e24_), "+v"(e25_)); pwn[2][2] = w10_; } A_SBAR(); \
    A_LWAIT(0); o[3] = __builtin_amdgcn_mfma_f32_32x32x16_bf16(__builtin_bit_cast(bf16x8, pw0), A_VFR(1, 0), o[3], 0, 0, 0); { sa += e22_; sb += e23_; unsigned w11_ = cvtpk_b(e22_, e23_); e26_ = __builtin_amdgcn_exp2f(S1[10]); e27_ = __builtin_amdgcn_exp2f(S1[11]); asm volatile("" : "+v"(sa), "+v"(sb), "+v"(w11_), "+v"(e26_), "+v"(e27_)); pwn[2][3] = w11_; } A_SBAR(); o[3] = __builtin_amdgcn_mfma_f32_32x32x16_bf16(__builtin_bit_cast(bf16x8, pw1), A_VFR(1, 1), o[3], 0, 0, 0); { sa += e24_; sb += e25_; unsigned w12_ = cvtpk_b(e24_, e25_); e28_ = __builtin_amdgcn_exp2f(S1[12]); e29_ = __builtin_amdgcn_exp2f(S1[13]); asm volatile("" : "+v"(sa), "+v"(sb), "+v"(w12_), "+v"(e28_), "+v"(e29_)); pwn[3][0] = w12_; } A_SBAR(); o[3] = __builtin_amdgcn_mfma_f32_32x32x16_bf16(__builtin_bit_cast(bf16x8, pw2), A_VFR(1, 2), o[3], 0, 0, 0); { sa += e26_; sb += e27_; unsigned w13_ = cvtpk_b(e26_, e27_); e30_ = __builtin_amdgcn_exp2f(S1[14]); e31_ = __builtin_amdgcn_exp2f(S1[15]); asm volatile("" : "+v"(sa), "+v"(sb), "+v"(w13_), "+v"(e30_), "+v"(e31_)); pwn[3][1] = w13_; } A_SBAR(); o[3] = __builtin_amdgcn_mfma_f32_32x32x16_bf16(__builtin_bit_cast(bf16x8, pw3), A_VFR(1, 3), o[3], 0, 0, 0); { sa += e28_; sb += e29_; unsigned w14_ = cvtpk_b(e28_, e29_); sa += e30_; sb += e31_; unsigned w15_ = cvtpk_b(e30_, e31_); asm volatile("" : "+v"(sa), "+v"(sb), "+v"(w14_), "+v"(w15_)); pwn[3][2] = w14_; pwn[3][3] = w15_; } A_SBAR(); \
      \
    float rm = sa + sb;                                     \
    { auto rr = __builtin_amdgcn_permlane32_swap(__float_as_uint(rm), __float_as_uint(rm), false, false); rm = __uint_as_float(rr[0]) + __uint_as_float(rr[1]); } \
    if (__builtin_expect(__any(rm > A_TRIG), 0)) { \
      const float dl = fmaxf(__builtin_amdgcn_logf(rm), 0.f); mhat += dl; \
      _Pragma("unroll") for (int r = 0; r < 16; ++r) negm[r] = -mhat; \
      asm volatile("" : "+v"(negm)); \
      const float f = __builtin_amdgcn_exp2f(-dl); l_reg *= f; sa *= f; sb *= f; \
      _Pragma("unroll") for (int q = 0; q < 4; ++q) _Pragma("unroll") for (int c = 0; c < 4; ++c) { const unsigned w_ = pwn[q][c]; pwn[q][c] = cvtpk_b(__uint_as_float(w_ << 16) * f, __uint_as_float(w_ & 0xffff0000u) * f); } \
      if (hi == 0) wsf[r32] = f; A_RESCALE_O(); } \
    l_reg += sa + sb; pw0 = pwn[0]; pw1 = pwn[1]; pw2 = pwn[2]; pw3 = pwn[3]; \
    if (i + ADEPTH < NT) A_WAITBAR(A_INFLIGHT); else A_WAITBAR(0); } while (0)
#define A_ROT() do { sV = sK; sK = s; s = (s == NSLOT - 1) ? 0 : s + 1; } while (0)
  int s = 0, sK = NSLOT - 1, sV = NSLOT - 2, i = 0;
  if (ROTL) {
  s16x4 vl[2][4], vh[2][4]; float sa = 0.f, sb = 0.f; u32x4 pwn[4]; float e0_, e1_, e2_, e3_, e4_, e5_, e6_, e7_, e8_, e9_, e10_, e11_, e12_, e13_, e14_, e15_, e16_, e17_, e18_, e19_, e20_, e21_, e22_, e23_, e24_, e25_, e26_, e27_, e28_, e29_, e30_, e31_;
  A_MBLOCK(true, false); A_VBLOCK(true); A_ROT();
#ifdef TPROBE
  unsigned long long tp0_ = __builtin_readcyclecounter(); unsigned long long tpa_ = 0;
#endif
  i = 1; A_ITER1(); A_ROT(); ++i;
#pragma unroll 1
  for (; i + 1 < NT; ) { A_ITER(); A_ROT(); ++i; A_ITER(); A_ROT(); ++i; }
  if (i < NT) { A_ITER(); A_ROT(); ++i; }
#ifdef TPROBE
  if (NT > 100 && blockIdx.x == 0 && wid == TP_WAVE) { const unsigned long long tp1_ = __builtin_readcyclecounter();
    if (lane == 0) g_tprobe = floorf(((float)(TPROBE == 1 ? tp1_ - tp0_ : tpa_) / (float)(NT - 1) - TP_OFF) * TP_SCALE * TP_Q + 0.5f) / TP_Q; }
#endif
  A_TAIL((void)0);
  __builtin_amdgcn_s_setprio(0);
  } else {
  A_MBLOCK(true, false); A_VBLOCK(true); A_ROT();
#pragma unroll 1
  for (i = 1; i < NT; ) { A_ITER0(); A_ROT(); ++i; }
  }
  A_MBLOCK(false, true);
#ifdef ATT_NOSTAGGER
  A_LGKBAR();
#endif
#undef A_KRD
#undef A_VRD
#undef A_VRD8
#undef A_LWAIT
#undef A_VFR
#undef A_PV4
#undef A_QK8
#undef A_KRD8
#undef A_RESCALE_O
#undef A_MBLOCK
#undef A_VBLOCK
#undef A_ROT
#undef A_SX
#undef A_TRIG
#undef A_GAP
#undef A_PV4I
#undef A_ITER
#undef A_ITER0
#undef A_ITER1
#undef A_HEAD
#undef A_TAIL
#undef A_BODY
#undef A_KRD8S
#undef A_KRD4B
#ifndef ATT_NOSTAGGER
  if (half == 0) A_LGKBAR();
#endif
  { auto rr = __builtin_amdgcn_permlane32_swap(__float_as_uint(l_reg), __float_as_uint(l_reg), false, false); l_out = __uint_as_float(rr[0]) + __uint_as_float(rr[1]); }
#undef DMA_K
#undef DMA_V
#undef DMA_VA
#undef DMA_VB
}

struct Tensors { const bf16_t* Q; const bf16_t* K; const bf16_t* V; bf16_t* MIX; float* scr; const float* g; float lam, oml; };
constexpr int MIXP = 2560, MIX_ATT = 1536, KTILES = 260;
template <bool ROTL> __device__ __forceinline__ void attn_unit(int h, int q0, int NT, const Tensors& T, char* lds) {
  int tid_ = threadIdx.x; asm volatile("" : "+v"(tid_));
  const int tid = tid_, wid = tid >> 6, lane = tid & 63, r32 = lane & 31, hi = lane >> 5;
  float* li_l = (float*)(lds + LDS_WS) + wid * 64 + 32;
  f32x16 o[4]; float l_reg;
  attn_pass<8, ROTL>(T.Q + (long)q0 * PITCH + h * 128 + 64, T.K + (size_t)(h * 2 + 1) * KTILES * 4096, T.V + (size_t)h * KTILES * 8192, NT, lds, o, l_reg);
  if (hi == 0) li_l[r32] = l_reg; asm volatile("s_waitcnt lgkmcnt(0)" ::: "memory");
  {
    float rli[16];
#pragma unroll
    for (int r = 0; r < 16; ++r) rli[r] = __builtin_amdgcn_rcpf(li_l[crow(r, hi)]);
    typedef float f4 __attribute__((ext_vector_type(4)));
    A_GAS f4* sp = (A_GAS f4*)(T.scr + (size_t)tid * 64);
#pragma unroll
    for (int d0 = 0; d0 < 4; ++d0)
#pragma unroll
      for (int r4 = 0; r4 < 4; ++r4) sp[d0 * 4 + r4] = (f4){o[d0][4 * r4] * rli[4 * r4], o[d0][4 * r4 + 1] * rli[4 * r4 + 1], o[d0][4 * r4 + 2] * rli[4 * r4 + 2], o[d0][4 * r4 + 3] * rli[4 * r4 + 3]};
  }
  asm volatile("s_waitcnt vmcnt(0) lgkmcnt(0)" ::: "memory");
  attn_pass<8, ROTL>(T.Q + (long)q0 * PITCH + h * 128, T.K + (size_t)(h * 2) * KTILES * 4096, T.V + (size_t)h * KTILES * 8192, NT, lds, o, l_reg);
  if (hi == 0) li_l[r32] = l_reg; asm volatile("s_waitcnt lgkmcnt(0)" ::: "memory");
  float ss[16];
#pragma unroll
  for (int r = 0; r < 16; ++r) ss[r] = 0.f;
  { typedef float f4 __attribute__((ext_vector_type(4)));
    const A_GAS f4* sp = (const A_GAS f4*)(T.scr + (size_t)tid * 64);
#pragma unroll
    for (int r4 = 0; r4 < 4; ++r4) { float rl[4];
#pragma unroll
      for (int q = 0; q < 4; ++q) rl[q] = __builtin_amdgcn_rcpf(li_l[crow(4 * r4 + q, hi)]);
#pragma unroll
      for (int d0 = 0; d0 < 4; ++d0) { const f4 p2 = sp[d0 * 4 + r4];
#pragma unroll
        for (int q = 0; q < 4; ++q) { const float v = o[d0][4 * r4 + q] * rl[q] - T.lam * p2[q]; o[d0][4 * r4 + q] = v; ss[4 * r4 + q] += v * v; } } } }
#pragma unroll
  for (int r = 0; r < 16; ++r) {
#pragma unroll
    for (int x = 1; x < 32; x <<= 1) ss[r] += __shfl_xor(ss[r], x);
    ss[r] = T.oml / sqrtf(ss[r] * (1.f / 128.f) + 1e-6f); }
  float gv[4];
#pragma unroll
  for (int d0 = 0; d0 < 4; ++d0) gv[d0] = ((const A_GAS float*)T.g)[d0 * 32 + r32];
  A_GAS bf16_t* Ow = (A_GAS bf16_t*)T.MIX + (long)(q0 + wid * QBLK) * MIXP + MIX_ATT + h * 128;
#pragma unroll
  for (int r = 0; r < 16; ++r) { const int orow = crow(r, hi);
#pragma unroll
    for (int d0 = 0; d0 < 4; ++d0) { const unsigned w = cvtpk(o[d0][r] * ss[r] * gv[d0], 0.f); Ow[(long)orow * MIXP + d0 * 32 + r32] = (bf16_t)(w & 0xffffu); } }
  asm volatile("s_waitcnt vmcnt(0) lgkmcnt(0)" ::: "memory");
  __syncthreads();
}
#undef A_WAITBAR
#undef A_LGKBAR
#undef A_SBAR
}
#define GAS __attribute__((address_space(1)))
#define LAS __attribute__((address_space(3)))
typedef unsigned short bf16;
typedef unsigned v4u __attribute__((ext_vector_type(4)));
typedef float f32x4 __attribute__((ext_vector_type(4)));
typedef short bf16x8 __attribute__((ext_vector_type(8)));
typedef GAS unsigned gu32;
typedef GAS unsigned long long gu64;
#define RLX_AGENT __ATOMIC_RELAXED, __HIP_MEMORY_SCOPE_AGENT
#define LDS_WAIT() asm volatile("s_waitcnt lgkmcnt(0)" ::: "memory")
#define VM_WAIT() asm volatile("s_waitcnt vmcnt(0)" ::: "memory")
__device__ __forceinline__ unsigned long long rt() { return __builtin_amdgcn_s_memrealtime(); }
__device__ __forceinline__ unsigned f2bf(float f) { unsigned u = __builtin_bit_cast(unsigned, f); return (u + 0x7fffu + ((u >> 16) & 1u)) >> 16; }
__device__ __forceinline__ unsigned pk2(float lo, float hi) { return f2bf(lo) | (f2bf(hi) << 16); }

#define XB_TMO      128
#define XB_XCNT(j)  (256  + 64 * (j))
#define XB_XSUB(j)  (1280 + 64 * (j))
#define XB_XGEN(j)  (2304 + 64 * (j))
#define XB_TOP      3328
#define XB_TOPGEN   3392
#define XCD_BAR_WORDS 3456
#define XB_SPIN_CAP (1u << 18)

__device__ __forceinline__ unsigned xb_ld(unsigned* p)              { return __hip_atomic_load(p, __ATOMIC_RELAXED, __HIP_MEMORY_SCOPE_AGENT); }
__device__ __forceinline__ unsigned xb_add(unsigned* p, unsigned v) { return __hip_atomic_fetch_add(p, v, __ATOMIC_RELAXED, __HIP_MEMORY_SCOPE_AGENT); }
__device__ __forceinline__ unsigned xb_xcc_id() { return (unsigned)__builtin_amdgcn_s_getreg((3 << 11) | 20) & 0xFu; }
#define XB_SPIN(cond, bar) do { unsigned _sp = 0; while (cond) { __builtin_amdgcn_s_sleep(1); \
    if ((++_sp & 255u) == 0u) { if (xb_ld(&(bar)[XB_TMO])) break; if (_sp > XB_SPIN_CAP) { atomicAdd(&(bar)[XB_TMO], 1u); break; } } } } while (0)

struct XcdBarrier {
    unsigned* bar; unsigned x;
    volatile LAS unsigned* st;
};

__device__ __forceinline__ XcdBarrier xcd_barrier_post(unsigned* bar, volatile LAS unsigned* st) {
    XcdBarrier b; b.bar = bar; b.x = xb_xcc_id(); b.st = st;
    if (threadIdx.x == 0) (void)xb_add(&bar[XB_XCNT(b.x)], 1u);
    return b;
}
__device__ __forceinline__ void xcd_barrier_complete(unsigned* bar, unsigned x, unsigned& nloc, unsigned& nx) {
    const unsigned G = gridDim.x * gridDim.y * gridDim.z;
    unsigned sum, cnt, mine, sp = 0u;
    for (;;) {
        sum = 0u; cnt = 0u; mine = 0u;
#pragma unroll
        for (unsigned j = 0; j < 16; ++j) { const unsigned c = xb_ld(&bar[XB_XCNT(j)]); sum += c; cnt += (c > 0u) ? 1u : 0u; mine = (j == x) ? c : mine; }
        if (sum == G) break;
        __builtin_amdgcn_s_sleep(1);
        if ((++sp & 255u) == 0u) { if (xb_ld(&bar[XB_TMO])) break; if (sp > XB_SPIN_CAP) { atomicAdd(&bar[XB_TMO], 1u); break; } }
    }
    nloc = mine > 0u ? mine : 1u; nx = cnt > 0u ? cnt : 1u;
}

__device__ __forceinline__ void xcd_barrier(const XcdBarrier& b) {
    asm volatile("s_waitcnt vmcnt(0)" ::: "memory");
    __syncthreads();
    if (threadIdx.x == 0) {
        unsigned* bar = b.bar;
        __builtin_amdgcn_s_waitcnt(0);
        unsigned nloc = b.st[0], nx = b.st[1];
        if (nloc == 0u) { xcd_barrier_complete(bar, b.x, nloc, nx); b.st[0] = nloc; b.st[1] = nx; }
        const unsigned old = xb_add(&bar[XB_XSUB(b.x)], 1u);
        const unsigned gen = old / nloc;
        if (old + 1u == (gen + 1u) * nloc) {
            __builtin_amdgcn_fence(__ATOMIC_RELEASE, "agent");
            asm volatile("s_waitcnt vmcnt(0)" ::: "memory");
            const unsigned og = xb_add(&bar[XB_TOP], 1u);
            const unsigned tg = og / nx;
            if (og + 1u == (tg + 1u) * nx) xb_add(&bar[XB_TOPGEN], 1u);
            else XB_SPIN(xb_ld(&bar[XB_TOPGEN]) == tg, bar);
            __builtin_amdgcn_fence(__ATOMIC_ACQUIRE, "agent");
            xb_add(&bar[XB_XGEN(b.x)], 1u);
            asm volatile("s_waitcnt vmcnt(0)" ::: "memory");
        } else {
            XB_SPIN(xb_ld(&bar[XB_XGEN(b.x)]) == gen, bar);
            __builtin_amdgcn_fence(__ATOMIC_ACQUIRE, "agent");
            asm volatile("s_waitcnt vmcnt(0)" ::: "memory");
        }
    }
    __syncthreads();
}
constexpr int DM = 2048, SEQ = 16384, CTXL = 256, ROWS = SEQ + CTXL, NMT = ROWS / 256;
constexpr int DIN = 4608, NMODV = 6 * DM, DEPTH = 2, NE = 32, DE = 512, NIN = 31;
constexpr int MIXP = 2560;
constexpr float LN_EPS = 1e-6f, ALPHA = 1.4142135623730951f;
constexpr float QSCALE = 0.125f * 1.4426950408889634f;
constexpr int LCAP = ROWS;
constexpr int NPH = 2 + 9 * DEPTH;

constexpr size_t MiB = 1u << 20, KiB = 1024;
constexpr size_t WS_CTL = 0, CTL_ZERO_BYTES = 128 * KiB;
constexpr size_t WS_MOD = 1 * MiB;
constexpr size_t WS_SMALL = 2 * MiB;
constexpr size_t WS_BINP = WS_SMALL, WS_ROPE = WS_SMALL + 64 * KiB, WS_BTA = WS_SMALL + 128 * KiB, WS_BTB = WS_SMALL + 192 * KiB, WS_F256 = WS_SMALL + 320 * KiB,
                 WS_LAMV = WS_SMALL + 576 * KiB, WS_CS128 = WS_SMALL + 640 * KiB  ;
constexpr size_t WS_WRT = 3 * MiB;
constexpr size_t WS_MODP = 4 * MiB;
constexpr size_t WS_WOT = 10 * MiB;
constexpr size_t WS_HB = 18 * MiB, WS_PWB = 21 * MiB;
constexpr size_t WS_WCAT = 26 * MiB;
constexpr size_t WS_WIN = 46 * MiB;
constexpr size_t WS_WGU = 82 * MiB;
constexpr size_t WS_WD = 210 * MiB;
constexpr size_t WS_XN = 274 * MiB;
constexpr size_t QKV_BYTES = (size_t)ROWS * 1024 * 2;
constexpr size_t WS_Q = 339 * MiB, WS_K = WS_Q + QKV_BYTES, WS_V = WS_K + QKV_BYTES, WS_AG = WS_V + QKV_BYTES;
constexpr size_t WS_YK = WS_Q;
constexpr size_t WS_UF = 469 * MiB, WS_UFC = 485 * MiB, WS_PF2 = 486 * MiB;
constexpr size_t WS_MIX = 518 * MiB;
constexpr size_t WS_T = 600 * MiB;
constexpr size_t WS_X2 = 730 * MiB;
constexpr size_t WS_ACT = 860 * MiB;
constexpr size_t WS_DMIX = WS_ACT;
constexpr size_t WS_O2N = 902 * MiB;
static_assert(WS_DMIX + (size_t)ROWS * DM * 2 <= 934 * MiB, "Dmix overlays ACT | O2N");
constexpr size_t WS_LIST = 934 * MiB;
constexpr size_t WS_WTOK = 939 * MiB;
constexpr size_t WS_END = 940 * MiB;
static_assert(WS_AG + QKV_BYTES <= WS_UF && WS_XN + (size_t)ROWS * DM * 2 <= WS_Q && WS_MIX + (size_t)ROWS * MIXP * 2 <= WS_T && WS_T + (size_t)ROWS * DM * 4 <= WS_X2 && WS_X2 + (size_t)ROWS * DM * 4 <= WS_ACT, "ws map");
static_assert(WS_WIN + (size_t)2 * DIN * DM * 2 <= WS_WGU && WS_WGU + (size_t)NE * 1024 * DM * 2 <= WS_WD && WS_WD + (size_t)NE * DM * DE * 2 <= WS_XN && WS_WCAT + (size_t)2 * DM * MIXP * 2 <= WS_WIN, "ws map 2");
constexpr int CW_TMO = 0, CW_CODE = 1, CW_BAR = 4096, CW_CNT = 16384, CW_CONVQ = 24576;
static_assert((size_t)(CW_CNT + 2 * 32 * 64) * 4 <= CTL_ZERO_BYTES, "control words inside the per-call memset");

constexpr int RING_OFF = 0, RING_BYTES = 139264;
constexpr int LDSCTL_OFF = RING_BYTES, MISC_OFF = LDSCTL_OFF + 320;
constexpr int LDS_BYTES = 147456;
constexpr int NWAVES = 8;

typedef float f32x2v __attribute__((ext_vector_type(2)));
typedef unsigned u32x2v __attribute__((ext_vector_type(2)));
using pg8::Unit;

__device__ __forceinline__ unsigned cvtpk(float lo, float hi) { unsigned r; asm volatile("v_cvt_pk_bf16_f32 %0, %1, %2" : "=v"(r) : "v"(lo), "v"(hi)); return r; }
__device__ __forceinline__ bf16 bf1(float x) { return (bf16)(cvtpk(x, 0.f) & 0xffffu); }
__device__ __forceinline__ float bf2f(unsigned short b) { return __uint_as_float((unsigned)b << 16); }
__device__ __forceinline__ float wave_sum(float v) {
#pragma unroll
    for (int o = 1; o < 64; o <<= 1) v += __shfl_xor(v, o);
    return v;
}
__device__ __forceinline__ float silu_f(float x) { return x / (1.f + __expf(-x)); }

struct Frame {
    LAS unsigned char* lds;
    volatile LAS unsigned* MISC;
    gu32* ctl;
    int tid, lane, wave;
    int vcu, G;
    const float* const* in; float* out; unsigned char* ws;
};

struct SchedWin { pg8::GridOrder go;
    __device__ __forceinline__ bool next(int i, Unit& u) const { return go.next(i, u); }
    __device__ __forceinline__ int arow(const Unit& u, int R) const { return (u.pn < 2 && u.pm >= 1) ? CTXL + 128 * (R & 127) + 2 * (u.pm - 1) + (R >> 7) : u.pm * 256 + R; }
    __device__ __forceinline__ int brow(const Unit& u) const { return u.pn * 256; } };
struct SchedNat { pg8::GridOrder go; int pmoff;
    __device__ __forceinline__ bool next(int i, Unit& u) const { if (!go.next(i, u)) return false; u.pm += pmoff; return true; }
    __device__ __forceinline__ int arow(const Unit& u, int R) const { return u.pm * 256 + R; }
    __device__ __forceinline__ int brow(const Unit& u) const { return u.pn * 256; } };
struct SchedFA { pg8::GridOrder go;
    __device__ __forceinline__ bool next(int i, Unit& u) const { return go.next(i, u); }
    __device__ __forceinline__ int arow(const Unit& u, int R) const { return (u.pm & 255) * 256 + R; }
    __device__ __forceinline__ int brow(const Unit&) const { return 0; } };
struct SchedFB { pg8::GridOrder go;
    __device__ __forceinline__ bool next(int i, Unit& u) const { return go.next(i, u); }
    __device__ __forceinline__ int arow(const Unit& u, int R) const { return (16 * (u.pm >> 3) + (R & 15)) * 128 + 16 * (u.pm & 7) + (R >> 4); }
    __device__ __forceinline__ int brow(const Unit&) const { return 0; } };
template <int WHICH> struct SchedMoe {
    const LAS int* tstart; const LAS int* cnt; const int* list; int G, c;
    static constexpr int NPN = WHICH == 1 ? 4 : 8;
    __device__ __forceinline__ bool next(int i, Unit& u) const {
        int L = i * G + c; const int nun = tstart[NE] * NPN; u.hb = -1;
        if (WHICH == 1 && nun > 2 * G && nun - 2 * G <= G / 2) {
            if (i == 2) { if (c >= 2 * (nun - 2 * G)) return false; L = 2 * G + (c >> 1); u.hb = c & 1; } else if (i > 2) return false; }
        const int gt = L / NPN; if (gt >= tstart[NE]) return false;
        int e = 0; while (tstart[e + 1] <= gt) ++e;
        u.pm = gt; u.pn = L % NPN; u.e = e; u.rt = gt - tstart[e]; return true; }
    __device__ __forceinline__ int arow(const Unit& u, int R) const {
        if (WHICH == 2) return u.pm * 256 + R;
        const int slot = u.rt * 256 + R; return slot < cnt[u.e] ? (((const GAS int*)list)[u.e * LCAP + slot] >> 1) : 0; }
    __device__ __forceinline__ int brow(const Unit& u) const { return WHICH == 1 ? u.e * 1024 + u.pn * 256 : u.e * DM + u.pn * 256; } };

struct EpiWin {
    static constexpr bool PERM = true;
    bf16 *Uf, *UfC, *AG, *Q, *Kb, *V; const float* bias; const f32x2v* rope;
    __device__ __forceinline__ void operator()(const f32x4 (&acc)[2][2][4][2], const Unit& u, int wr, int wc, int fr, int fq) const {
        const int pn = u.pn, pm = u.pm, c0 = wc * 32 + 8 * fq;
        f32x4 bv[2][2];
#pragma unroll
        for (int bj = 0; bj < 2; ++bj)
#pragma unroll
            for (int n = 0; n < 2; ++n) bv[bj][n] = *(const GAS f32x4*)(bias + pn * 256 + bj * 128 + c0 + 4 * n);
        if (pn < 2) {
#pragma unroll
            for (int ai = 0; ai < 2; ++ai)
#pragma unroll
                for (int m = 0; m < 4; ++m)
#pragma unroll
                    for (int bj = 0; bj < 2; ++bj) {
                        const f32x4 v0 = acc[ai][bj][m][0] + bv[bj][0], v1 = acc[ai][bj][m][1] + bv[bj][1];
                        const int ch = pn * 256 + bj * 128 + c0, a = wr * 64 + m * 16 + fr;
                        GAS bf16* dst; size_t st;
                        if (pm == 0) { dst = (GAS bf16*)UfC + (size_t)ch * 256 + (ai * 128 + a); st = 256; }
                        else { dst = (GAS bf16*)Uf + ((size_t)ch * 128 + (2 * (pm - 1) + ai)) * 128 + a; st = 128 * 128; }
                        dst[0] = bf1(v0[0]); dst[st] = bf1(v0[1]); dst[2 * st] = bf1(v0[2]); dst[3 * st] = bf1(v0[3]);
                        dst[4 * st] = bf1(v1[0]); dst[5 * st] = bf1(v1[1]); dst[6 * st] = bf1(v1[2]); dst[7 * st] = bf1(v1[3]);
                    }
        } else if (pn < 6) {
            bf16* base = AG; const int colt = (pn - 2) * 256;
#pragma unroll
            for (int ai = 0; ai < 2; ++ai)
#pragma unroll
                for (int m = 0; m < 4; ++m) { bf16* rowp = base + (size_t)(pm * 256 + ai * 128 + wr * 64 + m * 16 + fr) * 1024 + colt + c0;
#pragma unroll
                    for (int bj = 0; bj < 2; ++bj) { const f32x4 v0 = acc[ai][bj][m][0] + bv[bj][0], v1 = acc[ai][bj][m][1] + bv[bj][1];
                        v4u w; w.x = cvtpk(v0[0], v0[1]); w.y = cvtpk(v0[2], v0[3]); w.z = cvtpk(v1[0], v1[1]); w.w = cvtpk(v1[2], v1[3]);
                        *(GAS v4u*)(rowp + bj * 128) = w; } }
        } else if (pn >= 14) {
#pragma unroll
            for (int ai = 0; ai < 2; ++ai)
#pragma unroll
                for (int m = 0; m < 4; ++m) { const int row = pm * 256 + ai * 128 + wr * 64 + m * 16 + fr, t = row >> 6, key = row & 63;
#pragma unroll
                    for (int bj = 0; bj < 2; ++bj) { const f32x4 v0 = acc[ai][bj][m][0] + bv[bj][0], v1 = acc[ai][bj][m][1] + bv[bj][1];
                        v4u w; w.x = cvtpk(v0[0], v0[1]); w.y = cvtpk(v0[2], v0[3]); w.z = cvtpk(v1[0], v1[1]); w.w = cvtpk(v1[2], v1[3]);
                        const int h = 2 * (pn - 14) + bj;
                        *(GAS v4u*)(V + ((((size_t)h * 260 + t) * 16 + (c0 >> 5) * 4 + (key >> 4)) * 16 + (key & 15)) * 32 + (c0 & 31)) = w; } }
        } else {
            const bool isq = pn < 10; const int colt = (pn - (isq ? 6 : 10)) * 256; const float sc = isq ? QSCALE : 1.f;
#pragma unroll
            for (int ai = 0; ai < 2; ++ai)
#pragma unroll
                for (int m = 0; m < 4; ++m) { const int row = pm * 256 + ai * 128 + wr * 64 + m * 16 + fr;
                    f32x4 cs0 = (f32x4){1.f, 0.f, 1.f, 0.f}, cs1 = cs0;
                    if (pm > 0) { const int pos = row - CTXL; const int t = (wc & 1) ? 256 + (pos & 63) : (pos >> 6);
                        const GAS f32x4* rp = (const GAS f32x4*)(rope + t * 16 + 4 * fq); cs0 = rp[0]; cs1 = rp[1]; }
#pragma unroll
                    for (int bj = 0; bj < 2; ++bj) { const f32x4 v0 = acc[ai][bj][m][0] + bv[bj][0], v1 = acc[ai][bj][m][1] + bv[bj][1];
                        const float o0 = (v0[0] * cs0[0] - v0[1] * cs0[1]) * sc, o1 = (v0[0] * cs0[1] + v0[1] * cs0[0]) * sc;
                        const float o2 = (v0[2] * cs0[2] - v0[3] * cs0[3]) * sc, o3 = (v0[2] * cs0[3] + v0[3] * cs0[2]) * sc;
                        const float o4 = (v1[0] * cs1[0] - v1[1] * cs1[1]) * sc, o5 = (v1[0] * cs1[1] + v1[1] * cs1[0]) * sc;
                        const float o6 = (v1[2] * cs1[2] - v1[3] * cs1[3]) * sc, o7 = (v1[2] * cs1[3] + v1[3] * cs1[2]) * sc;
                        v4u w; w.x = cvtpk(o0, o1); w.y = cvtpk(o2, o3); w.z = cvtpk(o4, o5); w.w = cvtpk(o6, o7);
                        if (isq) *(GAS v4u*)(Q + (size_t)row * 1024 + colt + bj * 128 + c0) = w;
                        else {
                            const int h = (colt >> 7) + bj, t = row >> 6, key = row & 63;
                            *(GAS v4u*)(Kb + (((((size_t)(h * 2 + (c0 >> 6))) * 260 + t) * 8 + ((c0 & 63) >> 3)) * 64 + key) * 8) = w; } } }
        }
    }
};
struct EpiFA {
    static constexpr bool PERM = false;
    bf16* Pf2;
    __device__ __forceinline__ void operator()(const f32x4 (&acc)[2][2][4][2], const Unit& u, int wr, int wc, int fr, int fq) const {
#pragma unroll
        for (int m = 0; m < 4; ++m) { const int b = wr * 64 + m * 16 + fr;
#pragma unroll
            for (int n = 0; n < 2; ++n)
#pragma unroll
                for (int j = 0; j < 4; ++j) { const int klo = 32 * wc + 16 * n + 4 * fq + j;
                    const float f = (float)((b * klo) & 16383) * (1.f / 16384.f);
                    const float c = __builtin_amdgcn_cosf(f), s = __builtin_amdgcn_sinf(f);
#pragma unroll
                    for (int ai = 0; ai < 2; ++ai) { const float re = acc[ai][0][m][n][j], im = acc[ai][1][m][n][j];
                        GAS bf16* d = (GAS bf16*)Pf2 + (size_t)((2 * (u.pm & 255) + ai) * 128 + klo) * 256 + b;
                        d[0] = bf1(re * c + im * s); d[128] = bf1(im * c - re * s); } }
            asm volatile("" ::: "memory"); }
    }
};
struct EpiFB {
    static constexpr bool PERM = false;
    bf16* MIX;
    __device__ __forceinline__ void operator()(const f32x4 (&acc)[2][2][4][2], const Unit& u, int wr, int wc, int fr, int fq) const {
        const int ch = 16 * (u.pm >> 3) + fr;
#pragma unroll
        for (int ai = 0; ai < 2; ++ai)
#pragma unroll
            for (int m = 0; m < 4; ++m) { const int klo = 16 * (u.pm & 7) + 8 * ai + 4 * wr + m;
#pragma unroll
                for (int bj = 0; bj < 2; ++bj)
#pragma unroll
                    for (int n = 0; n < 2; ++n)
#pragma unroll
                        for (int j = 0; j < 4; ++j) { const int khi = 32 * wc + 16 * n + 4 * fq + j;
                            ((GAS bf16*)MIX)[(size_t)(CTXL + klo + 128 * khi) * MIXP + bj * 512 + ch] = bf1(acc[ai][bj][m][n][j]); }
                asm volatile("" ::: "memory"); }
    }
};
struct EpiCtxF {
    static constexpr bool PERM = false;
    bf16* MIX;
    __device__ __forceinline__ void operator()(const f32x4 (&acc)[2][2][4][2], const Unit& u, int wr, int wc, int fr, int fq) const {
#pragma unroll
        for (int ai = 0; ai < 2; ++ai)
#pragma unroll
            for (int m = 0; m < 4; ++m) { const int k = ai * 128 + wr * 64 + m * 16 + fr;
#pragma unroll
                for (int bj = 0; bj < 2; ++bj)
#pragma unroll
                    for (int n = 0; n < 2; ++n) { const f32x4 v = acc[ai][bj][m][n]; u32x2v w; w.x = cvtpk(v[0], v[1]); w.y = cvtpk(v[2], v[3]);
                        *(GAS u32x2v*)(MIX + (size_t)k * MIXP + u.pm * 512 + u.pn * 256 + bj * 128 + wc * 32 + 16 * n + 4 * fq) = w; }
                asm volatile("" ::: "memory"); }
    }
};
struct EpiWout {
    static constexpr bool PERM = true;
    const float* mod; bf16* Dm;
    __device__ __forceinline__ void operator()(const f32x4 (&acc)[2][2][4][2], const Unit& u, int wr, int wc, int fr, int fq) const {
        const int col0 = u.pn * 256 + wc * 32 + 8 * fq;
        const float* gp = mod + (u.pm == 0 ? NMODV : 0) + 2 * DM + col0;
        f32x4 gv[2][2];
#pragma unroll
        for (int bj = 0; bj < 2; ++bj)
#pragma unroll
            for (int n = 0; n < 2; ++n) gv[bj][n] = *(const GAS f32x4*)(gp + bj * 128 + 4 * n);
#pragma unroll
        for (int ai = 0; ai < 2; ++ai)
#pragma unroll
            for (int m = 0; m < 4; ++m) { bf16* rowp = Dm + (size_t)(u.pm * 256 + ai * 128 + wr * 64 + m * 16 + fr) * DM + col0;
#pragma unroll
                for (int bj = 0; bj < 2; ++bj) { const f32x4 v0 = acc[ai][bj][m][0] * gv[bj][0], v1 = acc[ai][bj][m][1] * gv[bj][1];
                    v4u w; w.x = cvtpk(v0[0], v0[1]); w.y = cvtpk(v0[2], v0[3]); w.z = cvtpk(v1[0], v1[1]); w.w = cvtpk(v1[2], v1[3]);
                    *(GAS v4u*)(rowp + bj * 128) = w; } }
    }
};
struct EpiFold {
    static constexpr bool PERM = true;
    bf16* out; int col0;
    __device__ __forceinline__ void operator()(const f32x4 (&acc)[2][2][4][2], const Unit& u, int wr, int wc, int fr, int fq) const {
        const int c0 = col0 + u.pn * 256 + wc * 32 + 8 * fq;
#pragma unroll
        for (int ai = 0; ai < 2; ++ai)
#pragma unroll
            for (int m = 0; m < 4; ++m) { bf16* rowp = out + (size_t)(u.pm * 256 + ai * 128 + wr * 64 + m * 16 + fr) * MIXP + c0;
#pragma unroll
                for (int bj = 0; bj < 2; ++bj) { const f32x4 v0 = acc[ai][bj][m][0], v1 = acc[ai][bj][m][1];
                    v4u w; w.x = cvtpk(v0[0], v0[1]); w.y = cvtpk(v0[2], v0[3]); w.z = cvtpk(v1[0], v1[1]); w.w = cvtpk(v1[2], v1[3]);
                    *(GAS v4u*)(rowp + bj * 128) = w; } }
    }
};
struct EpiMoe1 {
    static constexpr bool PERM = true;
    bf16* ACT;
    __device__ __forceinline__ void operator()(const f32x4 (&acc)[2][2][4][2], const Unit& u, int wr, int wc, int fr, int fq) const {
#pragma unroll
        for (int ai = 0; ai < 2; ++ai)
#pragma unroll
            for (int m = 0; m < 4; ++m) { bf16* rowp = ACT + (size_t)(u.pm * 256 + ai * 128 + wr * 64 + m * 16 + fr) * DE + u.pn * 128 + wc * 16 + 4 * fq;
#pragma unroll
                for (int bj = 0; bj < 2; ++bj) { if (u.hb >= 0 && u.hb != bj) continue;
                    const f32x4 v0 = acc[ai][bj][m][0], v1 = acc[ai][bj][m][1];
                    u32x2v w; w.x = cvtpk(silu_f(v0[0]) * v0[1], silu_f(v0[2]) * v0[3]); w.y = cvtpk(silu_f(v1[0]) * v1[1], silu_f(v1[2]) * v1[3]);
                    *(GAS u32x2v*)(rowp + bj * 64) = w; } }
    }
};
struct EpiMoe2 {
    static constexpr bool PERM = true;
    const LAS int* cnt; const int* list; const float* wtok; bf16* YK;
    __device__ __forceinline__ void operator()(const f32x4 (&acc)[2][2][4][2], const Unit& u, int wr, int wc, int fr, int fq) const {
        const int n = cnt[u.e];
#pragma unroll
        for (int ai = 0; ai < 2; ++ai)
#pragma unroll
            for (int m = 0; m < 4; ++m) { const int slot = u.rt * 256 + ai * 128 + wr * 64 + m * 16 + fr;
                if (slot < n) { const int tk = ((const GAS int*)list)[u.e * LCAP + slot]; const float w8 = ((const GAS float*)wtok)[tk];
                    bf16* rowp = YK + (size_t)tk * DM + u.pn * 256 + wc * 32 + 8 * fq;
#pragma unroll
                    for (int bj = 0; bj < 2; ++bj) { const f32x4 v0 = acc[ai][bj][m][0] * w8, v1 = acc[ai][bj][m][1] * w8;
                        v4u w; w.x = cvtpk(v0[0], v0[1]); w.y = cvtpk(v0[2], v0[3]); w.z = cvtpk(v1[0], v1[1]); w.w = cvtpk(v1[2], v1[3]);
                        *(GAS v4u*)(rowp + bj * 128) = w; } } }
    }
};
template <int MODE> __device__ __forceinline__ int t_rowmap(int n) {
    if (MODE == 2) return 2 * n; if (MODE == 3) return 2 * n + 1;
    if (MODE == 1) { if (n >= 1536 && n < 3584) { const int q = n - 1536, d = q & 63; return 1536 + (q & ~63) + (d < 32 ? 2 * d : 2 * (d - 32) + 1); } return n; }
    return n; }
struct TrLoad { f32x4 v[16]; };
__device__ __forceinline__ void tr_load(TrLoad& t, const float* W, int ldw, int nblk  , int item, int lane) {
    const int kb = item / nblk, nb = item % nblk, k0 = 64 * kb, n0 = 64 * nb, lr = lane >> 4, lc = (lane & 15) * 4;
#pragma unroll
    for (int i = 0; i < 16; ++i) t.v[i] = *(const GAS f32x4*)(W + (size_t)(k0 + 4 * i + lr) * ldw + n0 + lc);
}
template <int MODE> __device__ __forceinline__ void tr_finish(const TrLoad& t, int nblk, bf16* WT, int dpitch, int dcol0, LAS float* scr, int item, int lane) {
    const int kb = item / nblk, nb = item % nblk, k0 = 64 * kb, n0 = 64 * nb, lr = lane >> 4, lc = (lane & 15) * 4;
#pragma unroll
    for (int i = 0; i < 16; ++i) { LAS float* d = scr + (4 * i + lr) * 65 + lc; d[0] = t.v[i][0]; d[1] = t.v[i][1]; d[2] = t.v[i][2]; d[3] = t.v[i][3]; }
    LDS_WAIT(); asm volatile("" ::: "memory");
    const int c = lane & 7;
#pragma unroll
    for (int j = 0; j < 8; ++j) { const int n = (lane >> 3) + 8 * j; const LAS float* s = scr + (8 * c) * 65 + n;
        v4u o; o.x = pk2(s[0 * 65], s[1 * 65]); o.y = pk2(s[2 * 65], s[3 * 65]); o.z = pk2(s[4 * 65], s[5 * 65]); o.w = pk2(s[6 * 65], s[7 * 65]);
        *(GAS v4u*)(WT + (size_t)t_rowmap<MODE>(n0 + n) * dpitch + dcol0 + k0 + 8 * c) = o; }
    LDS_WAIT(); asm volatile("" ::: "memory");
}
template <int MODE> __device__ __forceinline__ void transpose_item(const float* W, int ldw, int nblk, bf16* WT, int dpitch, int dcol0, LAS float* scr, int item, int lane) {
    TrLoad t; tr_load(t, W, ldw, nblk, item, lane); tr_finish<MODE>(t, nblk, WT, dpitch, dcol0, scr, item, lane);
}
__device__ __forceinline__ void convert_experts(Frame& F, int l, LAS float* scr) {
    const int gw = F.vcu * NWAVES + F.wave, NGW = F.G * NWAVES;
    bf16* WGU = (bf16*)(F.ws + WS_WGU); bf16* WD = (bf16*)(F.ws + WS_WD);
    for (int it = gw; it < NE * 768; it += NGW) { const int e = it / 768, r = it % 768;
        if (r < 256) transpose_item<2>(F.in[26] + (size_t)(l * NE + e) * DM * DE, DE, 8, WGU + (size_t)e * 1024 * DM, DM, 0, scr, r, F.lane);
        else if (r < 512) transpose_item<3>(F.in[27] + (size_t)(l * NE + e) * DM * DE, DE, 8, WGU + (size_t)e * 1024 * DM, DM, 0, scr, r - 256, F.lane);
        else transpose_item<0>(F.in[28] + (size_t)(l * NE + e) * DE * DM, DM, 32, WD + (size_t)e * DM * DE, DE, 0, scr, r - 512, F.lane); }
}
__device__ __forceinline__ void f32gemm_tile(const float* A, int lda, const float* B, int ldb, int Kd, int mb, int nb, int lane, f32x4 (&acc)[4]) {
    const int n = nb * 256 + lane * 4;
#pragma unroll
    for (int i = 0; i < 4; ++i) acc[i] = (f32x4){0.f, 0.f, 0.f, 0.f};
    const float* a0 = A + (size_t)(mb * 4) * lda;
#pragma unroll 8
    for (int k = 0; k < Kd; ++k) { const f32x4 b = *(const GAS f32x4*)(B + (size_t)k * ldb + n);
#pragma unroll
        for (int i = 0; i < 4; ++i) acc[i] += b * ((const GAS float*)a0)[(size_t)i * lda + k]; }
}

__device__ __forceinline__ void ph_prologue_a(Frame& F) {
    const int gw = F.vcu * NWAVES + F.wave, NGW = F.G * NWAVES;
    if (F.tid < 128) { float s_, c_; sincospif(2.0f * (float)F.tid / 128.0f, &s_, &c_); LAS float* cst = (LAS float*)(F.lds + LDSCTL_OFF + 2048); cst[F.tid] = c_; cst[128 + F.tid] = s_; }
    { LAS float* sil = (LAS float*)(F.lds + RING_OFF);
      for (int i = F.tid; i < 2 * DM; i += NWAVES * 64) { const float x = i < DM ? F.in[1][i] : F.in[3][i - DM]; sil[i] = silu_f(x); }
      __syncthreads();
      float* MODP = (float*)(F.ws + WS_T);
      for (int it = F.vcu; it < 64 * 12; it += F.G) { const int kc = it & 63, rest = it >> 6, l = rest / 6, jb = rest % 6, j = jb * 2048 + F.tid * 4;
          const float* W = F.in[4] + ((size_t)l * DM + kc * 32) * NMODV + j; f32x4 s0 = (f32x4){0.f, 0.f, 0.f, 0.f}, s1 = s0;
#pragma unroll 8
          for (int k = 0; k < 32; ++k) { const f32x4 w = *(const GAS f32x4*)(W + (size_t)k * NMODV); s0 += w * sil[kc * 32 + k]; s1 += w * sil[DM + kc * 32 + k]; }
          *(GAS f32x4*)(MODP + ((size_t)(kc * 2 + l) * 2 + 0) * NMODV + j) = s0; *(GAS f32x4*)(MODP + ((size_t)(kc * 2 + l) * 2 + 1) * NMODV + j) = s1; }
      __syncthreads(); }
    LAS float* scr = (LAS float*)(F.lds + RING_OFF + F.wave * 16896);
    for (int it = gw; it < 2 * 2304 + 2 * 512 + 2 * 512; it += NGW) {
        if (it < 4608) { const int l = it / 2304, r = it % 2304; transpose_item<1>(F.in[6] + (size_t)l * DM * DIN, DIN, 72, (bf16*)(F.ws + WS_WIN) + (size_t)l * DIN * DM, DM, 0, scr, r, F.lane); }
        else if (it < 5632) { const int q = it - 4608, l = q / 512, r = q % 512; transpose_item<0>(F.in[19] + (size_t)l * DM * DM + (size_t)1024 * DM, DM, 32, (bf16*)(F.ws + WS_WCAT) + (size_t)l * DM * MIXP, MIXP, 1536, scr, r, F.lane); }
        else { const int q = it - 5632, l = q / 512, r = q % 512; transpose_item<0>(F.in[19] + (size_t)l * DM * DM, DM, 32, (bf16*)(F.ws + WS_WOT) + (size_t)l * DM * 1024, 1024, 0, scr, r, F.lane); } }
    convert_experts(F, 0, scr);
    { const LAS float* cst = (const LAS float*)(F.lds + LDSCTL_OFF + 2048);
      for (int wt = gw; wt < 2 * 8 * 64; wt += NGW) { const int sel = wt >> 6, l = sel >> 3, part = (sel >> 2) & 1, g = sel & 3, r = wt & 63, mb = r >> 1, nb = r & 1;
          const float* B = F.in[8] + (size_t)l * 512 * 512 + (size_t)(128 * g) * 512; const int n = nb * 256 + F.lane * 4;
          f32x4 acc[4];
#pragma unroll
          for (int i = 0; i < 4; ++i) acc[i] = (f32x4){0.f, 0.f, 0.f, 0.f};
#pragma unroll 8
          for (int j = 0; j < 128; ++j) { const f32x4 b = *(const GAS f32x4*)(B + (size_t)j * 512 + n);
#pragma unroll
              for (int i = 0; i < 4; ++i) acc[i] += b * cst[part * 128 + (((mb * 4 + i) * j) & 127)]; }
          bf16* HB = (bf16*)(F.ws + WS_HB) + (size_t)l * 1024 * 512; const float sc = 0.08838834764831845f;
#pragma unroll
          for (int i = 0; i < 4; ++i) { u32x2v w; w.x = cvtpk(acc[i][0] * sc, acc[i][1] * sc); w.y = cvtpk(acc[i][2] * sc, acc[i][3] * sc);
              *(GAS u32x2v*)(HB + (size_t)(part * 512 + g * 128 + mb * 4 + i) * 512 + n) = w; } }
      const int gt = F.vcu * NWAVES * 64 + F.tid, NTH = F.G * NWAVES * 64;
      for (int idx = gt; idx < 2 * 512 * 512 / 4; idx += NTH) { const f32x4 v = *(const GAS f32x4*)(F.in[13] + (size_t)idx * 4);
          u32x2v w; w.x = cvtpk(v[0], v[1]); w.y = cvtpk(v[2], v[3]); *(GAS u32x2v*)((bf16*)(F.ws + WS_PWB) + (size_t)idx * 4) = w; } }
    { const int gt = F.vcu * NWAVES * 64 + F.tid, NT = F.G * NWAVES * 64;
      constexpr int R0 = 9216, R1 = R0 + 5120, R2 = R1 + 32768, R3 = R2 + 65536, R4 = R3 + 131072, R5 = R4 + 32768, R6 = R5 + 49152, R7 = R6 + 2;
      for (int idx = gt; idx < R7; idx += NT) {
          if (idx < R0) { const int l = idx / DIN, c = idx % DIN; int src = c;
              if (c >= 1536 && c < 3584) { const int q = c - 1536, p = q & 63; src = 1536 + (q & ~63) + (p & 1) * 32 + (p >> 1); }
              ((float*)(F.ws + WS_BINP))[idx] = F.in[7][l * DIN + src]; }
          else if (idx < R1) { const int q = idx - R0, t = q >> 4, i = q & 15, p = t < 256 ? t : t - 256;
              const float inv = 1.0f / powf(10000.0f, (float)i / 16.0f), ang = (float)p * inv; float s, c; sincosf(ang, &s, &c);
              ((f32x2v*)(F.ws + WS_ROPE))[q] = (f32x2v){c, s}; }
          else if (idx < R2) { const int q = idx - R1, np = q >> 7, a = q & 127, kk = np & 127; float s, c; sincospif(2.0f * (float)((a * kk) & 127) / 128.0f, &s, &c);
              ((bf16*)(F.ws + WS_BTA))[q] = bf1((np < 128 ? c : -s) * 0.08838834764831845f); }
          else if (idx < R3) { const int q = idx - R2, np = q >> 8, k = q & 255, khi = np & 127, b = k & 127; float s, c; sincospif(2.0f * (float)((b * khi) & 127) / 128.0f, &s, &c);
              const float v = np < 128 ? (k < 128 ? c : s) : (k < 128 ? -s : c); ((bf16*)(F.ws + WS_BTB))[q] = bf1(v * 0.08838834764831845f); }
          else if (idx < R4) { const int q = idx - R3, r = q >> 8, n = q & 255, k = r & 255; float s, c; sincospif(2.0f * (float)((k * n) & 255) / 256.0f, &s, &c);
              ((bf16*)(F.ws + WS_F256))[q] = bf1((r < 256 ? c : -s) * 0.0625f); }
          else if (idx < R5) { const int q = idx - R4, part = q >> 14, m = (q >> 7) & 127, j = q & 127; float s, c; sincospif(2.0f * (float)((m * j) & 127) / 128.0f, &s, &c);
              ((float*)(F.ws + WS_CS128))[q] = part ? s : c; }
          else if (idx < R6) { const int q = idx - R5, l = q / 24576, r = q % 24576, hl = r / 12288, r2 = r % 12288, ks = r2 / 192, nt = (r2 / 64) % 3, ln = r2 & 63;
              const int n = 16 * nt + (ln & 15), k0 = 32 * ks + 8 * (ln >> 4); unsigned short o[8];
#pragma unroll
              for (int j = 0; j < 8; ++j) { const int k = k0 + j; float w = 0.f;
                  if (n < 4) w = F.in[22][((size_t)l * DM + k) * 4 + n]; else if (n < 36) w = F.in[24][((size_t)l * DM + k) * 32 + (n - 4)];
                  const unsigned short h = bf1(w); o[j] = hl ? bf1(w - bf2f(h)) : h; }
              v4u w4; w4.x = o[0] | ((unsigned)o[1] << 16); w4.y = o[2] | ((unsigned)o[3] << 16); w4.z = o[4] | ((unsigned)o[5] << 16); w4.w = o[6] | ((unsigned)o[7] << 16);
              ((v4u*)(F.ws + WS_WRT))[q] = w4; }
          else { const int l = idx - R6; float a = 0.f, b = 0.f;
              for (int i = 0; i < 64; ++i) { a += F.in[14][l * 64 + i] * F.in[15][l * 64 + i]; b += F.in[16][l * 64 + i] * F.in[17][l * 64 + i]; }
              const float lam_init = 0.8f - 0.6f * expf(-0.3f * (float)l);
              ((float*)(F.ws + WS_LAMV))[l] = expf(a) - expf(b) + lam_init; }
      } }
}
__device__ __forceinline__ void ph_prologue_b(Frame& F) {
    const int gw = F.vcu * NWAVES + F.wave, NGW = F.G * NWAVES;
    { const int gt = F.vcu * NWAVES * 64 + F.tid, NT = F.G * NWAVES * 64; const float* MODP = (const float*)(F.ws + WS_T); float* MOD = (float*)(F.ws + WS_MOD);
      for (int idx = gt; idx < 4 * NMODV; idx += NT) { const int lv = idx / NMODV, j = idx % NMODV, l = lv >> 1; float s = F.in[5][l * NMODV + j];
          for (int kc = 0; kc < 64; ++kc) s += MODP[((size_t)kc * 4 + lv) * NMODV + j];
          MOD[idx] = s; } }
#pragma unroll 1
    for (int l = 0; l < DEPTH; ++l) {
        { pg8::Gemm g{(const bf16*)(F.ws + WS_WOT) + (size_t)l * DM * 1024, (const bf16*)(F.ws + WS_HB) + (size_t)l * 1024 * 512, 512, 1024};
          SchedNat S; S.go.init(8, 4, F.G, (int)((blockIdx.x + F.G - 48 * l) % F.G)); S.pmoff = 0; EpiFold E{(bf16*)(F.ws + WS_WCAT) + (size_t)l * DM * MIXP, 0};
          pg8::gemm_phase<EpiFold, SchedNat>(F.lds + RING_OFF, g, S, E); }
        { pg8::Gemm g{(const bf16*)(F.ws + WS_WOT) + (size_t)l * DM * 1024 + 512, (const bf16*)(F.ws + WS_PWB) + (size_t)l * 512 * 512, 512, 1024};
          SchedNat S; S.go.init(8, 2, F.G, (int)((blockIdx.x + F.G - 48 * l - 32) % F.G)); S.pmoff = 0; EpiFold E{(bf16*)(F.ws + WS_WCAT) + (size_t)l * DM * MIXP, 1024};
          pg8::gemm_phase<EpiFold, SchedNat>(F.lds + RING_OFF, g, S, E); } }
}

struct RowV { f32x4 v[8]; };
__device__ __forceinline__ void row_load(RowV& r, const float* p, int lane) {
#pragma unroll
    for (int j = 0; j < 4; ++j) { r.v[2 * j] = *(const GAS f32x4*)(p + 512 * j + 8 * lane); r.v[2 * j + 1] = *(const GAS f32x4*)(p + 512 * j + 8 * lane + 4); } }
__device__ __forceinline__ void row_load_bf16(RowV& r, const bf16* p, int lane) {
#pragma unroll
    for (int j = 0; j < 4; ++j) { const v4u d = *(const GAS v4u*)(p + 512 * j + 8 * lane);
        r.v[2 * j] = (f32x4){__uint_as_float(d.x << 16), __uint_as_float(d.x & 0xffff0000u), __uint_as_float(d.y << 16), __uint_as_float(d.y & 0xffff0000u)};
        r.v[2 * j + 1] = (f32x4){__uint_as_float(d.z << 16), __uint_as_float(d.z & 0xffff0000u), __uint_as_float(d.w << 16), __uint_as_float(d.w & 0xffff0000u)}; } }
__device__ __forceinline__ void row_store(const RowV& r, float* p, int lane) {
#pragma unroll
    for (int j = 0; j < 4; ++j) { *(GAS f32x4*)(p + 512 * j + 8 * lane) = r.v[2 * j]; *(GAS f32x4*)(p + 512 * j + 8 * lane + 4) = r.v[2 * j + 1]; } }
__device__ __forceinline__ void row_norm(RowV& r) {
    float s = 0.f;
#pragma unroll
    for (int i = 0; i < 8; ++i) s += (r.v[i][0] + r.v[i][1]) + (r.v[i][2] + r.v[i][3]);
    const float mean = wave_sum(s) * (1.f / DM); float q = 0.f;
#pragma unroll
    for (int i = 0; i < 8; ++i) { r.v[i] = r.v[i] - mean; q += (r.v[i][0] * r.v[i][0] + r.v[i][1] * r.v[i][1]) + (r.v[i][2] * r.v[i][2] + r.v[i][3] * r.v[i][3]); }
    const float rstd = 1.f / sqrtf(wave_sum(q) * (1.f / DM) + LN_EPS);
#pragma unroll
    for (int i = 0; i < 8; ++i) r.v[i] = r.v[i] * rstd; }
__device__ __forceinline__ void row_affine(RowV& r, const float* mulp, float madd, const float* addp, int lane) {
#pragma unroll
    for (int j = 0; j < 4; ++j)
#pragma unroll
        for (int h = 0; h < 2; ++h) { const f32x4 m = *(const GAS f32x4*)(mulp + 512 * j + 8 * lane + 4 * h), a = *(const GAS f32x4*)(addp + 512 * j + 8 * lane + 4 * h);
            r.v[2 * j + h] = r.v[2 * j + h] * (m + madd) + a; } }
__device__ __forceinline__ void row_store_bf16(const RowV& r, bf16* p, int lane) {
#pragma unroll
    for (int j = 0; j < 4; ++j) { v4u w; w.x = cvtpk(r.v[2 * j][0], r.v[2 * j][1]); w.y = cvtpk(r.v[2 * j][2], r.v[2 * j][3]); w.z = cvtpk(r.v[2 * j + 1][0], r.v[2 * j + 1][1]); w.w = cvtpk(r.v[2 * j + 1][2], r.v[2 * j + 1][3]);
        *(GAS v4u*)(p + 512 * j + 8 * lane) = w; } }

__device__ __forceinline__ void ph_ln1(Frame& F, int l, const float* xc, const float* xl) {
    const int gw = F.vcu * NWAVES + F.wave, NGW = F.G * NWAVES; const float* MOD = (const float*)(F.ws + WS_MOD) + (size_t)l * 2 * NMODV; bf16* XN = (bf16*)(F.ws + WS_XN);
    for (int r = gw; r < ROWS; r += NGW) { const float* xp = r < CTXL ? xc + (size_t)r * DM : xl + (size_t)(r - CTXL) * DM; const float* mp = MOD + (r < CTXL ? NMODV : 0);
        RowV v; row_load(v, xp, F.lane); row_norm(v); row_affine(v, mp + DM, 1.f, mp, F.lane); row_store_bf16(v, XN + (size_t)r * DM, F.lane); }
}

__device__ __forceinline__ void conv_unit(Frame& F, int l, int ub) {
    const int row0 = 32 * ub, lo = row0 < CTXL ? 0 : CTXL, hi = row0 < CTXL ? CTXL : ROWS;
    const bf16* AG = (const bf16*)(F.ws + WS_AG); bf16* MIX = (bf16*)(F.ws + WS_MIX);
    LAS bf16* U = (LAS bf16*)(F.lds + RING_OFF);
    LAS float* Y = (LAS float*)(F.lds + RING_OFF + 65536);
    for (int it = F.tid; it < 62 * 64; it += NWAVES * 64) { const int t = it >> 6, c8 = (it & 63) * 8, gr = row0 - 15 + t;
        v4u o = (v4u){0u, 0u, 0u, 0u};
        if (gr >= lo && gr < hi) { const v4u a = *(const GAS v4u*)(AG + (size_t)gr * 1024 + c8), g = *(const GAS v4u*)(AG + (size_t)gr * 1024 + 512 + c8);
            const unsigned aw[4] = {a.x, a.y, a.z, a.w}, gw[4] = {g.x, g.y, g.z, g.w}; unsigned ow[4];
#pragma unroll
            for (int q = 0; q < 4; ++q) { const float a0 = __uint_as_float(aw[q] << 16), a1 = __uint_as_float(aw[q] & 0xffff0000u), g0 = __uint_as_float(gw[q] << 16), g1 = __uint_as_float(gw[q] & 0xffff0000u);
                ow[q] = cvtpk(a0 / (1.f + __expf(-g0)), a1 / (1.f + __expf(-g1))); }
            o = (v4u){ow[0], ow[1], ow[2], ow[3]}; }
        *(LAS v4u*)(U + t * 512 + c8) = o; }
    __syncthreads();
    { const int c = F.tid; float w[31];
#pragma unroll
      for (int j = 0; j < 31; ++j) w[j] = ((const GAS float*)F.in[9])[((size_t)l * 31 + j) * 512 + c];
      const float cb = F.in[10][l * 512 + c];
#pragma unroll
      for (int half = 0; half < 2; ++half) { float u[46];
#pragma unroll
          for (int t = 0; t < 46; ++t) u[t] = bf2f(U[(half * 16 + t) * 512 + c]);
#pragma unroll
          for (int n = 0; n < 16; ++n) { float s = cb;
#pragma unroll
              for (int j = 0; j < 31; ++j) s += u[n + j] * w[j];
              Y[(half * 16 + n) * 512 + c] = s; } } }
    __syncthreads();
    { const float* lg = F.in[11] + l * 512 + 8 * F.lane; const float* lb = F.in[12] + l * 512 + 8 * F.lane;
      const f32x4 g0 = *(const f32x4*)lg, g1 = *(const GAS f32x4*)(lg + 4), b0 = *(const f32x4*)lb, b1 = *(const GAS f32x4*)(lb + 4);
#pragma unroll
      for (int i = 0; i < 4; ++i) { const int n = 4 * F.wave + i; f32x4 y0 = *(LAS f32x4*)(Y + n * 512 + 8 * F.lane), y1 = *(LAS f32x4*)(Y + n * 512 + 8 * F.lane + 4);
          const float mean = wave_sum((y0[0] + y0[1]) + (y0[2] + y0[3]) + (y1[0] + y1[1]) + (y1[2] + y1[3])) * (1.f / 512.f);
          y0 = y0 - mean; y1 = y1 - mean;
          const float var = wave_sum((y0[0] * y0[0] + y0[1] * y0[1]) + (y0[2] * y0[2] + y0[3] * y0[3]) + (y1[0] * y1[0] + y1[1] * y1[1]) + (y1[2] * y1[2] + y1[3] * y1[3])) * (1.f / 512.f);
          const float rstd = 1.f / sqrtf(var + LN_EPS);
          y0 = y0 * rstd * g0 + b0; y1 = y1 * rstd * g1 + b1;
          v4u w4; w4.x = cvtpk(silu_f(y0[0]), silu_f(y0[1])); w4.y = cvtpk(silu_f(y0[2]), silu_f(y0[3])); w4.z = cvtpk(silu_f(y1[0]), silu_f(y1[1])); w4.w = cvtpk(silu_f(y1[2]), silu_f(y1[3]));
          *(GAS v4u*)(MIX + (size_t)(row0 + n) * MIXP + 1024 + 8 * F.lane) = w4; } }
    __syncthreads();
}
constexpr int HP = DM + 8;
template <bool XBF> __device__ __forceinline__ void ph_ln_router(Frame& F, int l, const void* xcv, const void* xlv) {
    const float* MOD = (const float*)(F.ws + WS_MOD) + (size_t)l * 2 * NMODV; bf16* T = (bf16*)(F.ws + WS_T); bf16* XN = (bf16*)(F.ws + WS_XN); const bf16* DMX = (const bf16*)(F.ws + WS_DMIX);
    const float* ga = F.in[20] + (size_t)l * DM; const float* ba = F.in[21] + (size_t)l * DM;
    const v4u* WRT = (const v4u*)(F.ws + WS_WRT) + (size_t)l * 24576;
    int* LIST = (int*)(F.ws + WS_LIST) + (size_t)l * NE * LCAP; float* WTOK = (float*)(F.ws + WS_WTOK) + (size_t)l * 2 * ROWS;
    LAS bf16* HHI = (LAS bf16*)(F.lds + RING_OFF); LAS bf16* HLO = HHI + 16 * HP;
    LAS float* PART = (LAS float*)(F.lds + RING_OFF);
    LAS float* LOGI = (LAS float*)(F.lds + RING_OFF + 32768);
    const int fr = F.lane & 15, fq = F.lane >> 4;
    const int blk0 = (l + 1 < DEPTH) ? 0 : CTXL / 16;
    for (int blk = blk0 + F.vcu; blk < ROWS / 16; blk += F.G) {
        RowV vv[2];
#pragma unroll
        for (int i = 0; i < 2; ++i) { const int r = blk * 16 + 2 * F.wave + i;
            if (XBF) row_load_bf16(vv[i], r < CTXL ? (const bf16*)xcv + (size_t)r * DM : (const bf16*)xlv + (size_t)(r - CTXL) * DM, F.lane);
            else row_load(vv[i], r < CTXL ? (const float*)xcv + (size_t)r * DM : (const float*)xlv + (size_t)(r - CTXL) * DM, F.lane);
#pragma unroll
            for (int j = 0; j < 4; ++j) { const v4u d = *(const GAS v4u*)(DMX + (size_t)r * DM + 512 * j + 8 * F.lane);
                vv[i].v[2 * j] = vv[i].v[2 * j] * ALPHA + (f32x4){__uint_as_float(d.x << 16), __uint_as_float(d.x & 0xffff0000u), __uint_as_float(d.y << 16), __uint_as_float(d.y & 0xffff0000u)};
                vv[i].v[2 * j + 1] = vv[i].v[2 * j + 1] * ALPHA + (f32x4){__uint_as_float(d.z << 16), __uint_as_float(d.z & 0xffff0000u), __uint_as_float(d.w << 16), __uint_as_float(d.w & 0xffff0000u)}; } }
#pragma unroll
        for (int i = 0; i < 2; ++i) { const int rl = 2 * F.wave + i, r = blk * 16 + rl; const float* mp = MOD + (r < CTXL ? NMODV : 0);
            RowV& v = vv[i]; row_norm(v); row_affine(v, ga, 0.f, ba, F.lane); row_store_bf16(v, T + (size_t)r * DM, F.lane);
            row_norm(v); row_affine(v, mp + 4 * DM, 1.f, mp + 3 * DM, F.lane);
#pragma unroll
            for (int j = 0; j < 4; ++j) { unsigned hw[4], lw[4];
#pragma unroll
                for (int q = 0; q < 4; ++q) { const float a = v.v[2 * j + (q >> 1)][(q & 1) * 2], b = v.v[2 * j + (q >> 1)][(q & 1) * 2 + 1];
                    const unsigned h = cvtpk(a, b); hw[q] = h; lw[q] = cvtpk(a - __uint_as_float(h << 16), b - __uint_as_float(h & 0xffff0000u)); }
                const v4u h4 = (v4u){hw[0], hw[1], hw[2], hw[3]}, l4 = (v4u){lw[0], lw[1], lw[2], lw[3]};
                *(GAS v4u*)(XN + (size_t)r * DM + 512 * j + 8 * F.lane) = h4;
                *(LAS v4u*)(HHI + rl * HP + 512 * j + 8 * F.lane) = h4; *(LAS v4u*)(HLO + rl * HP + 512 * j + 8 * F.lane) = l4; } }
        __syncthreads();
        f32x4 acc[3];
#pragma unroll
        for (int n = 0; n < 3; ++n) acc[n] = (f32x4){0.f, 0.f, 0.f, 0.f};
#pragma unroll 2
        for (int s = 0; s < 8; ++s) { const int ks = 8 * F.wave + s;
            const bf16x8 xh = *(const LAS bf16x8*)(HHI + fr * HP + ks * 32 + fq * 8), xl = *(const LAS bf16x8*)(HLO + fr * HP + ks * 32 + fq * 8);
#pragma unroll
            for (int n = 0; n < 3; ++n) { const v4u wh4 = ((const GAS v4u*)WRT)[((size_t)(0 * 64 + ks) * 3 + n) * 64 + F.lane], wl4 = ((const GAS v4u*)WRT)[((size_t)(1 * 64 + ks) * 3 + n) * 64 + F.lane];
                const bf16x8 wh = __builtin_bit_cast(bf16x8, wh4), wl = __builtin_bit_cast(bf16x8, wl4);
                acc[n] = __builtin_amdgcn_mfma_f32_16x16x32_bf16(wh, xh, acc[n], 0, 0, 0);
                acc[n] = __builtin_amdgcn_mfma_f32_16x16x32_bf16(wh, xl, acc[n], 0, 0, 0);
                acc[n] = __builtin_amdgcn_mfma_f32_16x16x32_bf16(wl, xh, acc[n], 0, 0, 0); } }
        __syncthreads();
#pragma unroll
        for (int n = 0; n < 3; ++n)
#pragma unroll
            for (int i = 0; i < 4; ++i) PART[(F.wave * 16 + fr) * 48 + 16 * n + 4 * fq + i] = acc[n][i];
        __syncthreads();
        for (int t = F.tid; t < 16 * 36; t += NWAVES * 64) { const int m = t / 36, n = t % 36; float s = n < 4 ? F.in[23][l * 4 + n] : F.in[25][l * 32 + (n - 4)];
#pragma unroll
            for (int w = 0; w < 8; ++w) s += PART[(w * 16 + m) * 48 + n];
            LOGI[m * 36 + n] = s; }
        __syncthreads();
        if (F.tid < 16) { const int r = blk * 16 + F.tid; const LAS float* lg = LOGI + F.tid * 36;
            int gi = 0; float gm = lg[0];
#pragma unroll
            for (int j = 1; j < 4; ++j) if (lg[j] > gm) { gm = lg[j]; gi = j; }
            float gs = 0.f;
#pragma unroll
            for (int j = 0; j < 4; ++j) gs += __expf(lg[j] - gm);
            const float wg = 1.f / gs;
            const LAS float* le = lg + 4 + gi * 8; int i1 = 0; float m1 = le[0];
#pragma unroll
            for (int j = 1; j < 8; ++j) if (le[j] > m1) { m1 = le[j]; i1 = j; }
            int i2 = -1; float m2 = -3.0e38f;
#pragma unroll
            for (int j = 0; j < 8; ++j) if (j != i1 && le[j] > m2) { m2 = le[j]; i2 = j; }
            const float e2 = __expf(m2 - m1), w1 = wg / (1.f + e2), w2 = wg * e2 / (1.f + e2);
            const int ea = gi * 8 + i1, eb = gi * 8 + i2;
            const int sa = (int)__hip_atomic_fetch_add(F.ctl + CW_CNT + (l * NE + ea) * 64, 1u, RLX_AGENT), sb = (int)__hip_atomic_fetch_add(F.ctl + CW_CNT + (l * NE + eb) * 64, 1u, RLX_AGENT);
            ((GAS int*)LIST)[ea * LCAP + sa] = r * 2; ((GAS int*)LIST)[eb * LCAP + sb] = r * 2 + 1; ((GAS float*)WTOK)[r * 2] = w1; ((GAS float*)WTOK)[r * 2 + 1] = w2; }
        __syncthreads();
    }
}
__device__ __forceinline__ void moe_setup(Frame& F, int l, LAS int* tstart, LAS int* cnt) {
    if (F.tid < NE) cnt[F.tid] = (int)__hip_atomic_load(F.ctl + CW_CNT + (l * NE + F.tid) * 64, RLX_AGENT);
    __syncthreads();
    if (F.tid == 0) { int s = 0; for (int e = 0; e < NE; ++e) { tstart[e] = s; s += (cnt[e] + 255) >> 8; } tstart[NE] = s; }
    __syncthreads();
}
template <bool FUSE_NEXT> __device__ __forceinline__ void ph_ln_final(Frame& F, int l, void* outcv, void* outlv) {
    const int gw = F.vcu * NWAVES + F.wave, NGW = F.G * NWAVES;
    const float* MOD = (const float*)(F.ws + WS_MOD) + (size_t)l * 2 * NMODV; const bf16* X1 = (const bf16*)(F.ws + WS_T); const bf16* YK = (const bf16*)(F.ws + WS_YK);
    const float* gf = F.in[29] + (size_t)l * DM; const float* bfp = F.in[30] + (size_t)l * DM;
    for (int r = gw; r < ROWS; r += NGW) { if (r < CTXL && outcv == nullptr) continue;
        const float* mp = MOD + (r < CTXL ? NMODV : 0) + 5 * DM;
        RowV v; row_load_bf16(v, X1 + (size_t)r * DM, F.lane);
#pragma unroll
        for (int j = 0; j < 4; ++j) { const v4u a = *(const GAS v4u*)(YK + (size_t)(2 * r) * DM + 512 * j + 8 * F.lane), b = *(const GAS v4u*)(YK + (size_t)(2 * r + 1) * DM + 512 * j + 8 * F.lane);
            const f32x4 g0 = *(const GAS f32x4*)(mp + 512 * j + 8 * F.lane), g1 = *(const GAS f32x4*)(mp + 512 * j + 8 * F.lane + 4);
            const f32x4 y0 = (f32x4){__uint_as_float(a.x << 16) + __uint_as_float(b.x << 16), __uint_as_float(a.x & 0xffff0000u) + __uint_as_float(b.x & 0xffff0000u),
                                     __uint_as_float(a.y << 16) + __uint_as_float(b.y << 16), __uint_as_float(a.y & 0xffff0000u) + __uint_as_float(b.y & 0xffff0000u)};
            const f32x4 y1 = (f32x4){__uint_as_float(a.z << 16) + __uint_as_float(b.z << 16), __uint_as_float(a.z & 0xffff0000u) + __uint_as_float(b.z & 0xffff0000u),
                                     __uint_as_float(a.w << 16) + __uint_as_float(b.w << 16), __uint_as_float(a.w & 0xffff0000u) + __uint_as_float(b.w & 0xffff0000u)};
            v.v[2 * j] = v.v[2 * j] * ALPHA + g0 * y0; v.v[2 * j + 1] = v.v[2 * j + 1] * ALPHA + g1 * y1; }
        row_norm(v); row_affine(v, gf, 0.f, bfp, F.lane);
#ifdef TPROBE
        if (!FUSE_NEXT) { const float tsc_ = 1.f + *(const volatile float*)&g_tprobe;
#pragma unroll
            for (int q = 0; q < 8; ++q) v.v[q] = v.v[q] * tsc_; }
#endif
        if (FUSE_NEXT) row_store_bf16(v, r < CTXL ? (bf16*)outcv + (size_t)r * DM : (bf16*)outlv + (size_t)(r - CTXL) * DM, F.lane);
        else row_store(v, r < CTXL ? (float*)outcv + (size_t)r * DM : (float*)outlv + (size_t)(r - CTXL) * DM, F.lane);
        if (FUSE_NEXT) { const float* mn = (const float*)(F.ws + WS_MOD) + (size_t)(l + 1) * 2 * NMODV + (r < CTXL ? NMODV : 0);
            row_norm(v); row_affine(v, mn + DM, 1.f, mn, F.lane); row_store_bf16(v, (bf16*)(F.ws + WS_XN) + (size_t)r * DM, F.lane); } }
}

#ifndef MK_ONE_LAUNCH
#define MK_ONE_LAUNCH 0
#endif
struct Args { const float* in[NIN]; float* out; unsigned char* ws; int ph_lo, ph_hi, pad0, pad1; };
__global__ void __launch_bounds__(NWAVES * 64, 2) mk_fwd(Args args) {
    extern __shared__ __attribute__((aligned(16))) unsigned char lds[];
    Frame F;
    F.lds = (LAS unsigned char*)lds;
    F.MISC = (volatile LAS unsigned*)(F.lds + MISC_OFF);
    F.tid = threadIdx.x; F.lane = F.tid & 63; F.wave = __builtin_amdgcn_readfirstlane(F.tid >> 6);
    F.G = gridDim.x; { const int bx = blockIdx.x; F.vcu = (F.G % 8 == 0) ? (bx % 8) * (F.G / 8) + bx / 8 : bx; }
    F.ws = args.ws; F.out = args.out; F.ctl = (gu32*)(args.ws + WS_CTL);
    F.in = args.in;
    for (int u = F.tid; u < (LDS_BYTES - LDSCTL_OFF) / 4; u += NWAVES * 64) ((LAS unsigned*)(F.lds + LDSCTL_OFF))[u] = 0u;
    __syncthreads();
#if MK_ONE_LAUNCH
    XcdBarrier bar = xcd_barrier_post((unsigned*)(F.ctl + CW_BAR), F.MISC + 8);
#define GRID_BAR() xcd_barrier(bar)
#else
#define GRID_BAR() do { } while (0)
#endif
    const int lo = args.ph_lo, hi = args.ph_hi;
#ifdef ONLY_REL
#define IN(k) (lo <= (k) && (k) < hi && ((k) < 2 ? (k) == ONLY_REL - 100 : ((k) - 2) % 9 == ONLY_REL))
#else
#define IN(k) (lo <= (k) && (k) < hi)
#endif
#ifndef REPEAT_REL
#define REPEAT_REL -1
#endif
#ifndef REPEAT_N
#define REPEAT_N 2
#endif
#ifndef REPEAT_MASK
#define REPEAT_MASK 0
#endif
#define REP(r) for (int rep_ = 0; rep_ < (((r) == REPEAT_REL || ((r) < 32 && ((REPEAT_MASK >> (r)) & 1))) ? REPEAT_N : 1); ++rep_)
#ifdef PROBE_PHASE
#ifndef PROBE_MULT
#define PROBE_MULT 3
#endif
    unsigned long long tprev_ = __builtin_amdgcn_s_memrealtime();
#define SEAM(k) do { if (IN(k) && IN((k) + 1)) { GRID_BAR(); const unsigned long long tn_ = __builtin_amdgcn_s_memrealtime(); \
        if ((k) == PROBE_PHASE) { const unsigned long long until_ = tn_ + PROBE_MULT * (tn_ - tprev_); while (__builtin_amdgcn_s_memrealtime() < until_) __builtin_amdgcn_s_sleep(8); } \
        tprev_ = __builtin_amdgcn_s_memrealtime(); } } while (0)
#else
#define SEAM(k) do { if (IN(k) && IN((k) + 1)) GRID_BAR(); } while (0)
#endif
#define PHASE_BEGIN() do { unsigned char* w_ = args.ws; float* o_ = args.out; asm volatile("" : "+s"(w_), "+s"(o_)); F.ws = w_; F.out = o_; F.ctl = (gu32*)(w_ + WS_CTL); \
        int t_ = threadIdx.x; asm volatile("" : "+v"(t_)); F.tid = t_; F.lane = t_ & 63; F.wave = __builtin_amdgcn_readfirstlane(t_ >> 6); } while (0)
    LAS int* tstart = (LAS int*)(F.lds + LDSCTL_OFF); LAS int* ecnt = (LAS int*)(F.lds + LDSCTL_OFF + 136);
    char* ldsg = (char*)lds + RING_OFF;

    if (IN(0)) REP(100) { PHASE_BEGIN(); ph_prologue_a(F); } SEAM(0);
    if (IN(1)) REP(101) { PHASE_BEGIN(); ph_prologue_b(F); } SEAM(1);
#pragma unroll 1
    for (int l = 0; l < DEPTH; ++l) {
        const int P = 2 + 9 * l;
        const float* xc = F.in[2]; const float* xl = F.in[0];
        const float* MODL = (const float*)(F.ws + WS_MOD) + (size_t)l * 2 * NMODV;
        if (l == 0) { if (IN(P + 0)) REP(0) { PHASE_BEGIN(); ph_ln1(F, l, xc, xl); } SEAM(P + 0); }
        if (IN(P + 1)) REP(1) { PHASE_BEGIN();
            pg8::Gemm g{(const bf16*)(F.ws + WS_XN), (const bf16*)(F.ws + WS_WIN) + (size_t)l * DIN * DM, DM, DM};
            SchedWin S; S.go.init(NMT, DIN / 256, F.G, (int)blockIdx.x);
            EpiWin E{(bf16*)(F.ws + WS_UF), (bf16*)(F.ws + WS_UFC), (bf16*)(F.ws + WS_AG), (bf16*)(F.ws + WS_Q), (bf16*)(F.ws + WS_K), (bf16*)(F.ws + WS_V),
                     (const float*)(F.ws + WS_BINP) + l * DIN, (const f32x2v*)(F.ws + WS_ROPE)};
            pg8::gemm_phase<EpiWin, SchedWin>(F.lds + RING_OFF, g, S, E);
        } SEAM(P + 1);
        if (IN(P + 2)) REP(2) { PHASE_BEGIN();
            attn::Tensors AT{(const bf16*)(F.ws + WS_Q), (const bf16*)(F.ws + WS_K), (const bf16*)(F.ws + WS_V), (bf16*)(F.ws + WS_MIX),
                             (float*)(F.ws + WS_O2N) + (size_t)blockIdx.x * 64 * 512, F.in[18] + l * 128, ((const float*)(F.ws + WS_LAMV))[l], 1.f - (0.8f - 0.6f * expf(-0.3f * (float)l))};
#ifndef NO_ATT
#ifndef REPEAT_ATT_N
#define REPEAT_ATT_N 1
#endif
            for (int u = F.vcu; u < 512 * REPEAT_ATT_N; u += F.G) attn::attn_unit<true>((u & 511) >> 6, 256 * (1 + (u & 63)), ROWS / 64, AT, ldsg);
            for (int u = F.vcu; u < 8; u += F.G) attn::attn_unit<false>(u, 0, CTXL / 64, AT, ldsg);
#endif
#ifndef NO_FA
            { pg8::Gemm g{(const bf16*)(F.ws + WS_UF), (const bf16*)(F.ws + WS_BTA), 128, 128};
#ifndef REPEAT_FA_N
#define REPEAT_FA_N 1
#endif
              SchedFA S; S.go.init(256 * REPEAT_FA_N, 1, F.G, (int)blockIdx.x); EpiFA E{(bf16*)(F.ws + WS_PF2)};
#ifndef REPEAT_FA_N
#define REPEAT_FA_N 1
#endif
              pg8::gemm_phase<EpiFA, SchedFA>(F.lds + RING_OFF, g, S, E); }
#endif
#ifndef NO_CTXF
            { pg8::Gemm g{(const bf16*)(F.ws + WS_F256), (const bf16*)(F.ws + WS_UFC), 256, 256};
              SchedNat S; S.go.init(2, 2, F.G, (int)((blockIdx.x + 128) % F.G)); S.pmoff = 0; EpiCtxF E{(bf16*)(F.ws + WS_MIX)};
              pg8::gemm_phase<EpiCtxF, SchedNat>(F.lds + RING_OFF, g, S, E); }
#endif
#ifndef NO_CONV
            { volatile LAS int* qslot = (volatile LAS int*)(F.lds + LDSCTL_OFF + 3072);
              for (;;) { __syncthreads(); if (F.tid == 0) *qslot = (int)__hip_atomic_fetch_add(F.ctl + CW_CONVQ + l * 64, 1u, RLX_AGENT);
                  __syncthreads(); const int u = *qslot; if (u >= ROWS / 32) break; conv_unit(F, l, u); } }
#endif
        } SEAM(P + 2);
        if (IN(P + 3)) REP(3) { PHASE_BEGIN();
            pg8::Gemm g{(const bf16*)(F.ws + WS_PF2), (const bf16*)(F.ws + WS_BTB), 256, 256};
            SchedFB S; S.go.init(256, 1, F.G, (int)blockIdx.x); EpiFB E{(bf16*)(F.ws + WS_MIX)};
            pg8::gemm_phase<EpiFB, SchedFB>(F.lds + RING_OFF, g, S, E);
            if (l + 1 < DEPTH) {
                pg8::Gemm g2{(const bf16*)(F.ws + WS_MIX), (const bf16*)(F.ws + WS_WCAT) + (size_t)l * DM * MIXP, MIXP, MIXP};
                SchedNat S2; S2.go.init(1, DM / 256, F.G, (int)((blockIdx.x + 96) % F.G)); S2.pmoff = 0; EpiWout E2{MODL, (bf16*)(F.ws + WS_DMIX)};
                pg8::gemm_phase<EpiWout, SchedNat>(F.lds + RING_OFF, g2, S2, E2); }
        } SEAM(P + 3);
        if (IN(P + 4)) REP(4) { PHASE_BEGIN();
            pg8::Gemm g{(const bf16*)(F.ws + WS_MIX), (const bf16*)(F.ws + WS_WCAT) + (size_t)l * DM * MIXP, MIXP, MIXP};
            SchedNat S; S.go.init(NMT - 1, DM / 256, F.G, (int)blockIdx.x); S.pmoff = 1; EpiWout E{MODL, (bf16*)(F.ws + WS_DMIX)};
            pg8::gemm_phase<EpiWout, SchedNat>(F.lds + RING_OFF, g, S, E);
        } SEAM(P + 4);
        if (IN(P + 5)) REP(5) { PHASE_BEGIN(); if (l == 0) ph_ln_router<false>(F, l, xc, xl); else ph_ln_router<true>(F, l, F.ws + WS_X2, (bf16*)(F.ws + WS_X2) + (size_t)CTXL * DM); } SEAM(P + 5);
        if (IN(P + 6)) REP(6) { PHASE_BEGIN();
            moe_setup(F, l, tstart, ecnt);
            pg8::Gemm g{(const bf16*)(F.ws + WS_XN), (const bf16*)(F.ws + WS_WGU), DM, DM};
            SchedMoe<1> S{tstart, ecnt, (const int*)(F.ws + WS_LIST) + (size_t)l * NE * LCAP, F.G, (int)F.vcu}; EpiMoe1 E{(bf16*)(F.ws + WS_ACT)};
            pg8::gemm_phase<EpiMoe1, SchedMoe<1>>(F.lds + RING_OFF, g, S, E);
        } SEAM(P + 6);
        if (IN(P + 7)) REP(7) { PHASE_BEGIN();
            moe_setup(F, l, tstart, ecnt);
            pg8::Gemm g{(const bf16*)(F.ws + WS_ACT), (const bf16*)(F.ws + WS_WD), DE, DE};
            SchedMoe<2> S{tstart, ecnt, (const int*)(F.ws + WS_LIST) + (size_t)l * NE * LCAP, F.G, (int)F.vcu};
            EpiMoe2 E{ecnt, (const int*)(F.ws + WS_LIST) + (size_t)l * NE * LCAP, (const float*)(F.ws + WS_WTOK) + (size_t)l * 2 * ROWS, (bf16*)(F.ws + WS_YK)};
            pg8::gemm_phase<EpiMoe2, SchedMoe<2>>(F.lds + RING_OFF, g, S, E);
        } SEAM(P + 7);
        if (IN(P + 8)) REP(8) { PHASE_BEGIN();
            if (l == 0) { ph_ln_final<true>(F, l, F.ws + WS_X2, (bf16*)(F.ws + WS_X2) + (size_t)CTXL * DM);
                          convert_experts(F, 1, (LAS float*)(F.lds + RING_OFF + F.wave * 16896)); }
            else ph_ln_final<false>(F, l, nullptr, F.out);
        }
        if (l + 1 < DEPTH) SEAM(P + 8);
    }
#undef IN
#undef SEAM
}

extern "C" void kernel_launch(void* const* d_in, const int* in_sizes, int n_in, void* d_out, int out_size, void* d_ws, size_t ws_size, hipStream_t stream) {
    static int grid = 0;
    if (grid == 0) {
        if (n_in != NIN || in_sizes[0] != SEQ * DM || out_size != SEQ * DM || ws_size < WS_END) { fprintf(stderr, "kernel_launch: shape mismatch (n_in %d, in0 %d, out %d, ws %zu < %zu?)\n", n_in, n_in > 0 ? in_sizes[0] : -1, out_size, ws_size, (size_t)WS_END); grid = -1; return; }
        int dev = 0, cus = 0, per_cu = 0;
        if (hipGetDevice(&dev) != hipSuccess || hipDeviceGetAttribute(&cus, hipDeviceAttributeMultiprocessorCount, dev) != hipSuccess) { grid = -1; return; }
        if (hipFuncSetAttribute((const void*)mk_fwd, hipFuncAttributeMaxDynamicSharedMemorySize, LDS_BYTES) != hipSuccess) { fprintf(stderr, "kernel_launch: hipFuncSetAttribute failed\n"); grid = -1; return; }
        if (hipOccupancyMaxActiveBlocksPerMultiprocessor(&per_cu, (const void*)mk_fwd, NWAVES * 64, LDS_BYTES) != hipSuccess || per_cu < 1)
            fprintf(stderr, "kernel_launch: note: occupancy query reports %d workgroups per CU\n", per_cu);
        (void)hipGetLastError();
        grid = cus;
        if (grid > 256) grid = 256;
    }
    if (grid < 0) return;
    if (hipMemsetAsync((char*)d_ws + WS_CTL, 0, CTL_ZERO_BYTES, stream) != hipSuccess) { fprintf(stderr, "kernel_launch: memset failed\n"); return; }
    Args a{};
    for (int i = 0; i < NIN; ++i) a.in[i] = (const float*)d_in[i];
    a.out = (float*)d_out; a.ws = (unsigned char*)d_ws;
#if MK_ONE_LAUNCH
    a.ph_lo = 0; a.ph_hi = NPH;
    hipLaunchKernelGGL(mk_fwd, dim3(grid), dim3(NWAVES * 64), LDS_BYTES, stream, a);
#else
    for (int p = 0; p < NPH; ++p) { a.ph_lo = p; a.ph_hi = p + 1; hipLaunchKernelGGL(mk_fwd, dim3(grid), dim3(NWAVES * 64), LDS_BYTES, stream, a); }
#endif
    const hipError_t le = hipPeekAtLastError();
    if (le != hipSuccess) fprintf(stderr, "kernel_launch: launch failed: %s\n", hipGetErrorName(le));
}
```

```cpp
#include <hip/hip_runtime.h>
#include <cstdio>
#include <cstdint>
#include <cmath>
#ifndef MK_ONE_LAUNCH
#define MK_ONE_LAUNCH 1
#endif
namespace pg8 {
#define PG8_LAS __attribute__((address_space(3)))
typedef unsigned short bf16_t;
typedef short bf16x8 __attribute__((ext_vector_type(8)));
typedef float f32x4 __attribute__((ext_vector_type(4)));
typedef float f32x2 __attribute__((ext_vector_type(2)));
typedef unsigned u32x4 __attribute__((ext_vector_type(4)));
typedef unsigned u32x2 __attribute__((ext_vector_type(2)));
constexpr int BM = 256, BK = 64, HALF = 128, HTB = HALF * BK * 2  , STAGE_BYTES = 8 * HTB, NXCD = 8, WGM = 8;

__host__ __device__ __forceinline__ int lds_byte(int r, int c) { const int st = (r >> 4) * 2 + (c >> 5), rr = r & 15, cc = c & 31, ob = rr * 64 + cc * 2; return st * 1024 + (ob ^ (((ob >> 9) & 1) << 5)); }
__host__ __device__ __forceinline__ void stage_rc(int b, int& R, int& C) { const int st = b / 1024, sb = b % 1024, swz = sb ^ (((sb >> 9) & 1) << 5); R = (st >> 1) * 16 + swz / 64; C = (st & 1) * 32 + (swz % 64) / 2; }
__host__ __device__ __forceinline__ int perm32(int rho) { const int n = rho >> 4, i = rho & 15; return 8 * (i >> 2) + 4 * n + (i & 3); }

struct Unit { int pm, pn, e, rt, hb; };
struct Gemm { const bf16_t* A; const bf16_t* Bt; int K, lda; };

struct GridOrder {
    int nM, nN, nwg, G, c;
    __device__ void init(int nM_, int nN_, int G_, int c_) { nM = nM_; nN = nN_; nwg = nM * nN; G = G_; c = c_; }
    __device__ bool next(int i, Unit& u) const {
        const long L = (long)i * G + c; if (L >= nwg) return false;
        int wgid = (int)L; { const int q = nwg / NXCD, r = nwg % NXCD, xcd = wgid % NXCD, off = wgid / NXCD; wgid = (xcd < r ? xcd * (q + 1) : r * (q + 1) + (xcd - r) * q) + off; }
        const int nig = WGM * nN, gid = wgid / nig, fm = gid * WGM, gsz = (nM - fm) < WGM ? (nM - fm) : WGM;
        u.pm = fm + ((wgid % nig) % gsz); u.pn = (wgid % nig) / gsz; u.e = 0; u.rt = 0; u.hb = -1; return true;
    }
};

__device__ __forceinline__ unsigned cvt_pk_bf16(float lo, float hi) { unsigned r; asm volatile("v_cvt_pk_bf16_f32 %0, %1, %2" : "=v"(r) : "v"(lo), "v"(hi)); return r; }

template <class Epi, class Sched>
__device__ __forceinline__ void gemm_phase(PG8_LAS unsigned char* lds, const Gemm g, const Sched& S, const Epi& E) {
    int tid_ = threadIdx.x; asm volatile("" : "+v"(tid_));
    const int tid = tid_, wid = __builtin_amdgcn_readfirstlane(tid >> 6), lane = tid & 63, wr = wid >> 2, wc = wid & 3, fr = lane & 15, fq = lane >> 4;
    int K_ = g.K; asm volatile("" : "+s"(K_));
    const int K = K_, nt = K / BK;
    unsigned voffB[2];
#pragma unroll
    for (int i = 0; i < 2; ++i) { int R, C; stage_rc(tid * 16 + i * 8192, R, C); const int Rb = Epi::PERM ? ((R & ~31) + perm32(R & 31)) : R;
        voffB[i] = (unsigned)(Rb * K + C) * 2u; }
    const size_t kstep = (size_t)(BK * 2);
    const size_t hstepB = (size_t)HALF * K * 2;
    const unsigned pitchA = (unsigned)g.lda * 2u;
    const unsigned ldsw = (unsigned)wid * 1024u;
    const int aoff = lds_byte(wr * 64 + fr, fq * 8), boff = lds_byte(wc * 32 + fr, fq * 8);
    const char* gA = (const char*)g.A;
#define PG8_SA(b, h) (((b) * 2 + (h)) * HTB)
#define PG8_SB(b, h) ((4 + (b) * 2 + (h)) * HTB)
#define PG8_STAGEB(bufoff, gbase) do { _Pragma("unroll") for (int _i = 0; _i < 2; ++_i) \
        __builtin_amdgcn_global_load_lds((const unsigned*)((const char*)(gbase) + voffB[_i]), (PG8_LAS unsigned*)(lds + (bufoff) + ldsw + _i * 8192), 16, 0, 0); } while (0)
#define PG8_STAGEA(bufoff, koff, vo) do { _Pragma("unroll") for (int _i = 0; _i < 2; ++_i) \
        __builtin_amdgcn_global_load_lds((const unsigned*)(gA + (koff) + (vo)[_i]), (PG8_LAS unsigned*)(lds + (bufoff) + ldsw + _i * 8192), 16, 0, 0); } while (0)
#define PG8_MKA(dst, u) do { _Pragma("unroll") for (int _i = 0; _i < 2; ++_i) { int R_, C_; stage_rc(tid * 16 + _i * 8192, R_, C_); _Pragma("unroll") for (int _h = 0; _h < 2; ++_h) \
        dst[_h][_i] = (unsigned)S.arow(u, _h * HALF + R_) * pitchA + (unsigned)C_ * 2u; } } while (0)
#define PG8_LDA(dst, b, h) do { _Pragma("unroll") for (int m = 0; m < 4; ++m) _Pragma("unroll") for (int k = 0; k < 2; ++k) dst[m][k] = *(const PG8_LAS bf16x8*)(lds + PG8_SA(b, h) + aoff + m * 2048 + k * 1024); } while (0)
#define PG8_LDB(dst, b, h) do { _Pragma("unroll") for (int n = 0; n < 2; ++n) _Pragma("unroll") for (int k = 0; k < 2; ++k) dst[n][k] = *(const PG8_LAS bf16x8*)(lds + PG8_SB(b, h) + boff + n * 2048 + k * 1024); } while (0)
#define PG8_MMA(ai, bj, At, Bt) do { __builtin_amdgcn_s_setprio(1); _Pragma("unroll") for (int m = 0; m < 4; ++m) _Pragma("unroll") for (int n = 0; n < 2; ++n) _Pragma("unroll") for (int k = 0; k < 2; ++k) \
        acc[ai][bj][m][n] = __builtin_amdgcn_mfma_f32_16x16x32_bf16(Bt[n][k], At[m][k], acc[ai][bj][m][n], 0, 0, 0); __builtin_amdgcn_s_setprio(0); } while (0)
#define PG8_WAIT_V(n) asm volatile("s_waitcnt vmcnt(" #n ")" ::: "memory")
#define PG8_WAIT_L(n) asm volatile("s_waitcnt lgkmcnt(" #n ")" ::: "memory")
#define PG8_BAR __builtin_amdgcn_s_barrier()
#define PG8_SCHED __builtin_amdgcn_sched_barrier(0)
    Unit cur, nxt; int ui = 0;
    if (!S.next(0, cur)) return;
    f32x4 acc[2][2][4][2];
#pragma unroll
    for (int a = 0; a < 2; ++a)
#pragma unroll
        for (int b = 0; b < 2; ++b)
#pragma unroll
            for (int m = 0; m < 4; ++m)
#pragma unroll
                for (int n = 0; n < 2; ++n) acc[a][b][m][n] = (f32x4){0.f, 0.f, 0.f, 0.f};
    bf16x8 At[4][2], B0[2][2], B1[2][2];
    unsigned cvA[2][2], nvA[2][2];
    PG8_MKA(cvA, cur);
    const char* cB = (const char*)g.Bt + (size_t)S.brow(cur) * K * 2;
    PG8_STAGEB(PG8_SB(0, 0), cB); PG8_STAGEB(PG8_SB(0, 1), cB + hstepB); PG8_STAGEA(PG8_SA(0, 0), 0, cvA[0]); PG8_STAGEA(PG8_SA(0, 1), 0, cvA[1]);
    if (wr == 1) PG8_BAR;
    PG8_WAIT_V(2); PG8_BAR;
    PG8_STAGEB(PG8_SB(1, 0), cB + kstep); PG8_STAGEA(PG8_SA(1, 0), kstep, cvA[0]); PG8_STAGEB(PG8_SB(1, 1), cB + hstepB + kstep);
    PG8_WAIT_V(6); PG8_BAR;
    for (;;) {
        const bool has_next = S.next(ui + 1, nxt); const int hb = cur.hb;
        const char* nB = cB;
        if (has_next) { PG8_MKA(nvA, nxt); nB = (const char*)g.Bt + (size_t)S.brow(nxt) * K * 2; }
        else {
#pragma unroll
            for (int h = 0; h < 2; ++h)
#pragma unroll
                for (int i = 0; i < 2; ++i) nvA[h][i] = cvA[h][i]; }
        for (int t = 0; t < nt; t += 2) {
            const bool last = (t == nt - 2);
            const size_t ka1 = (size_t)(t + 1) * kstep;
            const size_t ka2 = last ? (size_t)0 : (size_t)(t + 2) * kstep; const char* b2 = last ? nB : cB + (size_t)(t + 2) * kstep;
            const size_t ka3 = ka2 + kstep; const char* b3 = b2 + kstep;
            unsigned a2v[2][2];
#pragma unroll
            for (int h = 0; h < 2; ++h)
#pragma unroll
                for (int i = 0; i < 2; ++i) a2v[h][i] = last ? nvA[h][i] : cvA[h][i];
            PG8_LDB(B0, 0, 0); PG8_LDB(B1, 0, 1); PG8_SCHED; PG8_LDA(At, 0, 0); PG8_STAGEA(PG8_SA(1, 1), ka1, cvA[1]);
            PG8_WAIT_V(8); PG8_WAIT_L(0); PG8_BAR; if (hb != 1) PG8_MMA(0, 0, At, B0); if (hb != 0) PG8_MMA(0, 1, At, B1); PG8_BAR; PG8_SCHED;
            PG8_LDA(At, 0, 1); PG8_STAGEB(PG8_SB(0, 0), b2); PG8_STAGEB(PG8_SB(0, 1), b2 + hstepB); PG8_STAGEA(PG8_SA(0, 0), ka2, a2v[0]);
            PG8_WAIT_V(8); PG8_WAIT_L(0); PG8_BAR; if (hb != 1) PG8_MMA(1, 0, At, B0); if (hb != 0) PG8_MMA(1, 1, At, B1); PG8_BAR; PG8_SCHED;
            PG8_LDB(B0, 1, 0); PG8_LDB(B1, 1, 1); PG8_SCHED; PG8_LDA(At, 1, 0); PG8_STAGEA(PG8_SA(0, 1), ka2, a2v[1]);
            PG8_WAIT_V(8); PG8_WAIT_L(0); PG8_BAR; if (hb != 1) PG8_MMA(0, 0, At, B0); if (hb != 0) PG8_MMA(0, 1, At, B1); PG8_BAR; PG8_SCHED;
            PG8_LDA(At, 1, 1); PG8_STAGEB(PG8_SB(1, 0), b3); PG8_STAGEB(PG8_SB(1, 1), b3 + hstepB); PG8_STAGEA(PG8_SA(1, 0), ka3, a2v[0]);
            PG8_WAIT_V(8); PG8_WAIT_L(0); PG8_BAR; if (hb != 1) PG8_MMA(1, 0, At, B0); if (hb != 0) PG8_MMA(1, 1, At, B1); PG8_BAR; PG8_SCHED;
        }
        if (wr == 0) PG8_BAR;
        { int fr_ = fr, fq_ = fq, wr_ = wr, wc_ = wc; asm volatile("" : "+v"(fr_), "+v"(fq_), "+s"(wr_), "+s"(wc_));
          E(acc, cur, wr_, wc_, fr_, fq_); }
        if (!has_next) break;
#pragma unroll
        for (int a = 0; a < 2; ++a)
#pragma unroll
            for (int b = 0; b < 2; ++b)
#pragma unroll
                for (int m = 0; m < 4; ++m)
#pragma unroll
                    for (int n = 0; n < 2; ++n) acc[a][b][m][n] = (f32x4){0.f, 0.f, 0.f, 0.f};
        cur = nxt; cB = nB; ++ui;
#pragma unroll
        for (int h = 0; h < 2; ++h)
#pragma unroll
            for (int i = 0; i < 2; ++i) cvA[h][i] = nvA[h][i];
        if (wr == 1) PG8_BAR;
    }
    PG8_WAIT_V(0);
    PG8_BAR;
#undef PG8_SA
#undef PG8_SB
#undef PG8_STAGEA
#undef PG8_STAGEB
#undef PG8_MKA
#undef PG8_LDA
#undef PG8_LDB
#undef PG8_MMA
#undef PG8_WAIT_V
#undef PG8_WAIT_L
#undef PG8_BAR
#undef PG8_SCHED
}
}
#ifndef ATT_D
#define ATT_D 4
#endif
#ifndef ATT_STAGGER
#define ATT_NOSTAGGER 1
#endif
#if ATT_D == 2
#define A_INFLIGHT 3
#elif ATT_D == 3
#define A_INFLIGHT 6
#elif ATT_D == 4
#ifdef ATT_LDR4
#define A_INFLIGHT 18
#else
#define A_INFLIGHT 9
#endif
#else
#error ATT_D
#endif
#define A_GAS __attribute__((address_space(1)))
#ifdef TPROBE
__device__ float g_tprobe;
#ifndef TP_WAVE
#define TP_WAVE 0
#endif
#ifndef TP_Q
#define TP_Q 50.f
#endif
#ifndef TP_OFF
#define TP_OFF 0.f
#endif
#ifndef TP_SCALE
#define TP_SCALE 1e-4f
#endif
#endif
namespace attn {
using bf16x8 = __attribute__((ext_vector_type(8))) short;
using s16x4  = __attribute__((ext_vector_type(4))) short;
using f32x16 = __attribute__((ext_vector_type(16))) float;
using u32x4  = __attribute__((ext_vector_type(4))) unsigned;
using f32x4v = __attribute__((ext_vector_type(4))) float;
typedef unsigned short bf16_t;
constexpr int NW = 8, QBLK = 32, KVBLK = 64, PITCH = 1024;
#ifndef ATT_D
#define ATT_D 4
#endif
constexpr int ADEPTH = ATT_D;
constexpr int NSLOT = ADEPTH + 1, KSLOT = 8192, VSLOT = 16384;
constexpr int LDS_K = 0, LDS_V = NSLOT * KSLOT, LDS_WS = LDS_V + NSLOT * VSLOT, SHM_ATTN = LDS_WS + NW * 64 * 4;
__device__ __forceinline__ int crow(int r, int hi) { return (r & 3) + 8 * (r >> 2) + 4 * hi; }
__device__ __forceinline__ unsigned cvtpk(float lo, float hi) { unsigned r; asm volatile("v_cvt_pk_bf16_f32 %0, %1, %2" : "=v"(r) : "v"(lo), "v"(hi)); return r; }
typedef float f32x2_t __attribute__((ext_vector_type(2))); typedef __bf16 bf16x2_t __attribute__((ext_vector_type(2)));
__device__ __forceinline__ unsigned cvtpk_b(float lo, float hi) { f32x2_t v = {lo, hi}; bf16x2_t b = __builtin_convertvector(v, bf16x2_t); return __builtin_bit_cast(unsigned, b); }
__device__ __forceinline__ void glds16(const void* gsrc, unsigned lds_dst) { unsigned keep;
  asm volatile("s_mov_b32 %0, m0\n\ts_mov_b32 m0, %2\n\ts_nop 0\n\tglobal_load_lds_dwordx4 %1, off\n\ts_mov_b32 m0, %0" : "=&s"(keep) : "v"(gsrc), "s"(lds_dst) : "memory"); }
typedef __attribute__((address_space(3))) const char* lds_cptr;
typedef short v4i16_t __attribute__((ext_vector_type(4)));
__device__ __forceinline__ s16x4 vtr(lds_cptr p) { return __builtin_bit_cast(s16x4, __builtin_amdgcn_ds_read_tr16_b64_v4i16((__attribute__((address_space(3))) v4i16_t*)p)); }
#define A_WAITBAR_(V) asm volatile("s_waitcnt vmcnt(" #V ") lgkmcnt(0)\n\ts_barrier" ::: "memory")
#define A_WAITBAR(V) A_WAITBAR_(V)
#define A_LGKBAR() asm volatile("s_waitcnt lgkmcnt(0)\n\ts_barrier" ::: "memory")
#define A_SBAR() __builtin_amdgcn_sched_barrier(0)

template <int THRL, bool ROTL>
__device__ __forceinline__ void attn_pass(const bf16_t* __restrict__ Qb, const bf16_t* __restrict__ Kh, const bf16_t* __restrict__ Vh, int NT, char* shm, f32x16 (&o)[4], float& l_out) {
  int tid_ = threadIdx.x; asm volatile("" : "+v"(tid_));
  const int tid = tid_, lane = tid & 63, r32 = lane & 31, hi = lane >> 5; const int wid = __builtin_amdgcn_readfirstlane(tid >> 6);
#ifdef ATT_NOSTAGGER
  const int half = 0;
#else
#ifdef ATT_PARITY
  const int half = wid & 1;
#else
  const int half = wid >> 2;
#endif
#endif
  const unsigned lds0 = (unsigned)(uintptr_t)shm;
  float* wsf = (float*)(shm + LDS_WS) + wid * 64;
  const bf16_t* ksrc = Kh + wid * 512 + lane * 8;
  const bf16_t* vsrc = Vh + wid * 512 + lane * 8;
  const unsigned kdst = lds0 + LDS_K + wid * 1024, vdst = lds0 + LDS_V + wid * 1024;
#ifdef ATT_LDR4
#define A_RFL(x) (unsigned)__builtin_amdgcn_readfirstlane(x)
#define DMA_K(t, s) do { if (wid < 4) { glds16(ksrc + (long)(t) * 4096, A_RFL(kdst + (s) * KSLOT)); glds16(ksrc + (long)(t) * 4096 + 2048, A_RFL(kdst + (s) * KSLOT + 4096)); } } while (0)
#define DMA_VA(t, s) do { if (wid < 4) { glds16(vsrc + (long)(t) * 8192, A_RFL(vdst + (s) * VSLOT)); glds16(vsrc + (long)(t) * 8192 + 2048, A_RFL(vdst + (s) * VSLOT + 4096)); } } while (0)
#define DMA_VB(t, s) do { if (wid < 4) { glds16(vsrc + (long)(t) * 8192 + 4096, A_RFL(vdst + (s) * VSLOT + 8192)); glds16(vsrc + (long)(t) * 8192 + 6144, A_RFL(vdst + (s) * VSLOT + 12288)); } } while (0)
#else
#define DMA_K(t, s) glds16(ksrc + (long)(t) * 4096, (unsigned)__builtin_amdgcn_readfirstlane(kdst + (s) * KSLOT))
#define DMA_VA(t, s) glds16(vsrc + (long)(t) * 8192, (unsigned)__builtin_amdgcn_readfirstlane(vdst + (s) * VSLOT))
#define DMA_VB(t, s) glds16(vsrc + (long)(t) * 8192 + 4096, (unsigned)__builtin_amdgcn_readfirstlane(vdst + (s) * VSLOT + 8192))
#endif
#define DMA_V(t, s) do { DMA_VA(t, s); DMA_VB(t, s); } while (0)
  bf16x8 qr[4];
  { const bf16_t* Qw = Qb + (long)(wid * QBLK + r32) * PITCH + hi * 8;
#pragma unroll
    for (int d0 = 0; d0 < 4; ++d0) qr[d0] = *(const A_GAS bf16x8*)(Qw + d0 * 16); }
  DMA_K(0, 0);
#pragma unroll
  for (int g = 1; g < ADEPTH; ++g) { DMA_K(g, g); DMA_V(g - 1, g - 1); }
  float mhat = 0.f, l_reg = 0.f;
#pragma unroll
  for (int d = 0; d < 4; ++d) o[d] = f32x16{};
  f32x16 negm = f32x16{}; asm volatile("" : "+v"(negm));
  f32x16 S0, S1; u32x4 pw0, pw1, pw2, pw3;

  pw0 = pw1 = pw2 = pw3 = (u32x4){0u, 0u, 0u, 0u};
  A_WAITBAR(A_INFLIGHT);
  if (half == 1) A_LGKBAR();
  const unsigned kaddr0 = lds0 + LDS_K + hi * 1024 + r32 * 16;
  const unsigned vaddr0 = lds0 + LDS_V + ((lane >> 4) & 1) * 32 + (lane & 3) * 8 + (4 * hi + ((lane & 15) >> 2)) * 64;
#define A_KRD(dst, addr, off) asm volatile("ds_read_b128 %0, %1 offset:%2" : "=&v"(dst) : "v"(addr), "i"(off) : "memory")
#define A_VRD(dst, addr, off) asm volatile("ds_read_b64_tr_b16 %0, %1 offset:%2" : "=&v"(dst) : "v"(addr), "i"(off) : "memory")
#define A_VRD8(b, addr, d0) do { A_VRD(vl[b][0], addr, (d0) * 4096); A_VRD(vh[b][0], addr, (d0) * 4096 + 512); A_VRD(vl[b][1], addr, (d0) * 4096 + 1024); A_VRD(vh[b][1], addr, (d0) * 4096 + 1536); \
                                  A_VRD(vl[b][2], addr, (d0) * 4096 + 2048); A_VRD(vh[b][2], addr, (d0) * 4096 + 2560); A_VRD(vl[b][3], addr, (d0) * 4096 + 3072); A_VRD(vh[b][3], addr, (d0) * 4096 + 3584); } while (0)
#define A_LWAIT(n) do { asm volatile("s_waitcnt lgkmcnt(" #n ")" ::: "memory"); A_SBAR(); } while (0)
#define A_VFR(b, k) (bf16x8){vl[b][k][0], vl[b][k][1], vl[b][k][2], vl[b][k][3], vh[b][k][0], vh[b][k][1], vh[b][k][2], vh[b][k][3]}
#define A_PV4(od, b) do { od = __builtin_amdgcn_mfma_f32_32x32x16_bf16(__builtin_bit_cast(bf16x8, pw0), A_VFR(b, 0), od, 0, 0, 0); od = __builtin_amdgcn_mfma_f32_32x32x16_bf16(__builtin_bit_cast(bf16x8, pw1), A_VFR(b, 1), od, 0, 0, 0); \
                          od = __builtin_amdgcn_mfma_f32_32x32x16_bf16(__builtin_bit_cast(bf16x8, pw2), A_VFR(b, 2), od, 0, 0, 0); od = __builtin_amdgcn_mfma_f32_32x32x16_bf16(__builtin_bit_cast(bf16x8, pw3), A_VFR(b, 3), od, 0, 0, 0); } while (0)
#define A_QK8() do { S0 = __builtin_amdgcn_mfma_f32_32x32x16_bf16(kf[0], qr[0], negm, 0, 0, 0); S1 = __builtin_amdgcn_mfma_f32_32x32x16_bf16(kf[1], qr[0], negm, 0, 0, 0); \
    _Pragma("unroll") for (int d0 = 1; d0 < 4; ++d0) { S0 = __builtin_amdgcn_mfma_f32_32x32x16_bf16(kf[2 * d0], qr[d0], S0, 0, 0, 0); S1 = __builtin_amdgcn_mfma_f32_32x32x16_bf16(kf[2 * d0 + 1], qr[d0], S1, 0, 0, 0); } } while (0)
#define A_KRD8(addr) do { _Pragma("unroll") for (int d0 = 0; d0 < 4; ++d0) { A_KRD(kf[2 * d0], addr, d0 * 2048); A_KRD(kf[2 * d0 + 1], addr, d0 * 2048 + 512); } } while (0)
  const unsigned wsa = lds0 + LDS_WS + wid * 256 + hi * 16;
#define A_RESCALE_O() do { asm volatile("s_waitcnt lgkmcnt(0)" ::: "memory"); \
    _Pragma("unroll") for (int r4 = 0; r4 < 4; ++r4) { f32x4v w4_; asm volatile("ds_read_b128 %0, %1 offset:%2\n\ts_waitcnt lgkmcnt(0)" : "=&v"(w4_) : "v"(wsa), "i"(r4 * 32) : "memory"); \
      _Pragma("unroll") for (int d = 0; d < 4; ++d) _Pragma("unroll") for (int q = 0; q < 4; ++q) o[d][4 * r4 + q] *= w4_[q]; } } while (0)
#ifdef ATT_NOSTAGGER
#define A_END_M() do { } while (0)
#else
#define A_END_M() do { if (half == 1) { if (i + ADEPTH < NT) A_WAITBAR(A_INFLIGHT); else A_WAITBAR(0); } else A_LGKBAR(); } while (0)
#endif
#define A_MBLOCK(QK, PV) do { bf16x8 kf[8]; s16x4 vl[2][4], vh[2][4]; const unsigned ka = kaddr0 + s * KSLOT, va = vaddr0 + sK * VSLOT; \
    if (i + ADEPTH < NT) DMA_K(i + ADEPTH, sK); if (i + ADEPTH - 1 < NT) DMA_V(i + ADEPTH - 1, sV); \
    if (QK) A_KRD8(ka); \
    if (PV) A_VRD8(0, va, 0); \
    if (QK) { if (PV) A_LWAIT(8); else A_LWAIT(0); A_QK8(); A_SBAR(); } \
    if (PV) { A_VRD8(1, va, 1); A_LWAIT(8); A_PV4(o[0], 0); A_SBAR(); A_VRD8(0, va, 2); A_LWAIT(8); A_PV4(o[1], 1); A_SBAR(); A_VRD8(1, va, 3); A_LWAIT(8); A_PV4(o[2], 0); A_SBAR(); A_LWAIT(0); A_PV4(o[3], 1); } \
    A_END_M(); } while (0)
#define A_VBLOCK(FIRST) do { \
      float a = fmaxf(fmaxf(S0[0], S0[1]), S1[0]), b = fmaxf(fmaxf(S0[2], S0[3]), S1[1]); a = fmaxf(fmaxf(a, S1[2]), S1[3]); \
      _Pragma("unroll") for (int r = 4; r < 16; r += 4) { a = fmaxf(fmaxf(a, S0[r]), S0[r + 1]); b = fmaxf(fmaxf(b, S0[r + 2]), S0[r + 3]); a = fmaxf(fmaxf(a, S1[r]), S1[r + 1]); b = fmaxf(fmaxf(b, S1[r + 2]), S1[r + 3]); } \
      float rm = fmaxf(a, b); \
      { auto rr = __builtin_amdgcn_permlane32_swap(__float_as_uint(rm), __float_as_uint(rm), false, false); rm = fmaxf(__uint_as_float(rr[0]), __uint_as_float(rr[1])); } \
      bool resc = false; \
      if (FIRST || __builtin_expect(__any(rm > (float)THRL), 0)) { \
        const float dl = FIRST ? rm : fmaxf(rm, 0.f); mhat += dl; \
        _Pragma("unroll") for (int r = 0; r < 16; ++r) { S0[r] -= dl; S1[r] -= dl; } \
        _Pragma("unroll") for (int r = 0; r < 16; ++r) negm[r] = -mhat; \
        asm volatile("" : "+v"(negm)); \
        const float f = __builtin_amdgcn_exp2f(-dl); l_reg *= f; if (hi == 0) wsf[r32] = f; resc = !(FIRST); } \
      _Pragma("unroll") for (int r = 0; r < 16; ++r) { S0[r] = __builtin_amdgcn_exp2f(S0[r]); S1[r] = __builtin_amdgcn_exp2f(S1[r]); } \
      float sa = (S0[0] + S0[1]) + (S0[2] + S0[3]), sb = (S1[0] + S1[1]) + (S1[2] + S1[3]); \
      _Pragma("unroll") for (int r = 4; r < 16; r += 4) { sa += (S0[r] + S0[r + 1]) + (S0[r + 2] + S0[r + 3]); sb += (S1[r] + S1[r + 1]) + (S1[r + 2] + S1[r + 3]); } \
      l_reg += sa + sb; \
      pw0 = (u32x4){cvtpk(S0[0], S0[1]), cvtpk(S0[2], S0[3]), cvtpk(S0[4], S0[5]), cvtpk(S0[6], S0[7])}; \
      pw1 = (u32x4){cvtpk(S0[8], S0[9]), cvtpk(S0[10], S0[11]), cvtpk(S0[12], S0[13]), cvtpk(S0[14], S0[15])}; \
      pw2 = (u32x4){cvtpk(S1[0], S1[1]), cvtpk(S1[2], S1[3]), cvtpk(S1[4], S1[5]), cvtpk(S1[6], S1[7])}; \
      pw3 = (u32x4){cvtpk(S1[8], S1[9]), cvtpk(S1[10], S1[11]), cvtpk(S1[12], S1[13]), cvtpk(S1[14], S1[15])}; \
      if (resc) A_RESCALE_O(); \
      if (half == 0) { if (i + ADEPTH < NT) A_WAITBAR(A_INFLIGHT); else A_WAITBAR(0); } else A_LGKBAR(); } while (0)
#ifdef ATT_TRIG1
#define A_TRIG 1.0f
#else
#define A_TRIG (float)(1 << THRL)
#endif
#if defined(TPROBE)
#define A_TP_NOW() __builtin_readcyclecounter()
#define A_TP_DECL() unsigned long long tq0_ = 0, tq1_ = 0
#else
#define A_TP_DECL() do { } while (0)
#endif
#if defined(TPROBE) && TPROBE == 2
#define A_TP_TOP() do { } while (0)
#define A_TP_M8() do { } while (0)
#define A_TP_PRE() tq0_ = A_TP_NOW()
#define A_TP_POST() do { tq1_ = A_TP_NOW(); tpa_ += tq1_ - tq0_; } while (0)
#elif defined(TPROBE) && TPROBE == 3
#define A_TP_TOP() tq0_ = A_TP_NOW()
#define A_TP_M8() tq1_ = A_TP_NOW()
#define A_TP_PRE() do { } while (0)
#define A_TP_POST() tpa_ += tq1_ - tq0_
#elif defined(TPROBE) && TPROBE == 4
#define A_TP_TOP() do { } while (0)
#define A_TP_M8() tq0_ = A_TP_NOW()
#define A_TP_PRE() tq1_ = A_TP_NOW()
#define A_TP_POST() tpa_ += tq1_ - tq0_
#else
#define A_TP_TOP() do { } while (0)
#define A_TP_M8() do { } while (0)
#define A_TP_PRE() do { } while (0)
#define A_TP_POST() do { } while (0)
#endif
#if defined(TPROBE) && TPROBE == 2
#define A_TPB_PRE() const unsigned long long tb0_ = __builtin_readcyclecounter()
#define A_TPB_POST() do { const unsigned long long tb1_ = __builtin_readcyclecounter(); tpa_ += tb1_ - tb0_; } while (0)
#else
#define A_TPB_PRE() do { } while (0)
#define A_TPB_POST() do { } while (0)
#endif
#define A_SX(j) ((j) < 16 ? S0[(j) & 15] : S1[(j) & 15])
#define A_GAP(od, ks, b, w) do { od = __builtin_amdgcn_mfma_f32_32x32x16_bf16(__builtin_bit_cast(bf16x8, pw##ks), A_VFR(b, ks), od, 0, 0, 0); \
    { const float s0_ = A_SX(2 * (w)), s1_ = A_SX(2 * (w) + 1); \
      const float e0_ = __builtin_amdgcn_exp2f(s0_), e1_ = __builtin_amdgcn_exp2f(s1_); sa += e0_; sb += e1_; unsigned w_ = cvtpk_b(e0_, e1_); asm volatile("" : "+v"(w_), "+v"(sa), "+v"(sb)); pwn[(w) >> 2][(w) & 3] = w_; } A_SBAR(); } while (0)
#define A_PV4I(od, b, w0) do { A_GAP(od, 0, b, (w0)); A_GAP(od, 1, b, (w0) + 1); A_GAP(od, 2, b, (w0) + 2); A_GAP(od, 3, b, (w0) + 3); } while (0)
#define A_KRD8S() do { A_KRD(kf[0], ka, 0); A_KRD(kf[2], ka, 2048); A_KRD(kf[4], ka, 4096); A_KRD(kf[6], ka, 6144); } while (0)
#define A_KRD4B() do { A_KRD(kf[1], ka, 512); A_KRD(kf[3], ka, 2560); A_KRD(kf[5], ka, 4608); A_KRD(kf[7], ka, 6656); } while (0)
#define A_HEAD() do { __builtin_amdgcn_s_setprio(3); A_SBAR(); A_KRD8S(); } while (0)
#define A_TAIL(REISSUE) do { o[3] = __builtin_amdgcn_mfma_f32_32x32x16_bf16(__builtin_bit_cast(bf16x8, pw0), A_VFR(1, 0), o[3], 0, 0, 0); { sa += e22_; sb += e23_; unsigned w11_ = cvtpk_b(e22_, e23_); e26_ = __builtin_amdgcn_exp2f(S1[10]); e27_ = __builtin_amdgcn_exp2f(S1[11]); asm volatile("" : "+v"(sa), "+v"(sb), "+v"(w11_), "+v"(e26_), "+v"(e27_)); pwn[2][3] = w11_; } A_SBAR(); o[3] = __builtin_amdgcn_mfma_f32_32x32x16_bf16(__builtin_bit_cast(bf16x8, pw1), A_VFR(1, 1), o[3], 0, 0, 0); { sa += e24_; sb += e25_; unsigned w12_ = cvtpk_b(e24_, e25_); e28_ = __builtin_amdgcn_exp2f(S1[12]); e29_ = __builtin_amdgcn_exp2f(S1[13]); asm volatile("" : "+v"(sa), "+v"(sb), "+v"(w12_), "+v"(e28_), "+v"(e29_)); pwn[3][0] = w12_; } A_SBAR(); o[3] = __builtin_amdgcn_mfma_f32_32x32x16_bf16(__builtin_bit_cast(bf16x8, pw2), A_VFR(1, 2), o[3], 0, 0, 0); { sa += e26_; sb += e27_; unsigned w13_ = cvtpk_b(e26_, e27_); e30_ = __builtin_amdgcn_exp2f(S1[14]); e31_ = __builtin_amdgcn_exp2f(S1[15]); asm volatile("" : "+v"(sa), "+v"(sb), "+v"(w13_), "+v"(e30_), "+v"(e31_)); pwn[3][1] = w13_; } A_SBAR(); o[3] = __builtin_amdgcn_mfma_f32_32x32x16_bf16(__builtin_bit_cast(bf16x8, pw3), A_VFR(1, 3), o[3], 0, 0, 0); { sa += e28_; sb += e29_; unsigned w14_ = cvtpk_b(e28_, e29_); sa += e30_; sb += e31_; unsigned w15_ = cvtpk_b(e30_, e31_); asm volatile("" : "+v"(sa), "+v"(sb), "+v"(w14_), "+v"(w15_)); pwn[3][2] = w14_; pwn[3][3] = w15_; } A_SBAR(); \
      \
    float rm = sa + sb;                                     \
    { auto rr = __builtin_amdgcn_permlane32_swap(__float_as_uint(rm), __float_as_uint(rm), false, false); rm = __uint_as_float(rr[0]) + __uint_as_float(rr[1]); } \
    if (__builtin_expect(__any(rm > A_TRIG), 0)) { asm volatile("s_waitcnt lgkmcnt(0)" ::: "memory");     \
      const float dl = fmaxf(__builtin_amdgcn_logf(rm), 0.f); mhat += dl; \
      _Pragma("unroll") for (int r = 0; r < 16; ++r) negm[r] = -mhat; \
      asm volatile("" : "+v"(negm)); \
      const float f = __builtin_amdgcn_exp2f(-dl); l_reg *= f; sa *= f; sb *= f; \
      _Pragma("unroll") for (int q = 0; q < 4; ++q) _Pragma("unroll") for (int c = 0; c < 4; ++c) { const unsigned w_ = pwn[q][c]; pwn[q][c] = cvtpk_b(__uint_as_float(w_ << 16) * f, __uint_as_float(w_ & 0xffff0000u) * f); } \
      if (hi == 0) wsf[r32] = f; A_RESCALE_O(); REISSUE; } \
    l_reg += sa + sb; pw0 = pwn[0]; pw1 = pwn[1]; pw2 = pwn[2]; pw3 = pwn[3]; \
    sa = 0.f; sb = 0.f; } while (0)
#define A_BODY() do { A_KRD4B(); \
    A_LWAIT(7); S0 = __builtin_amdgcn_mfma_f32_32x32x16_bf16(kf[0], qr[0], negm, 0, 0, 0); A_SBAR(); if (i + ADEPTH < NT) DMA_K(i + ADEPTH, sK); A_SBAR(); \
    A_LWAIT(6); S0 = __builtin_amdgcn_mfma_f32_32x32x16_bf16(kf[2], qr[1], S0, 0, 0, 0); A_SBAR(); \
    A_LWAIT(5); S0 = __builtin_amdgcn_mfma_f32_32x32x16_bf16(kf[4], qr[2], S0, 0, 0, 0); A_SBAR(); if (i + ADEPTH - 1 < NT) DMA_VA(i + ADEPTH - 1, sV); A_SBAR(); \
    A_LWAIT(4); S0 = __builtin_amdgcn_mfma_f32_32x32x16_bf16(kf[6], qr[3], S0, 0, 0, 0); A_SBAR(); A_VRD8(0, va, 0); \
    A_LWAIT(11); S1 = __builtin_amdgcn_mfma_f32_32x32x16_bf16(kf[1], qr[0], negm, 0, 0, 0); A_SBAR(); if (i + ADEPTH - 1 < NT) DMA_VB(i + ADEPTH - 1, sV); A_SBAR(); __builtin_amdgcn_s_setprio(2); A_SBAR(); \
    A_LWAIT(10); S1 = __builtin_amdgcn_mfma_f32_32x32x16_bf16(kf[3], qr[1], S1, 0, 0, 0); A_SBAR(); { e0_ = __builtin_amdgcn_exp2f(S0[0]); e1_ = __builtin_amdgcn_exp2f(S0[1]); e2_ = __builtin_amdgcn_exp2f(S0[2]); asm volatile("" : "+v"(e0_), "+v"(e1_), "+v"(e2_)); } A_SBAR(); \
    A_LWAIT(9); S1 = __builtin_amdgcn_mfma_f32_32x32x16_bf16(kf[5], qr[2], S1, 0, 0, 0); A_SBAR(); { e3_ = __builtin_amdgcn_exp2f(S0[3]); sa += e0_; sb += e1_; unsigned w0_ = cvtpk_b(e0_, e1_); asm volatile("" : "+v"(e3_), "+v"(sa), "+v"(sb), "+v"(w0_)); pwn[0][0] = w0_; } A_SBAR(); \
    A_LWAIT(8); S1 = __builtin_amdgcn_mfma_f32_32x32x16_bf16(kf[7], qr[3], S1, 0, 0, 0); A_SBAR(); { e4_ = __builtin_amdgcn_exp2f(S0[4]); e5_ = __builtin_amdgcn_exp2f(S0[5]); sa += e2_; sb += e3_; asm volatile("" : "+v"(e4_), "+v"(e5_), "+v"(sa), "+v"(sb)); } A_SBAR(); \
    A_VRD8(1, va, 1); A_LWAIT(8); o[0] = __builtin_amdgcn_mfma_f32_32x32x16_bf16(__builtin_bit_cast(bf16x8, pw0), A_VFR(0, 0), o[0], 0, 0, 0); { unsigned w1_ = cvtpk_b(e2_, e3_); e6_ = __builtin_amdgcn_exp2f(S0[6]); e7_ = __builtin_amdgcn_exp2f(S0[7]); sa += e4_; asm volatile("" : "+v"(w1_), "+v"(e6_), "+v"(e7_), "+v"(sa)); pwn[0][1] = w1_; } A_SBAR(); o[0] = __builtin_amdgcn_mfma_f32_32x32x16_bf16(__builtin_bit_cast(bf16x8, pw1), A_VFR(0, 1), o[0], 0, 0, 0); { sb += e5_; unsigned w2_ = cvtpk_b(e4_, e5_); e8_ = __builtin_amdgcn_exp2f(S0[8]); e9_ = __builtin_amdgcn_exp2f(S0[9]); asm volatile("" : "+v"(sb), "+v"(w2_), "+v"(e8_), "+v"(e9_)); pwn[0][2] = w2_; } A_SBAR(); o[0] = __builtin_amdgcn_mfma_f32_32x32x16_bf16(__builtin_bit_cast(bf16x8, pw2), A_VFR(0, 2), o[0], 0, 0, 0); { sa += e6_; sb += e7_; unsigned w3_ = cvtpk_b(e6_, e7_); e10_ = __builtin_amdgcn_exp2f(S0[10]); asm volatile("" : "+v"(sa), "+v"(sb), "+v"(w3_), "+v"(e10_)); pwn[0][3] = w3_; } A_SBAR(); o[0] = __builtin_amdgcn_mfma_f32_32x32x16_bf16(__builtin_bit_cast(bf16x8, pw3), A_VFR(0, 3), o[0], 0, 0, 0); { e11_ = __builtin_amdgcn_exp2f(S0[11]); sa += e8_; sb += e9_; unsigned w4_ = cvtpk_b(e8_, e9_); asm volatile("" : "+v"(e11_), "+v"(sa), "+v"(sb), "+v"(w4_)); pwn[1][0] = w4_; } A_SBAR(); __builtin_amdgcn_s_setprio(1); A_SBAR(); \
    A_VRD8(0, va, 2); A_LWAIT(8); o[1] = __builtin_amdgcn_mfma_f32_32x32x16_bf16(__builtin_bit_cast(bf16x8, pw0), A_VFR(1, 0), o[1], 0, 0, 0); { e12_ = __builtin_amdgcn_exp2f(S0[12]); e13_ = __builtin_amdgcn_exp2f(S0[13]); sa += e10_; sb += e11_; asm volatile("" : "+v"(e12_), "+v"(e13_), "+v"(sa), "+v"(sb)); } A_SBAR(); o[1] = __builtin_amdgcn_mfma_f32_32x32x16_bf16(__builtin_bit_cast(bf16x8, pw1), A_VFR(1, 1), o[1], 0, 0, 0); { unsigned w5_ = cvtpk_b(e10_, e11_); e14_ = __builtin_amdgcn_exp2f(S0[14]); e15_ = __builtin_amdgcn_exp2f(S0[15]); sa += e12_; asm volatile("" : "+v"(w5_), "+v"(e14_), "+v"(e15_), "+v"(sa)); pwn[1][1] = w5_; } A_SBAR(); o[1] = __builtin_amdgcn_mfma_f32_32x32x16_bf16(__builtin_bit_cast(bf16x8, pw2), A_VFR(1, 2), o[1], 0, 0, 0); { sb += e13_; unsigned w6_ = cvtpk_b(e12_, e13_); e16_ = __builtin_amdgcn_exp2f(S1[0]); e17_ = __builtin_amdgcn_exp2f(S1[1]); asm volatile("" : "+v"(sb), "+v"(w6_), "+v"(e16_), "+v"(e17_)); pwn[1][2] = w6_; } A_SBAR(); o[1] = __builtin_amdgcn_mfma_f32_32x32x16_bf16(__builtin_bit_cast(bf16x8, pw3), A_VFR(1, 3), o[1], 0, 0, 0); { sa += e14_; sb += e15_; unsigned w7_ = cvtpk_b(e14_, e15_); e18_ = __builtin_amdgcn_exp2f(S1[2]); asm volatile("" : "+v"(sa), "+v"(sb), "+v"(w7_), "+v"(e18_)); pwn[1][3] = w7_; } A_SBAR(); \
    A_VRD8(1, va, 3); A_LWAIT(8); o[2] = __builtin_amdgcn_mfma_f32_32x32x16_bf16(__builtin_bit_cast(bf16x8, pw0), A_VFR(0, 0), o[2], 0, 0, 0); { e19_ = __builtin_amdgcn_exp2f(S1[3]); sa += e16_; sb += e17_; unsigned w8_ = cvtpk_b(e16_, e17_); asm volatile("" : "+v"(e19_), "+v"(sa), "+v"(sb), "+v"(w8_)); pwn[2][0] = w8_; } A_SBAR(); __builtin_amdgcn_s_setprio(0); A_SBAR(); o[2] = __builtin_amdgcn_mfma_f32_32x32x16_bf16(__builtin_bit_cast(bf16x8, pw1), A_VFR(0, 1), o[2], 0, 0, 0); { e20_ = __builtin_amdgcn_exp2f(S1[4]); e21_ = __builtin_amdgcn_exp2f(S1[5]); sa += e18_; sb += e19_; asm volatile("" : "+v"(e20_), "+v"(e21_), "+v"(sa), "+v"(sb)); } A_SBAR(); o[2] = __builtin_amdgcn_mfma_f32_32x32x16_bf16(__builtin_bit_cast(bf16x8, pw2), A_VFR(0, 2), o[2], 0, 0, 0); { unsigned w9_ = cvtpk_b(e18_, e19_); e22_ = __builtin_amdgcn_exp2f(S1[6]); e23_ = __builtin_amdgcn_exp2f(S1[7]); sa += e20_; asm volatile("" : "+v"(w9_), "+v"(e22_), "+v"(e23_), "+v"(sa)); pwn[2][1] = w9_; } A_SBAR(); o[2] = __builtin_amdgcn_mfma_f32_32x32x16_bf16(__builtin_bit_cast(bf16x8, pw3), A_VFR(0, 3), o[2], 0, 0, 0); { sb += e21_; unsigned w10_ = cvtpk_b(e20_, e21_); e24_ = __builtin_amdgcn_exp2f(S1[8]); e25_ = __builtin_amdgcn_exp2f(S1[9]); asm volatile("" : "+v"(sb), "+v"(w10_), "+v"(e24_), "+v"(e25_)); pwn[2][2] = w10_; } A_SBAR(); \
    A_TPB_PRE(); if (i + ADEPTH < NT) A_WAITBAR(A_INFLIGHT); else A_WAITBAR(0); A_TPB_POST(); } while (0)
#define A_ITER1() do { bf16x8 kf[8]; const unsigned ka = kaddr0 + s * KSLOT, va = vaddr0 + sK * VSLOT; A_HEAD(); A_BODY(); } while (0)
#define A_ITER() do { bf16x8 kf[8]; const unsigned ka = kaddr0 + s * KSLOT, va = vaddr0 + sK * VSLOT; A_HEAD(); A_TAIL(A_KRD8S()); A_BODY(); } while (0)
#define A_ITER0() do { bf16x8 kf[8]; s16x4 vl[2][4], vh[2][4]; const unsigned ka = kaddr0 + s * KSLOT, va = vaddr0 + sK * VSLOT; \
      \
    __builtin_amdgcn_s_setprio(3); A_SBAR(); A_KRD(kf[0], ka, 0); A_KRD(kf[2], ka, 2048); A_KRD(kf[4], ka, 4096); A_KRD(kf[6], ka, 6144); A_KRD(kf[1], ka, 512); A_KRD(kf[3], ka, 2560); A_KRD(kf[5], ka, 4608); A_KRD(kf[7], ka, 6656); \
    float sa = 0.f, sb = 0.f; u32x4 pwn[4]; float e0_, e1_, e2_, e3_, e4_, e5_, e6_, e7_, e8_, e9_, e10_, e11_, e12_, e13_, e14_, e15_, e16_, e17_, e18_, e19_, e20_, e21_, e22_, e23_, e24_, e25_, e26_, e27_, e28_, e29_, e30_, e31_; \
      \
    A_LWAIT(7); S0 = __builtin_amdgcn_mfma_f32_32x32x16_bf16(kf[0], qr[0], negm, 0, 0, 0); A_SBAR(); if (i + ADEPTH < NT) DMA_K(i + ADEPTH, sK); A_SBAR(); \
    A_LWAIT(6); S0 = __builtin_amdgcn_mfma_f32_32x32x16_bf16(kf[2], qr[1], S0, 0, 0, 0); A_SBAR(); \
    A_LWAIT(5); S0 = __builtin_amdgcn_mfma_f32_32x32x16_bf16(kf[4], qr[2], S0, 0, 0, 0); A_SBAR(); if (i + ADEPTH - 1 < NT) DMA_VA(i + ADEPTH - 1, sV); A_SBAR(); \
    A_LWAIT(4); S0 = __builtin_amdgcn_mfma_f32_32x32x16_bf16(kf[6], qr[3], S0, 0, 0, 0); A_SBAR(); A_VRD8(0, va, 0); \
    A_LWAIT(11); S1 = __builtin_amdgcn_mfma_f32_32x32x16_bf16(kf[1], qr[0], negm, 0, 0, 0); A_SBAR(); if (i + ADEPTH - 1 < NT) DMA_VB(i + ADEPTH - 1, sV); A_SBAR(); \
    A_LWAIT(10); S1 = __builtin_amdgcn_mfma_f32_32x32x16_bf16(kf[3], qr[1], S1, 0, 0, 0); A_SBAR(); { e0_ = __builtin_amdgcn_exp2f(S0[0]); e1_ = __builtin_amdgcn_exp2f(S0[1]); e2_ = __builtin_amdgcn_exp2f(S0[2]); asm volatile("" : "+v"(e0_), "+v"(e1_), "+v"(e2_)); } A_SBAR(); __builtin_amdgcn_s_setprio(2); A_SBAR(); \
    A_LWAIT(9); S1 = __builtin_amdgcn_mfma_f32_32x32x16_bf16(kf[5], qr[2], S1, 0, 0, 0); A_SBAR(); { e3_ = __builtin_amdgcn_exp2f(S0[3]); sa += e0_; sb += e1_; unsigned w0_ = cvtpk_b(e0_, e1_); asm volatile("" : "+v"(e3_), "+v"(sa), "+v"(sb), "+v"(w0_)); pwn[0][0] = w0_; } A_SBAR(); \
    A_LWAIT(8); S1 = __builtin_amdgcn_mfma_f32_32x32x16_bf16(kf[7], qr[3], S1, 0, 0, 0); A_SBAR(); { e4_ = __builtin_amdgcn_exp2f(S0[4]); e5_ = __builtin_amdgcn_exp2f(S0[5]); sa += e2_; sb += e3_; asm volatile("" : "+v"(e4_), "+v"(e5_), "+v"(sa), "+v"(sb)); } A_SBAR(); \
    A_VRD8(1, va, 1); A_LWAIT(8); o[0] = __builtin_amdgcn_mfma_f32_32x32x16_bf16(__builtin_bit_cast(bf16x8, pw0), A_VFR(0, 0), o[0], 0, 0, 0); { unsigned w1_ = cvtpk_b(e2_, e3_); e6_ = __builtin_amdgcn_exp2f(S0[6]); e7_ = __builtin_amdgcn_exp2f(S0[7]); sa += e4_; asm volatile("" : "+v"(w1_), "+v"(e6_), "+v"(e7_), "+v"(sa)); pwn[0][1] = w1_; } A_SBAR(); o[0] = __builtin_amdgcn_mfma_f32_32x32x16_bf16(__builtin_bit_cast(bf16x8, pw1), A_VFR(0, 1), o[0], 0, 0, 0); { sb += e5_; unsigned w2_ = cvtpk_b(e4_, e5_); e8_ = __builtin_amdgcn_exp2f(S0[8]); e9_ = __builtin_amdgcn_exp2f(S0[9]); asm volatile("" : "+v"(sb), "+v"(w2_), "+v"(e8_), "+v"(e9_)); pwn[0][2] = w2_; } A_SBAR(); o[0] = __builtin_amdgcn_mfma_f32_32x32x16_bf16(__builtin_bit_cast(bf16x8, pw2), A_VFR(0, 2), o[0], 0, 0, 0); { sa += e6_; sb += e7_; unsigned w3_ = cvtpk_b(e6_, e7_); e10_ = __builtin_amdgcn_exp2f(S0[10]); asm volatile("" : "+v"(sa), "+v"(sb), "+v"(w3_), "+v"(e10_)); pwn[0][3] = w3_; } A_SBAR(); o[0] = __builtin_amdgcn_mfma_f32_32x32x16_bf16(__builtin_bit_cast(bf16x8, pw3), A_VFR(0, 3), o[0], 0, 0, 0); { e11_ = __builtin_amdgcn_exp2f(S0[11]); sa += e8_; sb += e9_; unsigned w4_ = cvtpk_b(e8_, e9_); asm volatile("" : "+v"(e11_), "+v"(sa), "+v"(sb), "+v"(w4_)); pwn[1][0] = w4_; } A_SBAR(); __builtin_amdgcn_s_setprio(1); A_SBAR(); \
    A_VRD8(0, va, 2); A_LWAIT(8); o[1] = __builtin_amdgcn_mfma_f32_32x32x16_bf16(__builtin_bit_cast(bf16x8, pw0), A_VFR(1, 0), o[1], 0, 0, 0); { e12_ = __builtin_amdgcn_exp2f(S0[12]); e13_ = __builtin_amdgcn_exp2f(S0[13]); sa += e10_; sb += e11_; asm volatile("" : "+v"(e12_), "+v"(e13_), "+v"(sa), "+v"(sb)); } A_SBAR(); o[1] = __builtin_amdgcn_mfma_f32_32x32x16_bf16(__builtin_bit_cast(bf16x8, pw1), A_VFR(1, 1), o[1], 0, 0, 0); { unsigned w5_ = cvtpk_b(e10_, e11_); e14_ = __builtin_amdgcn_exp2f(S0[14]); e15_ = __builtin_amdgcn_exp2f(S0[15]); sa += e12_; asm volatile("" : "+v"(w5_), "+v"(e14_), "+v"(e15_), "+v"(sa)); pwn[1][1] = w5_; } A_SBAR(); o[1] = __builtin_amdgcn_mfma_f32_32x32x16_bf16(__builtin_bit_cast(bf16x8, pw2), A_VFR(1, 2), o[1], 0, 0, 0); { sb += e13_; unsigned w6_ = cvtpk_b(e12_, e13_); e16_ = __builtin_amdgcn_exp2f(S1[0]); e17_ = __builtin_amdgcn_exp2f(S1[1]); asm volatile("" : "+v"(sb), "+v"(w6_), "+v"(e16_), "+v"(e17_)); pwn[1][2] = w6_; } A_SBAR(); o[1] = __builtin_amdgcn_mfma_f32_32x32x16_bf16(__builtin_bit_cast(bf16x8, pw3), A_VFR(1, 3), o[1], 0, 0, 0); { sa += e14_; sb += e15_; unsigned w7_ = cvtpk_b(e14_, e15_); e18_ = __builtin_amdgcn_exp2f(S1[2]); asm volatile("" : "+v"(sa), "+v"(sb), "+v"(w7_), "+v"(e18_)); pwn[1][3] = w7_; } A_SBAR(); \
    A_VRD8(1, va, 3); A_LWAIT(8); o[2] = __builtin_amdgcn_mfma_f32_32x32x16_bf16(__builtin_bit_cast(bf16x8, pw0), A_VFR(0, 0), o[2], 0, 0, 0); { e19_ = __builtin_amdgcn_exp2f(S1[3]); sa += e16_; sb += e17_; unsigned w8_ = cvtpk_b(e16_, e17_); asm volatile("" : "+v"(e19_), "+v"(sa), "+v"(sb), "+v"(w8_)); pwn[2][0] = w8_; } A_SBAR(); o[2] = __builtin_amdgcn_mfma_f32_32x32x16_bf16(__builtin_bit_cast(bf16x8, pw1), A_VFR(0, 1), o[2], 0, 0, 0); { e20_ = __builtin_amdgcn_exp2f(S1[4]); e21_ = __builtin_amdgcn_exp2f(S1[5]); sa += e18_; sb += e19_; asm volatile("" : "+v"(e20_), "+v"(e21_), "+v"(sa), "+v"(sb)); } A_SBAR(); __builtin_amdgcn_s_setprio(0); A_SBAR(); o[2] = __builtin_amdgcn_mfma_f32_32x32x16_bf16(__builtin_bit_cast(bf16x8, pw2), A_VFR(0, 2), o[2], 0, 0, 0); { unsigned w9_ = cvtpk_b(e18_, e19_); e22_ = __builtin_amdgcn_exp2f(S1[6]); e23_ = __builtin_amdgcn_exp2f(S1[7]); sa += e20_; asm volatile("" : "+v"(w9_), "+v"(e22_), "+v"(e23_), "+v"(sa)); pwn[2][1] = w9_; } A_SBAR(); o[2] = __builtin_amdgcn_mfma_f32_32x32x16_bf16(__builtin_bit_cast(bf16x8, pw3), A_VFR(0, 3), o[2], 0, 0, 0); { sb += e21_; unsigned w10_ = cvtpk_b(e20_, e21_); e24_ = __builtin_amdgcn_exp2f(S1[8]); e25_ = __builtin_amdgcn_exp2f(S1[9]); asm volatile("" : "+v"(sb), "+v"(w10_), "+v"(e24_), "+v"(e25_)); pwn[2][2] = w10_; } A_SBAR(); \
    A_LWAIT(0); o[3] = __builtin_amdgcn_mfma_f32_32x32x16_bf16(__builtin_bit_cast(bf16x8, pw0), A_VFR(1, 0), o[3], 0, 0, 0); { sa += e22_; sb += e23_; unsigned w11_ = cvtpk_b(e22_, e23_); e26_ = __builtin_amdgcn_exp2f(S1[10]); e27_ = __builtin_amdgcn_exp2f(S1[11]); asm volatile("" : "+v"(sa), "+v"(sb), "+v"(w11_), "+v"(e26_), "+v"(e27_)); pwn[2][3] = w11_; } A_SBAR(); o[3] = __builtin_amdgcn_mfma_f32_32x32x16_bf16(__builtin_bit_cast(bf16x8, pw1), A_VFR(1, 1), o[3], 0, 0, 0); { sa += e24_; sb += e25_; unsigned w12_ = cvtpk_b(e24_, e25_); e28_ = __builtin_amdgcn_exp2f(S1[12]); e29_ = __builtin_amdgcn_exp2f(S1[13]); asm volatile("" : "+v"(sa), "+v"(sb), "+v"(w12_), "+v"(e28_), "+v"(e29_)); pwn[3][0] = w12_; } A_SBAR(); o[3] = __builtin_amdgcn_mfma_f32_32x32x16_bf16(__builtin_bit_cast(bf16x8, pw2), A_VFR(1, 2), o[3], 0, 0, 0); { sa += e26_; sb += e27_; unsigned w13_ = cvtpk_b(e26_, e27_); e30_ = __builtin_amdgcn_exp2f(S1[14]); e31_ = __builtin_amdgcn_exp2f(S1[15]); asm volatile("" : "+v"(sa), "+v"(sb), "+v"(w13_), "+v"(e30_), "+v"(e31_)); pwn[3][1] = w13_; } A_SBAR(); o[3] = __builtin_amdgcn_mfma_f32_32x32x16_bf16(__builtin_bit_cast(bf16x8, pw3), A_VFR(1, 3), o[3], 0, 0, 0); { sa += e28_; sb += e29_; unsigned w14_ = cvtpk_b(e28_, e29_); sa += e30_; sb += e31_; unsigned w15_ = cvtpk_b(e30_, e31_); asm volatile("" : "+v"(sa), "+v"(sb), "+v"(w14_), "+v"(w15_)); pwn[3][2] = w14_; pwn[3][3] = w15_; } A_SBAR(); \
      \
    float rm = sa + sb;                                     \
    { auto rr = __builtin_amdgcn_permlane32_swap(__float_as_uint(rm), __float_as_uint(rm), false, false); rm = __uint_as_float(rr[0]) + __uint_as_float(rr[1]); } \
    if (__builtin_expect(__any(rm > A_TRIG), 0)) { \
      const float dl = fmaxf(__builtin_amdgcn_logf(rm), 0.f); mhat += dl; \
      _Pragma("unroll") for (int r = 0; r < 16; ++r) negm[r] = -mhat; \
      asm volatile("" : "+v"(negm)); \
      const float f = __builtin_amdgcn_exp2f(-dl); l_reg *= f; sa *= f; sb *= f; \
      _Pragma("unroll") for (int q = 0; q < 4; ++q) _Pragma("unroll") for (int c = 0; c < 4; ++c) { const unsigned w_ = pwn[q][c]; pwn[q][c] = cvtpk_b(__uint_as_float(w_ << 16) * f, __uint_as_float(w_ & 0xffff0000u) * f); } \
      if (hi == 0) wsf[r32] = f; A_RESCALE_O(); } \
    l_reg += sa + sb; pw0 = pwn[0]; pw1 = pwn[1]; pw2 = pwn[2]; pw3 = pwn[3]; \
    if (i + ADEPTH < NT) A_WAITBAR(A_INFLIGHT); else A_WAITBAR(0); } while (0)
#define A_ROT() do { sV = sK; sK = s; s = (s == NSLOT - 1) ? 0 : s + 1; } while (0)
  int s = 0, sK = NSLOT - 1, sV = NSLOT - 2, i = 0;
  if (ROTL) {
  s16x4 vl[2][4], vh[2][4]; float sa = 0.f, sb = 0.f; u32x4 pwn[4]; float e0_, e1_, e2_, e3_, e4_, e5_, e6_, e7_, e8_, e9_, e10_, e11_, e12_, e13_, e14_, e15_, e16_, e17_, e18_, e19_, e20_, e21_, e22_, e23_, e24_, e25_, e26_, e27_, e28_, e29_, e30_, e31_;
  A_MBLOCK(true, false); A_VBLOCK(true); A_ROT();
#ifdef TPROBE
  unsigned long long tp0_ = __builtin_readcyclecounter(); unsigned long long tpa_ = 0;
#endif
  i = 1; A_ITER1(); A_ROT(); ++i;
#pragma unroll 1
  for (; i + 1 < NT; ) { A_ITER(); A_ROT(); ++i; A_ITER(); A_ROT(); ++i; }
  if (i < NT) { A_ITER(); A_ROT(); ++i; }
#ifdef TPROBE
  if (NT > 100 && blockIdx.x == 0 && wid == TP_WAVE) { const unsigned long long tp1_ = __builtin_readcyclecounter();
    if (lane == 0) g_tprobe = floorf(((float)(TPROBE == 1 ? tp1_ - tp0_ : tpa_) / (float)(NT - 1) - TP_OFF) * TP_SCALE * TP_Q + 0.5f) / TP_Q; }
#endif
  A_TAIL((void)0);
  __builtin_amdgcn_s_setprio(0);
  } else {
  A_MBLOCK(true, false); A_VBLOCK(true); A_ROT();
#pragma unroll 1
  for (i = 1; i < NT; ) { A_ITER0(); A_ROT(); ++i; }
  }
  A_MBLOCK(false, true);
#ifdef ATT_NOSTAGGER
  A_LGKBAR();
#endif
#undef A_KRD
#undef A_VRD
#undef A_VRD8
#undef A_LWAIT
#undef A_VFR
#undef A_PV4
#undef A_QK8
#undef A_KRD8
#undef A_RESCALE_O
#undef A_MBLOCK
#undef A_VBLOCK
#undef A_ROT
#undef A_SX
#undef A_TRIG
#undef A_GAP
#undef A_PV4I
#undef A_ITER
#undef A_ITER0
#undef A_ITER1
#undef A_HEAD
#undef A_TAIL
#undef A_BODY
#undef A_KRD8S
#undef A_KRD4B
#ifndef ATT_NOSTAGGER
  if (half == 0) A_LGKBAR();
#endif
  { auto rr = __builtin_amdgcn_permlane32_swap(__float_as_uint(l_reg), __float_as_uint(l_reg), false, false); l_out = __uint_as_float(rr[0]) + __uint_as_float(rr[1]); }
#undef DMA_K
#undef DMA_V
#undef DMA_VA
#undef DMA_VB
}

struct Tensors { const bf16_t* Q; const bf16_t* K; const bf16_t* V; bf16_t* MIX; float* scr; const float* g; float lam, oml; };
constexpr int MIXP = 2560, MIX_ATT = 1536, KTILES = 260;
template <bool ROTL> __device__ __forceinline__ void attn_unit(int h, int q0, int NT, const Tensors& T, char* lds) {
  int tid_ = threadIdx.x; asm volatile("" : "+v"(tid_));
  const int tid = tid_, wid = tid >> 6, lane = tid & 63, r32 = lane & 31, hi = lane >> 5;
  float* li_l = (float*)(lds + LDS_WS) + wid * 64 + 32;
  f32x16 o[4]; float l_reg;
  attn_pass<8, ROTL>(T.Q + (long)q0 * PITCH + h * 128 + 64, T.K + (size_t)(h * 2 + 1) * KTILES * 4096, T.V + (size_t)h * KTILES * 8192, NT, lds, o, l_reg);
  if (hi == 0) li_l[r32] = l_reg; asm volatile("s_waitcnt lgkmcnt(0)" ::: "memory");
  {
    float rli[16];
#pragma unroll
    for (int r = 0; r < 16; ++r) rli[r] = __builtin_amdgcn_rcpf(li_l[crow(r, hi)]);
    typedef float f4 __attribute__((ext_vector_type(4)));
    A_GAS f4* sp = (A_GAS f4*)(T.scr + (size_t)tid * 64);
#pragma unroll
    for (int d0 = 0; d0 < 4; ++d0)
#pragma unroll
      for (int r4 = 0; r4 < 4; ++r4) sp[d0 * 4 + r4] = (f4){o[d0][4 * r4] * rli[4 * r4], o[d0][4 * r4 + 1] * rli[4 * r4 + 1], o[d0][4 * r4 + 2] * rli[4 * r4 + 2], o[d0][4 * r4 + 3] * rli[4 * r4 + 3]};
  }
  asm volatile("s_waitcnt vmcnt(0) lgkmcnt(0)" ::: "memory");
  attn_pass<8, ROTL>(T.Q + (long)q0 * PITCH + h * 128, T.K + (size_t)(h * 2) * KTILES * 4096, T.V + (size_t)h * KTILES * 8192, NT, lds, o, l_reg);
  if (hi == 0) li_l[r32] = l_reg; asm volatile("s_waitcnt lgkmcnt(0)" ::: "memory");
  float ss[16];
#pragma unroll
  for (int r = 0; r < 16; ++r) ss[r] = 0.f;
  { typedef float f4 __attribute__((ext_vector_type(4)));
    const A_GAS f4* sp = (const A_GAS f4*)(T.scr + (size_t)tid * 64);
#pragma unroll
    for (int r4 = 0; r4 < 4; ++r4) { float rl[4];
#pragma unroll
      for (int q = 0; q < 4; ++q) rl[q] = __builtin_amdgcn_rcpf(li_l[crow(4 * r4 + q, hi)]);
#pragma unroll
      for (int d0 = 0; d0 < 4; ++d0) { const f4 p2 = sp[d0 * 4 + r4];
#pragma unroll
        for (int q = 0; q < 4; ++q) { const float v = o[d0][4 * r4 + q] * rl[q] - T.lam * p2[q]; o[d0][4 * r4 + q] = v; ss[4 * r4 + q] += v * v; } } } }
#pragma unroll
  for (int r = 0; r < 16; ++r) {
#pragma unroll
    for (int x = 1; x < 32; x <<= 1) ss[r] += __shfl_xor(ss[r], x);
    ss[r] = T.oml / sqrtf(ss[r] * (1.f / 128.f) + 1e-6f); }
  float gv[4];
#pragma unroll
  for (int d0 = 0; d0 < 4; ++d0) gv[d0] = ((const A_GAS float*)T.g)[d0 * 32 + r32];
  A_GAS bf16_t* Ow = (A_GAS bf16_t*)T.MIX + (long)(q0 + wid * QBLK) * MIXP + MIX_ATT + h * 128;
#pragma unroll
  for (int r = 0; r < 16; ++r) { const int orow = crow(r, hi);
#pragma unroll
    for (int d0 = 0; d0 < 4; ++d0) { const unsigned w = cvtpk(o[d0][r] * ss[r] * gv[d0], 0.f); Ow[(long)orow * MIXP + d0 * 32 + r32] = (bf16_t)(w & 0xffffu); } }
  asm volatile("s_waitcnt vmcnt(0) lgkmcnt(0)" ::: "memory");
  __syncthreads();
}
#undef A_WAITBAR
#undef A_LGKBAR
#undef A_SBAR
}
#define GAS __attribute__((address_space(1)))
#define LAS __attribute__((address_space(3)))
typedef unsigned short bf16;
typedef unsigned v4u __attribute__((ext_vector_type(4)));
typedef float f32x4 __attribute__((ext_vector_type(4)));
typedef short bf16x8 __attribute__((ext_vector_type(8)));
typedef GAS unsigned gu32;
typedef GAS unsigned long long gu64;
#define RLX_AGENT __ATOMIC_RELAXED, __HIP_MEMORY_SCOPE_AGENT
#define LDS_WAIT() asm volatile("s_waitcnt lgkmcnt(0)" ::: "memory")
#define VM_WAIT() asm volatile("s_waitcnt vmcnt(0)" ::: "memory")
__device__ __forceinline__ unsigned long long rt() { return __builtin_amdgcn_s_memrealtime(); }
__device__ __forceinline__ unsigned f2bf(float f) { unsigned u = __builtin_bit_cast(unsigned, f); return (u + 0x7fffu + ((u >> 16) & 1u)) >> 16; }
__device__ __forceinline__ unsigned pk2(float lo, float hi) { return f2bf(lo) | (f2bf(hi) << 16); }

#define XB_TMO      128
#define XB_XCNT(j)  (256  + 64 * (j))
#define XB_XSUB(j)  (1280 + 64 * (j))
#define XB_XGEN(j)  (2304 + 64 * (j))
#define XB_TOP      3328
#define XB_TOPGEN   3392
#define XCD_BAR_WORDS 3456
#define XB_SPIN_CAP (1u << 18)

__device__ __forceinline__ unsigned xb_ld(unsigned* p)              { return __hip_atomic_load(p, __ATOMIC_RELAXED, __HIP_MEMORY_SCOPE_AGENT); }
__device__ __forceinline__ unsigned xb_add(unsigned* p, unsigned v) { return __hip_atomic_fetch_add(p, v, __ATOMIC_RELAXED, __HIP_MEMORY_SCOPE_AGENT); }
__device__ __forceinline__ unsigned xb_xcc_id() { return (unsigned)__builtin_amdgcn_s_getreg((3 << 11) | 20) & 0xFu; }
#define XB_SPIN(cond, bar) do { unsigned _sp = 0; while (cond) { __builtin_amdgcn_s_sleep(1); \
    if ((++_sp & 255u) == 0u) { if (xb_ld(&(bar)[XB_TMO])) break; if (_sp > XB_SPIN_CAP) { atomicAdd(&(bar)[XB_TMO], 1u); break; } } } } while (0)

struct XcdBarrier {
    unsigned* bar; unsigned x;
    volatile LAS unsigned* st;
};

__device__ __forceinline__ XcdBarrier xcd_barrier_post(unsigned* bar, volatile LAS unsigned* st) {
    XcdBarrier b; b.bar = bar; b.x = xb_xcc_id(); b.st = st;
    if (threadIdx.x == 0) (void)xb_add(&bar[XB_XCNT(b.x)], 1u);
    return b;
}
__device__ __forceinline__ void xcd_barrier_complete(unsigned* bar, unsigned x, unsigned& nloc, unsigned& nx) {
    const unsigned G = gridDim.x * gridDim.y * gridDim.z;
    unsigned sum, cnt, mine, sp = 0u;
    for (;;) {
        sum = 0u; cnt = 0u; mine = 0u;
#pragma unroll
        for (unsigned j = 0; j < 16; ++j) { const unsigned c = xb_ld(&bar[XB_XCNT(j)]); sum += c; cnt += (c > 0u) ? 1u : 0u; mine = (j == x) ? c : mine; }
        if (sum == G) break;
        __builtin_amdgcn_s_sleep(1);
        if ((++sp & 255u) == 0u) { if (xb_ld(&bar[XB_TMO])) break; if (sp > XB_SPIN_CAP) { atomicAdd(&bar[XB_TMO], 1u); break; } }
    }
    nloc = mine > 0u ? mine : 1u; nx = cnt > 0u ? cnt : 1u;
}

__device__ __forceinline__ void xcd_barrier(const XcdBarrier& b) {
    asm volatile("s_waitcnt vmcnt(0)" ::: "memory");
    __syncthreads();
    if (threadIdx.x == 0) {
        unsigned* bar = b.bar;
        __builtin_amdgcn_s_waitcnt(0);
        unsigned nloc = b.st[0], nx = b.st[1];
        if (nloc == 0u) { xcd_barrier_complete(bar, b.x, nloc, nx); b.st[0] = nloc; b.st[1] = nx; }
        const unsigned old = xb_add(&bar[XB_XSUB(b.x)], 1u);
        const unsigned gen = old / nloc;
        if (old + 1u == (gen + 1u) * nloc) {
            __builtin_amdgcn_fence(__ATOMIC_RELEASE, "agent");
            asm volatile("s_waitcnt vmcnt(0)" ::: "memory");
            const unsigned og = xb_add(&bar[XB_TOP], 1u);
            const unsigned tg = og / nx;
            if (og + 1u == (tg + 1u) * nx) xb_add(&bar[XB_TOPGEN], 1u);
            else XB_SPIN(xb_ld(&bar[XB_TOPGEN]) == tg, bar);
            __builtin_amdgcn_fence(__ATOMIC_ACQUIRE, "agent");
            xb_add(&bar[XB_XGEN(b.x)], 1u);
            asm volatile("s_waitcnt vmcnt(0)" ::: "memory");
        } else {
            XB_SPIN(xb_ld(&bar[XB_XGEN(b.x)]) == gen, bar);
            __builtin_amdgcn_fence(__ATOMIC_ACQUIRE, "agent");
            asm volatile("s_waitcnt vmcnt(0)" ::: "memory");
        }
    }
    __syncthreads();
}
constexpr int DM = 2048, SEQ = 16384, CTXL = 256, ROWS = SEQ + CTXL, NMT = ROWS / 256;
constexpr int DIN = 4608, NMODV = 6 * DM, DEPTH = 2, NE = 32, DE = 512, NIN = 31;
constexpr int MIXP = 2560;
constexpr float LN_EPS = 1e-6f, ALPHA = 1.4142135623730951f;
constexpr float QSCALE = 0.125f * 1.4426950408889634f;
constexpr int LCAP = ROWS;
constexpr int NPH = 2 + 9 * DEPTH;

constexpr size_t MiB = 1u << 20, KiB = 1024;
constexpr size_t WS_CTL = 0, CTL_ZERO_BYTES = 128 * KiB;
constexpr size_t WS_MOD = 1 * MiB;
constexpr size_t WS_SMALL = 2 * MiB;
constexpr size_t WS_BINP = WS_SMALL, WS_ROPE = WS_SMALL + 64 * KiB, WS_BTA = WS_SMALL + 128 * KiB, WS_BTB = WS_SMALL + 192 * KiB, WS_F256 = WS_SMALL + 320 * KiB,
                 WS_LAMV = WS_SMALL + 576 * KiB, WS_CS128 = WS_SMALL + 640 * KiB  ;
constexpr size_t WS_WRT = 3 * MiB;
constexpr size_t WS_MODP = 4 * MiB;
constexpr size_t WS_WOT = 10 * MiB;
constexpr size_t WS_HB = 18 * MiB, WS_PWB = 21 * MiB;
constexpr size_t WS_WCAT = 26 * MiB;
constexpr size_t WS_WIN = 46 * MiB;
constexpr size_t WS_WGU = 82 * MiB;
constexpr size_t WS_WD = 210 * MiB;
constexpr size_t WS_XN = 274 * MiB;
constexpr size_t QKV_BYTES = (size_t)ROWS * 1024 * 2;
constexpr size_t WS_Q = 339 * MiB, WS_K = WS_Q + QKV_BYTES, WS_V = WS_K + QKV_BYTES, WS_AG = WS_V + QKV_BYTES;
constexpr size_t WS_YK = WS_Q;
constexpr size_t WS_UF = 469 * MiB, WS_UFC = 485 * MiB, WS_PF2 = 486 * MiB;
constexpr size_t WS_MIX = 518 * MiB;
constexpr size_t WS_T = 600 * MiB;
constexpr size_t WS_X2 = 730 * MiB;
constexpr size_t WS_ACT = 860 * MiB;
constexpr size_t WS_DMIX = WS_ACT;
constexpr size_t WS_O2N = 902 * MiB;
static_assert(WS_DMIX + (size_t)ROWS * DM * 2 <= 934 * MiB, "Dmix overlays ACT | O2N");
constexpr size_t WS_LIST = 934 * MiB;
constexpr size_t WS_WTOK = 939 * MiB;
constexpr size_t WS_END = 940 * MiB;
static_assert(WS_AG + QKV_BYTES <= WS_UF && WS_XN + (size_t)ROWS * DM * 2 <= WS_Q && WS_MIX + (size_t)ROWS * MIXP * 2 <= WS_T && WS_T + (size_t)ROWS * DM * 4 <= WS_X2 && WS_X2 + (size_t)ROWS * DM * 4 <= WS_ACT, "ws map");
static_assert(WS_WIN + (size_t)2 * DIN * DM * 2 <= WS_WGU && WS_WGU + (size_t)NE * 1024 * DM * 2 <= WS_WD && WS_WD + (size_t)NE * DM * DE * 2 <= WS_XN && WS_WCAT + (size_t)2 * DM * MIXP * 2 <= WS_WIN, "ws map 2");
constexpr int CW_TMO = 0, CW_CODE = 1, CW_BAR = 4096, CW_CNT = 16384, CW_CONVQ = 24576;
static_assert((size_t)(CW_CNT + 2 * 32 * 64) * 4 <= CTL_ZERO_BYTES, "control words inside the per-call memset");

constexpr int RING_OFF = 0, RING_BYTES = 139264;
constexpr int LDSCTL_OFF = RING_BYTES, MISC_OFF = LDSCTL_OFF + 320;
constexpr int LDS_BYTES = 147456;
constexpr int NWAVES = 8;

typedef float f32x2v __attribute__((ext_vector_type(2)));
typedef unsigned u32x2v __attribute__((ext_vector_type(2)));
using pg8::Unit;

__device__ __forceinline__ unsigned cvtpk(float lo, float hi) { unsigned r; asm volatile("v_cvt_pk_bf16_f32 %0, %1, %2" : "=v"(r) : "v"(lo), "v"(hi)); return r; }
__device__ __forceinline__ bf16 bf1(float x) { return (bf16)(cvtpk(x, 0.f) & 0xffffu); }
__device__ __forceinline__ float bf2f(unsigned short b) { return __uint_as_float((unsigned)b << 16); }
__device__ __forceinline__ float wave_sum(float v) {
#pragma unroll
    for (int o = 1; o < 64; o <<= 1) v += __shfl_xor(v, o);
    return v;
}
__device__ __forceinline__ float silu_f(float x) { return x / (1.f + __expf(-x)); }

struct Frame {
    LAS unsigned char* lds;
    volatile LAS unsigned* MISC;
    gu32* ctl;
    int tid, lane, wave;
    int vcu, G;
    const float* const* in; float* out; unsigned char* ws;
};

struct SchedWin { pg8::GridOrder go;
    __device__ __forceinline__ bool next(int i, Unit& u) const { return go.next(i, u); }
    __device__ __forceinline__ int arow(const Unit& u, int R) const { return (u.pn < 2 && u.pm >= 1) ? CTXL + 128 * (R & 127) + 2 * (u.pm - 1) + (R >> 7) : u.pm * 256 + R; }
    __device__ __forceinline__ int brow(const Unit& u) const { return u.pn * 256; } };
struct SchedNat { pg8::GridOrder go; int pmoff;
    __device__ __forceinline__ bool next(int i, Unit& u) const { if (!go.next(i, u)) return false; u.pm += pmoff; return true; }
    __device__ __forceinline__ int arow(const Unit& u, int R) const { return u.pm * 256 + R; }
    __device__ __forceinline__ int brow(const Unit& u) const { return u.pn * 256; } };
struct SchedNatHalf { pg8::GridOrder go;
    __device__ __forceinline__ bool next(int i, Unit& u) const { if (!go.next(i, u)) return false; u.hb = u.pn & 1; u.pn >>= 1; return true; }
    __device__ __forceinline__ int arow(const Unit& u, int R) const { return u.pm * 256 + R; }
    __device__ __forceinline__ int brow(const Unit& u) const { return u.pn * 256; } };
struct SchedFA { pg8::GridOrder go;
    __device__ __forceinline__ bool next(int i, Unit& u) const { return go.next(i, u); }
    __device__ __forceinline__ int arow(const Unit& u, int R) const { return (u.pm & 255) * 256 + R; }
    __device__ __forceinline__ int brow(const Unit&) const { return 0; } };
struct SchedFB { pg8::GridOrder go;
    __device__ __forceinline__ bool next(int i, Unit& u) const { return go.next(i, u); }
    __device__ __forceinline__ int arow(const Unit& u, int R) const { return (16 * (u.pm >> 3) + (R & 15)) * 128 + 16 * (u.pm & 7) + (R >> 4); }
    __device__ __forceinline__ int brow(const Unit&) const { return 0; } };
template <int WHICH> struct SchedMoe {
    const LAS int* tstart; const LAS int* cnt; const int* list; int G, c;
    static constexpr int NPN = WHICH == 1 ? 4 : 8;
    __device__ __forceinline__ bool next(int i, Unit& u) const {
        int L = i * G + c; const int nun = tstart[NE] * NPN; u.hb = -1;
        if (WHICH == 1 && nun > 2 * G && nun - 2 * G <= G / 2) {
            if (i == 2) { if (c >= 2 * (nun - 2 * G)) return false; L = 2 * G + (c >> 1); u.hb = c & 1; } else if (i > 2) return false; }
        const int gt = L / NPN; if (gt >= tstart[NE]) return false;
        int e = 0; while (tstart[e + 1] <= gt) ++e;
        u.pm = gt; u.pn = L % NPN; u.e = e; u.rt = gt - tstart[e]; return true; }
    __device__ __forceinline__ int arow(const Unit& u, int R) const {
        if (WHICH == 2) return u.pm * 256 + R;
        const int slot = u.rt * 256 + R; return slot < cnt[u.e] ? (((const GAS int*)list)[u.e * LCAP + slot] >> 1) : 0; }
    __device__ __forceinline__ int brow(const Unit& u) const { return WHICH == 1 ? u.e * 1024 + u.pn * 256 : u.e * DM + u.pn * 256; } };

struct EpiWin {
    static constexpr bool PERM = true;
    bf16 *Uf, *UfC, *AG, *Q, *Kb, *V; const float* bias; const f32x2v* rope;
    __device__ __forceinline__ void operator()(const f32x4 (&acc)[2][2][4][2], const Unit& u, int wr, int wc, int fr, int fq) const {
        const int pn = u.pn, pm = u.pm, c0 = wc * 32 + 8 * fq;
        f32x4 bv[2][2];
#pragma unroll
        for (int bj = 0; bj < 2; ++bj)
#pragma unroll
            for (int n = 0; n < 2; ++n) bv[bj][n] = *(const GAS f32x4*)(bias + pn * 256 + bj * 128 + c0 + 4 * n);
        if (pn < 2) {
#pragma unroll
            for (int ai = 0; ai < 2; ++ai)
#pragma unroll
                for (int m = 0; m < 4; ++m)
#pragma unroll
                    for (int bj = 0; bj < 2; ++bj) {
                        const f32x4 v0 = acc[ai][bj][m][0] + bv[bj][0], v1 = acc[ai][bj][m][1] + bv[bj][1];
                        const int ch = pn * 256 + bj * 128 + c0, a = wr * 64 + m * 16 + fr;
                        GAS bf16* dst; size_t st;
                        if (pm == 0) { dst = (GAS bf16*)UfC + (size_t)ch * 256 + (ai * 128 + a); st = 256; }
                        else { dst = (GAS bf16*)Uf + ((size_t)ch * 128 + (2 * (pm - 1) + ai)) * 128 + a; st = 128 * 128; }
                        dst[0] = bf1(v0[0]); dst[st] = bf1(v0[1]); dst[2 * st] = bf1(v0[2]); dst[3 * st] = bf1(v0[3]);
                        dst[4 * st] = bf1(v1[0]); dst[5 * st] = bf1(v1[1]); dst[6 * st] = bf1(v1[2]); dst[7 * st] = bf1(v1[3]);
                    }
        } else if (pn < 6) {
            bf16* base = AG; const int colt = (pn - 2) * 256;
#pragma unroll
            for (int ai = 0; ai < 2; ++ai)
#pragma unroll
                for (int m = 0; m < 4; ++m) { bf16* rowp = base + (size_t)(pm * 256 + ai * 128 + wr * 64 + m * 16 + fr) * 1024 + colt + c0;
#pragma unroll
                    for (int bj = 0; bj < 2; ++bj) { const f32x4 v0 = acc[ai][bj][m][0] + bv[bj][0], v1 = acc[ai][bj][m][1] + bv[bj][1];
                        v4u w; w.x = cvtpk(v0[0], v0[1]); w.y = cvtpk(v0[2], v0[3]); w.z = cvtpk(v1[0], v1[1]); w.w = cvtpk(v1[2], v1[3]);
                        *(GAS v4u*)(rowp + bj * 128) = w; } }
        } else if (pn >= 14) {
#pragma unroll
            for (int ai = 0; ai < 2; ++ai)
#pragma unroll
                for (int m = 0; m < 4; ++m) { const int row = pm * 256 + ai * 128 + wr * 64 + m * 16 + fr, t = row >> 6, key = row & 63;
#pragma unroll
                    for (int bj = 0; bj < 2; ++bj) { const f32x4 v0 = acc[ai][bj][m][0] + bv[bj][0], v1 = acc[ai][bj][m][1] + bv[bj][1];
                        v4u w; w.x = cvtpk(v0[0], v0[1]); w.y = cvtpk(v0[2], v0[3]); w.z = cvtpk(v1[0], v1[1]); w.w = cvtpk(v1[2], v1[3]);
                        const int h = 2 * (pn - 14) + bj;
                        *(GAS v4u*)(V + ((((size_t)h * 260 + t) * 16 + (c0 >> 5) * 4 + (key >> 4)) * 16 + (key & 15)) * 32 + (c0 & 31)) = w; } }
        } else {
            const bool isq = pn < 10; const int colt = (pn - (isq ? 6 : 10)) * 256; const float sc = isq ? QSCALE : 1.f;
#pragma unroll
            for (int ai = 0; ai < 2; ++ai)
#pragma unroll
                for (int m = 0; m < 4; ++m) { const int row = pm * 256 + ai * 128 + wr * 64 + m * 16 + fr;
                    f32x4 cs0 = (f32x4){1.f, 0.f, 1.f, 0.f}, cs1 = cs0;
                    if (pm > 0) { const int pos = row - CTXL; const int t = (wc & 1) ? 256 + (pos & 63) : (pos >> 6);
                        const GAS f32x4* rp = (const GAS f32x4*)(rope + t * 16 + 4 * fq); cs0 = rp[0]; cs1 = rp[1]; }
#pragma unroll
                    for (int bj = 0; bj < 2; ++bj) { const f32x4 v0 = acc[ai][bj][m][0] + bv[bj][0], v1 = acc[ai][bj][m][1] + bv[bj][1];
                        const float o0 = (v0[0] * cs0[0] - v0[1] * cs0[1]) * sc, o1 = (v0[0] * cs0[1] + v0[1] * cs0[0]) * sc;
                        const float o2 = (v0[2] * cs0[2] - v0[3] * cs0[3]) * sc, o3 = (v0[2] * cs0[3] + v0[3] * cs0[2]) * sc;
                        const float o4 = (v1[0] * cs1[0] - v1[1] * cs1[1]) * sc, o5 = (v1[0] * cs1[1] + v1[1] * cs1[0]) * sc;
                        const float o6 = (v1[2] * cs1[2] - v1[3] * cs1[3]) * sc, o7 = (v1[2] * cs1[3] + v1[3] * cs1[2]) * sc;
                        v4u w; w.x = cvtpk(o0, o1); w.y = cvtpk(o2, o3); w.z = cvtpk(o4, o5); w.w = cvtpk(o6, o7);
                        if (isq) *(GAS v4u*)(Q + (size_t)row * 1024 + colt + bj * 128 + c0) = w;
                        else {
                            const int h = (colt >> 7) + bj, t = row >> 6, key = row & 63;
                            *(GAS v4u*)(Kb + (((((size_t)(h * 2 + (c0 >> 6))) * 260 + t) * 8 + ((c0 & 63) >> 3)) * 64 + key) * 8) = w; } } }
        }
    }
};
struct EpiFA {
    static constexpr bool PERM = false;
    bf16* Pf2;
    __device__ __forceinline__ void operator()(const f32x4 (&acc)[2][2][4][2], const Unit& u, int wr, int wc, int fr, int fq) const {
#pragma unroll
        for (int m = 0; m < 4; ++m) { const int b = wr * 64 + m * 16 + fr;
#pragma unroll
            for (int n = 0; n < 2; ++n)
#pragma unroll
                for (int j = 0; j < 4; ++j) { const int klo = 32 * wc + 16 * n + 4 * fq + j;
                    const float f = (float)((b * klo) & 16383) * (1.f / 16384.f);
                    const float c = __builtin_amdgcn_cosf(f), s = __builtin_amdgcn_sinf(f);
#pragma unroll
                    for (int ai = 0; ai < 2; ++ai) { const float re = acc[ai][0][m][n][j], im = acc[ai][1][m][n][j];
                        GAS bf16* d = (GAS bf16*)Pf2 + (size_t)((2 * (u.pm & 255) + ai) * 128 + klo) * 256 + b;
                        d[0] = bf1(re * c + im * s); d[128] = bf1(im * c - re * s); } }
            asm volatile("" ::: "memory"); }
    }
};
struct EpiFB {
    static constexpr bool PERM = false;
    bf16* MIX;
    __device__ __forceinline__ void operator()(const f32x4 (&acc)[2][2][4][2], const Unit& u, int wr, int wc, int fr, int fq) const {
        const int ch = 16 * (u.pm >> 3) + fr;
#pragma unroll
        for (int ai = 0; ai < 2; ++ai)
#pragma unroll
            for (int m = 0; m < 4; ++m) { const int klo = 16 * (u.pm & 7) + 8 * ai + 4 * wr + m;
#pragma unroll
                for (int bj = 0; bj < 2; ++bj)
#pragma unroll
                    for (int n = 0; n < 2; ++n)
#pragma unroll
                        for (int j = 0; j < 4; ++j) { const int khi = 32 * wc + 16 * n + 4 * fq + j;
                            ((GAS bf16*)MIX)[(size_t)(CTXL + klo + 128 * khi) * MIXP + bj * 512 + ch] = bf1(acc[ai][bj][m][n][j]); }
                asm volatile("" ::: "memory"); }
    }
};
struct EpiCtxF {
    static constexpr bool PERM = false;
    bf16* MIX;
    __device__ __forceinline__ void operator()(const f32x4 (&acc)[2][2][4][2], const Unit& u, int wr, int wc, int fr, int fq) const {
#pragma unroll
        for (int ai = 0; ai < 2; ++ai)
#pragma unroll
            for (int m = 0; m < 4; ++m) { const int k = ai * 128 + wr * 64 + m * 16 + fr;
#pragma unroll
                for (int bj = 0; bj < 2; ++bj)
#pragma unroll
                    for (int n = 0; n < 2; ++n) { const f32x4 v = acc[ai][bj][m][n]; u32x2v w; w.x = cvtpk(v[0], v[1]); w.y = cvtpk(v[2], v[3]);
                        *(GAS u32x2v*)(MIX + (size_t)k * MIXP + u.pm * 512 + u.pn * 256 + bj * 128 + wc * 32 + 16 * n + 4 * fq) = w; }
                asm volatile("" ::: "memory"); }
    }
};
struct EpiWout {
    static constexpr bool PERM = true;
    const float* mod; bf16* Dm;
    __device__ __forceinline__ void operator()(const f32x4 (&acc)[2][2][4][2], const Unit& u, int wr, int wc, int fr, int fq) const {
        const int col0 = u.pn * 256 + wc * 32 + 8 * fq;
        const float* gp = mod + (u.pm == 0 ? NMODV : 0) + 2 * DM + col0;
        f32x4 gv[2][2];
#pragma unroll
        for (int bj = 0; bj < 2; ++bj)
#pragma unroll
            for (int n = 0; n < 2; ++n) gv[bj][n] = *(const GAS f32x4*)(gp + bj * 128 + 4 * n);
#pragma unroll
        for (int ai = 0; ai < 2; ++ai)
#pragma unroll
            for (int m = 0; m < 4; ++m) { bf16* rowp = Dm + (size_t)(u.pm * 256 + ai * 128 + wr * 64 + m * 16 + fr) * DM + col0;
#pragma unroll
                for (int bj = 0; bj < 2; ++bj) { if (u.hb >= 0 && u.hb != bj) continue;
                    const f32x4 v0 = acc[ai][bj][m][0] * gv[bj][0], v1 = acc[ai][bj][m][1] * gv[bj][1];
                    v4u w; w.x = cvtpk(v0[0], v0[1]); w.y = cvtpk(v0[2], v0[3]); w.z = cvtpk(v1[0], v1[1]); w.w = cvtpk(v1[2], v1[3]);
                    *(GAS v4u*)(rowp + bj * 128) = w; } }
    }
};
struct EpiFold {
    static constexpr bool PERM = true;
    bf16* out; int col0;
    __device__ __forceinline__ void operator()(const f32x4 (&acc)[2][2][4][2], const Unit& u, int wr, int wc, int fr, int fq) const {
        const int c0 = col0 + u.pn * 256 + wc * 32 + 8 * fq;
#pragma unroll
        for (int ai = 0; ai < 2; ++ai)
#pragma unroll
            for (int m = 0; m < 4; ++m) { bf16* rowp = out + (size_t)(u.pm * 256 + ai * 128 + wr * 64 + m * 16 + fr) * MIXP + c0;
#pragma unroll
                for (int bj = 0; bj < 2; ++bj) { const f32x4 v0 = acc[ai][bj][m][0], v1 = acc[ai][bj][m][1];
                    v4u w; w.x = cvtpk(v0[0], v0[1]); w.y = cvtpk(v0[2], v0[3]); w.z = cvtpk(v1[0], v1[1]); w.w = cvtpk(v1[2], v1[3]);
                    *(GAS v4u*)(rowp + bj * 128) = w; } }
    }
};
struct EpiMoe1 {
    static constexpr bool PERM = true;
    bf16* ACT;
    __device__ __forceinline__ void operator()(const f32x4 (&acc)[2][2][4][2], const Unit& u, int wr, int wc, int fr, int fq) const {
#pragma unroll
        for (int ai = 0; ai < 2; ++ai)
#pragma unroll
            for (int m = 0; m < 4; ++m) { bf16* rowp = ACT + (size_t)(u.pm * 256 + ai * 128 + wr * 64 + m * 16 + fr) * DE + u.pn * 128 + wc * 16 + 4 * fq;
#pragma unroll
                for (int bj = 0; bj < 2; ++bj) { if (u.hb >= 0 && u.hb != bj) continue;
                    const f32x4 v0 = acc[ai][bj][m][0], v1 = acc[ai][bj][m][1];
                    u32x2v w; w.x = cvtpk(silu_f(v0[0]) * v0[1], silu_f(v0[2]) * v0[3]); w.y = cvtpk(silu_f(v1[0]) * v1[1], silu_f(v1[2]) * v1[3]);
                    *(GAS u32x2v*)(rowp + bj * 64) = w; } }
    }
};
struct EpiMoe2 {
    static constexpr bool PERM = true;
    const LAS int* cnt; const int* list; const float* wtok; bf16* YK;
    __device__ __forceinline__ void operator()(const f32x4 (&acc)[2][2][4][2], const Unit& u, int wr, int wc, int fr, int fq) const {
        const int n = cnt[u.e];
#pragma unroll
        for (int ai = 0; ai < 2; ++ai)
#pragma unroll
            for (int m = 0; m < 4; ++m) { const int slot = u.rt * 256 + ai * 128 + wr * 64 + m * 16 + fr;
                if (slot < n) { const int tk = ((const GAS int*)list)[u.e * LCAP + slot]; const float w8 = ((const GAS float*)wtok)[tk];
                    bf16* rowp = YK + (size_t)tk * DM + u.pn * 256 + wc * 32 + 8 * fq;
#pragma unroll
                    for (int bj = 0; bj < 2; ++bj) { const f32x4 v0 = acc[ai][bj][m][0] * w8, v1 = acc[ai][bj][m][1] * w8;
                        v4u w; w.x = cvtpk(v0[0], v0[1]); w.y = cvtpk(v0[2], v0[3]); w.z = cvtpk(v1[0], v1[1]); w.w = cvtpk(v1[2], v1[3]);
                        *(GAS v4u*)(rowp + bj * 128) = w; } } }
    }
};
template <int MODE> __device__ __forceinline__ int t_rowmap(int n) {
    if (MODE == 2) return 2 * n; if (MODE == 3) return 2 * n + 1;
    if (MODE == 1) { if (n >= 1536 && n < 3584) { const int q = n - 1536, d = q & 63; return 1536 + (q & ~63) + (d < 32 ? 2 * d : 2 * (d - 32) + 1); } return n; }
    return n; }
struct TrLoad { f32x4 v[16]; };
__device__ __forceinline__ void tr_load(TrLoad& t, const float* W, int ldw, int nblk  , int item, int lane) {
    const int kb = item / nblk, nb = item % nblk, k0 = 64 * kb, n0 = 64 * nb, lr = lane >> 4, lc = (lane & 15) * 4;
#pragma unroll
    for (int i = 0; i < 16; ++i) t.v[i] = *(const GAS f32x4*)(W + (size_t)(k0 + 4 * i + lr) * ldw + n0 + lc);
}
template <int MODE> __device__ __forceinline__ void tr_finish(const TrLoad& t, int nblk, bf16* WT, int dpitch, int dcol0, LAS float* scr, int item, int lane) {
    const int kb = item / nblk, nb = item % nblk, k0 = 64 * kb, n0 = 64 * nb, lr = lane >> 4, lc = (lane & 15) * 4;
#pragma unroll
    for (int i = 0; i < 16; ++i) { LAS float* d = scr + (4 * i + lr) * 65 + lc; d[0] = t.v[i][0]; d[1] = t.v[i][1]; d[2] = t.v[i][2]; d[3] = t.v[i][3]; }
    LDS_WAIT(); asm volatile("" ::: "memory");
    const int c = lane & 7;
#pragma unroll
    for (int j = 0; j < 8; ++j) { const int n = (lane >> 3) + 8 * j; const LAS float* s = scr + (8 * c) * 65 + n;
        v4u o; o.x = pk2(s[0 * 65], s[1 * 65]); o.y = pk2(s[2 * 65], s[3 * 65]); o.z = pk2(s[4 * 65], s[5 * 65]); o.w = pk2(s[6 * 65], s[7 * 65]);
        *(GAS v4u*)(WT + (size_t)t_rowmap<MODE>(n0 + n) * dpitch + dcol0 + k0 + 8 * c) = o; }
    LDS_WAIT(); asm volatile("" ::: "memory");
}
template <int MODE> __device__ __forceinline__ void transpose_item(const float* W, int ldw, int nblk, bf16* WT, int dpitch, int dcol0, LAS float* scr, int item, int lane) {
    TrLoad t; tr_load(t, W, ldw, nblk, item, lane); tr_finish<MODE>(t, nblk, WT, dpitch, dcol0, scr, item, lane);
}
__device__ __forceinline__ void convert_experts(Frame& F, int l, LAS float* scr) {
    const int gw = F.vcu * NWAVES + F.wave, NGW = F.G * NWAVES;
    bf16* WGU = (bf16*)(F.ws + WS_WGU); bf16* WD = (bf16*)(F.ws + WS_WD);
    for (int it = gw; it < NE * 768; it += NGW) { const int e = it / 768, r = it % 768;
        if (r < 256) transpose_item<2>(F.in[26] + (size_t)(l * NE + e) * DM * DE, DE, 8, WGU + (size_t)e * 1024 * DM, DM, 0, scr, r, F.lane);
        else if (r < 512) transpose_item<3>(F.in[27] + (size_t)(l * NE + e) * DM * DE, DE, 8, WGU + (size_t)e * 1024 * DM, DM, 0, scr, r - 256, F.lane);
        else transpose_item<0>(F.in[28] + (size_t)(l * NE + e) * DE * DM, DM, 32, WD + (size_t)e * DM * DE, DE, 0, scr, r - 512, F.lane); }
}
__device__ __forceinline__ void f32gemm_tile(const float* A, int lda, const float* B, int ldb, int Kd, int mb, int nb, int lane, f32x4 (&acc)[4]) {
    const int n = nb * 256 + lane * 4;
#pragma unroll
    for (int i = 0; i < 4; ++i) acc[i] = (f32x4){0.f, 0.f, 0.f, 0.f};
    const float* a0 = A + (size_t)(mb * 4) * lda;
#pragma unroll 8
    for (int k = 0; k < Kd; ++k) { const f32x4 b = *(const GAS f32x4*)(B + (size_t)k * ldb + n);
#pragma unroll
        for (int i = 0; i < 4; ++i) acc[i] += b * ((const GAS float*)a0)[(size_t)i * lda + k]; }
}

__device__ __forceinline__ void ph_prologue_a(Frame& F) {
    const int gw = F.vcu * NWAVES + F.wave, NGW = F.G * NWAVES;
    if (F.tid < 128) { float s_, c_; sincospif(2.0f * (float)F.tid / 128.0f, &s_, &c_); LAS float* cst = (LAS float*)(F.lds + LDSCTL_OFF + 2048); cst[F.tid] = c_; cst[128 + F.tid] = s_; }
    { LAS float* sil = (LAS float*)(F.lds + RING_OFF);
      for (int i = F.tid; i < 2 * DM; i += NWAVES * 64) { const float x = i < DM ? F.in[1][i] : F.in[3][i - DM]; sil[i] = silu_f(x); }
      __syncthreads();
      float* MODP = (float*)(F.ws + WS_T);
      for (int it = F.vcu; it < 64 * 12; it += F.G) { const int kc = it & 63, rest = it >> 6, l = rest / 6, jb = rest % 6, j = jb * 2048 + F.tid * 4;
          const float* W = F.in[4] + ((size_t)l * DM + kc * 32) * NMODV + j; f32x4 s0 = (f32x4){0.f, 0.f, 0.f, 0.f}, s1 = s0;
#pragma unroll 8
          for (int k = 0; k < 32; ++k) { const f32x4 w = *(const GAS f32x4*)(W + (size_t)k * NMODV); s0 += w * sil[kc * 32 + k]; s1 += w * sil[DM + kc * 32 + k]; }
          *(GAS f32x4*)(MODP + ((size_t)(kc * 2 + l) * 2 + 0) * NMODV + j) = s0; *(GAS f32x4*)(MODP + ((size_t)(kc * 2 + l) * 2 + 1) * NMODV + j) = s1; }
      __syncthreads(); }
    LAS float* scr = (LAS float*)(F.lds + RING_OFF + F.wave * 16896);
    for (int it = gw; it < 2 * 2304 + 2 * 512 + 2 * 512; it += NGW) {
        if (it < 4608) { const int l = it / 2304, r = it % 2304; transpose_item<1>(F.in[6] + (size_t)l * DM * DIN, DIN, 72, (bf16*)(F.ws + WS_WIN) + (size_t)l * DIN * DM, DM, 0, scr, r, F.lane); }
        else if (it < 5632) { const int q = it - 4608, l = q / 512, r = q % 512; transpose_item<0>(F.in[19] + (size_t)l * DM * DM + (size_t)1024 * DM, DM, 32, (bf16*)(F.ws + WS_WCAT) + (size_t)l * DM * MIXP, MIXP, 1536, scr, r, F.lane); }
        else { const int q = it - 5632, l = q / 512, r = q % 512; transpose_item<0>(F.in[19] + (size_t)l * DM * DM, DM, 32, (bf16*)(F.ws + WS_WOT) + (size_t)l * DM * 1024, 1024, 0, scr, r, F.lane); } }
    convert_experts(F, 0, scr);
    { const LAS float* cst = (const LAS float*)(F.lds + LDSCTL_OFF + 2048);
      for (int wt = gw; wt < 2 * 8 * 64; wt += NGW) { const int sel = wt >> 6, l = sel >> 3, part = (sel >> 2) & 1, g = sel & 3, r = wt & 63, mb = r >> 1, nb = r & 1;
          const float* B = F.in[8] + (size_t)l * 512 * 512 + (size_t)(128 * g) * 512; const int n = nb * 256 + F.lane * 4;
          f32x4 acc[4];
#pragma unroll
          for (int i = 0; i < 4; ++i) acc[i] = (f32x4){0.f, 0.f, 0.f, 0.f};
#pragma unroll 8
          for (int j = 0; j < 128; ++j) { const f32x4 b = *(const GAS f32x4*)(B + (size_t)j * 512 + n);
#pragma unroll
              for (int i = 0; i < 4; ++i) acc[i] += b * cst[part * 128 + (((mb * 4 + i) * j) & 127)]; }
          bf16* HB = (bf16*)(F.ws + WS_HB) + (size_t)l * 1024 * 512; const float sc = 0.08838834764831845f;
#pragma unroll
          for (int i = 0; i < 4; ++i) { u32x2v w; w.x = cvtpk(acc[i][0] * sc, acc[i][1] * sc); w.y = cvtpk(acc[i][2] * sc, acc[i][3] * sc);
              *(GAS u32x2v*)(HB + (size_t)(part * 512 + g * 128 + mb * 4 + i) * 512 + n) = w; } }
      const int gt = F.vcu * NWAVES * 64 + F.tid, NTH = F.G * NWAVES * 64;
      for (int idx = gt; idx < 2 * 512 * 512 / 4; idx += NTH) { const f32x4 v = *(const GAS f32x4*)(F.in[13] + (size_t)idx * 4);
          u32x2v w; w.x = cvtpk(v[0], v[1]); w.y = cvtpk(v[2], v[3]); *(GAS u32x2v*)((bf16*)(F.ws + WS_PWB) + (size_t)idx * 4) = w; } }
    { const int gt = F.vcu * NWAVES * 64 + F.tid, NT = F.G * NWAVES * 64;
      constexpr int R0 = 9216, R1 = R0 + 5120, R2 = R1 + 32768, R3 = R2 + 65536, R4 = R3 + 131072, R5 = R4 + 32768, R6 = R5 + 49152, R7 = R6 + 2;
      for (int idx = gt; idx < R7; idx += NT) {
          if (idx < R0) { const int l = idx / DIN, c = idx % DIN; int src = c;
              if (c >= 1536 && c < 3584) { const int q = c - 1536, p = q & 63; src = 1536 + (q & ~63) + (p & 1) * 32 + (p >> 1); }
              ((float*)(F.ws + WS_BINP))[idx] = F.in[7][l * DIN + src]; }
          else if (idx < R1) { const int q = idx - R0, t = q >> 4, i = q & 15, p = t < 256 ? t : t - 256;
              const float inv = 1.0f / powf(10000.0f, (float)i / 16.0f), ang = (float)p * inv; float s, c; sincosf(ang, &s, &c);
              ((f32x2v*)(F.ws + WS_ROPE))[q] = (f32x2v){c, s}; }
          else if (idx < R2) { const int q = idx - R1, np = q >> 7, a = q & 127, kk = np & 127; float s, c; sincospif(2.0f * (float)((a * kk) & 127) / 128.0f, &s, &c);
              ((bf16*)(F.ws + WS_BTA))[q] = bf1((np < 128 ? c : -s) * 0.08838834764831845f); }
          else if (idx < R3) { const int q = idx - R2, np = q >> 8, k = q & 255, khi = np & 127, b = k & 127; float s, c; sincospif(2.0f * (float)((b * khi) & 127) / 128.0f, &s, &c);
              const float v = np < 128 ? (k < 128 ? c : s) : (k < 128 ? -s : c); ((bf16*)(F.ws + WS_BTB))[q] = bf1(v * 0.08838834764831845f); }
          else if (idx < R4) { const int q = idx - R3, r = q >> 8, n = q & 255, k = r & 255; float s, c; sincospif(2.0f * (float)((k * n) & 255) / 256.0f, &s, &c);
              ((bf16*)(F.ws + WS_F256))[q] = bf1((r < 256 ? c : -s) * 0.0625f); }
          else if (idx < R5) { const int q = idx - R4, part = q >> 14, m = (q >> 7) & 127, j = q & 127; float s, c; sincospif(2.0f * (float)((m * j) & 127) / 128.0f, &s, &c);
              ((float*)(F.ws + WS_CS128))[q] = part ? s : c; }
          else if (idx < R6) { const int q = idx - R5, l = q / 24576, r = q % 24576, hl = r / 12288, r2 = r % 12288, ks = r2 / 192, nt = (r2 / 64) % 3, ln = r2 & 63;
              const int n = 16 * nt + (ln & 15), k0 = 32 * ks + 8 * (ln >> 4); unsigned short o[8];
#pragma unroll
              for (int j = 0; j < 8; ++j) { const int k = k0 + j; float w = 0.f;
                  if (n < 4) w = F.in[22][((size_t)l * DM + k) * 4 + n]; else if (n < 36) w = F.in[24][((size_t)l * DM + k) * 32 + (n - 4)];
                  const unsigned short h = bf1(w); o[j] = hl ? bf1(w - bf2f(h)) : h; }
              v4u w4; w4.x = o[0] | ((unsigned)o[1] << 16); w4.y = o[2] | ((unsigned)o[3] << 16); w4.z = o[4] | ((unsigned)o[5] << 16); w4.w = o[6] | ((unsigned)o[7] << 16);
              ((v4u*)(F.ws + WS_WRT))[q] = w4; }
          else { const int l = idx - R6; float a = 0.f, b = 0.f;
              for (int i = 0; i < 64; ++i) { a += F.in[14][l * 64 + i] * F.in[15][l * 64 + i]; b += F.in[16][l * 64 + i] * F.in[17][l * 64 + i]; }
              const float lam_init = 0.8f - 0.6f * expf(-0.3f * (float)l);
              ((float*)(F.ws + WS_LAMV))[l] = expf(a) - expf(b) + lam_init; }
      } }
}
__device__ __forceinline__ void ph_prologue_b(Frame& F) {
    const int gw = F.vcu * NWAVES + F.wave, NGW = F.G * NWAVES;
    { const int gt = F.vcu * NWAVES * 64 + F.tid, NT = F.G * NWAVES * 64; const float* MODP = (const float*)(F.ws + WS_T); float* MOD = (float*)(F.ws + WS_MOD);
      for (int idx = gt; idx < 4 * NMODV; idx += NT) { const int lv = idx / NMODV, j = idx % NMODV, l = lv >> 1; float s = F.in[5][l * NMODV + j];
          for (int kc = 0; kc < 64; ++kc) s += MODP[((size_t)kc * 4 + lv) * NMODV + j];
          MOD[idx] = s; } }
#pragma unroll 1
    for (int l = 0; l < DEPTH; ++l) {
        { pg8::Gemm g{(const bf16*)(F.ws + WS_WOT) + (size_t)l * DM * 1024, (const bf16*)(F.ws + WS_HB) + (size_t)l * 1024 * 512, 512, 1024};
          SchedNat S; S.go.init(8, 4, F.G, (int)((blockIdx.x + F.G - 48 * l) % F.G)); S.pmoff = 0; EpiFold E{(bf16*)(F.ws + WS_WCAT) + (size_t)l * DM * MIXP, 0};
          pg8::gemm_phase<EpiFold, SchedNat>(F.lds + RING_OFF, g, S, E); }
        { pg8::Gemm g{(const bf16*)(F.ws + WS_WOT) + (size_t)l * DM * 1024 + 512, (const bf16*)(F.ws + WS_PWB) + (size_t)l * 512 * 512, 512, 1024};
          SchedNat S; S.go.init(8, 2, F.G, (int)((blockIdx.x + F.G - 48 * l - 32) % F.G)); S.pmoff = 0; EpiFold E{(bf16*)(F.ws + WS_WCAT) + (size_t)l * DM * MIXP, 1024};
          pg8::gemm_phase<EpiFold, SchedNat>(F.lds + RING_OFF, g, S, E); } }
}

struct RowV { f32x4 v[8]; };
__device__ __forceinline__ void row_load(RowV& r, const float* p, int lane) {
#pragma unroll
    for (int j = 0; j < 4; ++j) { r.v[2 * j] = *(const GAS f32x4*)(p + 512 * j + 8 * lane); r.v[2 * j + 1] = *(const GAS f32x4*)(p + 512 * j + 8 * lane + 4); } }
__device__ __forceinline__ void row_load_bf16(RowV& r, const bf16* p, int lane) {
#pragma unroll
    for (int j = 0; j < 4; ++j) { const v4u d = *(const GAS v4u*)(p + 512 * j + 8 * lane);
        r.v[2 * j] = (f32x4){__uint_as_float(d.x << 16), __uint_as_float(d.x & 0xffff0000u), __uint_as_float(d.y << 16), __uint_as_float(d.y & 0xffff0000u)};
        r.v[2 * j + 1] = (f32x4){__uint_as_float(d.z << 16), __uint_as_float(d.z & 0xffff0000u), __uint_as_float(d.w << 16), __uint_as_float(d.w & 0xffff0000u)}; } }
__device__ __forceinline__ void row_store(const RowV& r, float* p, int lane) {
#pragma unroll
    for (int j = 0; j < 4; ++j) { *(GAS f32x4*)(p + 512 * j + 8 * lane) = r.v[2 * j]; *(GAS f32x4*)(p + 512 * j + 8 * lane + 4) = r.v[2 * j + 1]; } }
__device__ __forceinline__ void row_norm(RowV& r) {
    float s = 0.f;
#pragma unroll
    for (int i = 0; i < 8; ++i) s += (r.v[i][0] + r.v[i][1]) + (r.v[i][2] + r.v[i][3]);
    const float mean = wave_sum(s) * (1.f / DM); float q = 0.f;
#pragma unroll
    for (int i = 0; i < 8; ++i) { r.v[i] = r.v[i] - mean; q += (r.v[i][0] * r.v[i][0] + r.v[i][1] * r.v[i][1]) + (r.v[i][2] * r.v[i][2] + r.v[i][3] * r.v[i][3]); }
    const float rstd = 1.f / sqrtf(wave_sum(q) * (1.f / DM) + LN_EPS);
#pragma unroll
    for (int i = 0; i < 8; ++i) r.v[i] = r.v[i] * rstd; }
__device__ __forceinline__ void row_affine(RowV& r, const float* mulp, float madd, const float* addp, int lane) {
#pragma unroll
    for (int j = 0; j < 4; ++j)
#pragma unroll
        for (int h = 0; h < 2; ++h) { const f32x4 m = *(const GAS f32x4*)(mulp + 512 * j + 8 * lane + 4 * h), a = *(const GAS f32x4*)(addp + 512 * j + 8 * lane + 4 * h);
            r.v[2 * j + h] = r.v[2 * j + h] * (m + madd) + a; } }
__device__ __forceinline__ void row_store_bf16(const RowV& r, bf16* p, int lane) {
#pragma unroll
    for (int j = 0; j < 4; ++j) { v4u w; w.x = cvtpk(r.v[2 * j][0], r.v[2 * j][1]); w.y = cvtpk(r.v[2 * j][2], r.v[2 * j][3]); w.z = cvtpk(r.v[2 * j + 1][0], r.v[2 * j + 1][1]); w.w = cvtpk(r.v[2 * j + 1][2], r.v[2 * j + 1][3]);
        *(GAS v4u*)(p + 512 * j + 8 * lane) = w; } }

__device__ __forceinline__ void ph_ln1(Frame& F, int l, const float* xc, const float* xl) {
    const int gw = F.vcu * NWAVES + F.wave, NGW = F.G * NWAVES; const float* MOD = (const float*)(F.ws + WS_MOD) + (size_t)l * 2 * NMODV; bf16* XN = (bf16*)(F.ws + WS_XN);
    for (int r = gw; r < ROWS; r += NGW) { const float* xp = r < CTXL ? xc + (size_t)r * DM : xl + (size_t)(r - CTXL) * DM; const float* mp = MOD + (r < CTXL ? NMODV : 0);
        RowV v; row_load(v, xp, F.lane); row_norm(v); row_affine(v, mp + DM, 1.f, mp, F.lane); row_store_bf16(v, XN + (size_t)r * DM, F.lane); }
}

__device__ __forceinline__ void conv_unit(Frame& F, int l, int ub) {
    const int row0 = 32 * ub, lo = row0 < CTXL ? 0 : CTXL, hi = row0 < CTXL ? CTXL : ROWS;
    const bf16* AG = (const bf16*)(F.ws + WS_AG); bf16* MIX = (bf16*)(F.ws + WS_MIX);
    LAS bf16* U = (LAS bf16*)(F.lds + RING_OFF);
    LAS float* Y = (LAS float*)(F.lds + RING_OFF + 65536);
    for (int it = F.tid; it < 62 * 64; it += NWAVES * 64) { const int t = it >> 6, c8 = (it & 63) * 8, gr = row0 - 15 + t;
        v4u o = (v4u){0u, 0u, 0u, 0u};
        if (gr >= lo && gr < hi) { const v4u a = *(const GAS v4u*)(AG + (size_t)gr * 1024 + c8), g = *(const GAS v4u*)(AG + (size_t)gr * 1024 + 512 + c8);
            const unsigned aw[4] = {a.x, a.y, a.z, a.w}, gw[4] = {g.x, g.y, g.z, g.w}; unsigned ow[4];
#pragma unroll
            for (int q = 0; q < 4; ++q) { const float a0 = __uint_as_float(aw[q] << 16), a1 = __uint_as_float(aw[q] & 0xffff0000u), g0 = __uint_as_float(gw[q] << 16), g1 = __uint_as_float(gw[q] & 0xffff0000u);
                ow[q] = cvtpk(a0 / (1.f + __expf(-g0)), a1 / (1.f + __expf(-g1))); }
            o = (v4u){ow[0], ow[1], ow[2], ow[3]}; }
        *(LAS v4u*)(U + t * 512 + c8) = o; }
    __syncthreads();
    { const int c = F.tid; float w[31];
#pragma unroll
      for (int j = 0; j < 31; ++j) w[j] = ((const GAS float*)F.in[9])[((size_t)l * 31 + j) * 512 + c];
      const float cb = F.in[10][l * 512 + c];
#pragma unroll
      for (int half = 0; half < 2; ++half) { float u[46];
#pragma unroll
          for (int t = 0; t < 46; ++t) u[t] = bf2f(U[(half * 16 + t) * 512 + c]);
#pragma unroll
          for (int n = 0; n < 16; ++n) { float s = cb;
#pragma unroll
              for (int j = 0; j < 31; ++j) s += u[n + j] * w[j];
              Y[(half * 16 + n) * 512 + c] = s; } } }
    __syncthreads();
    { const float* lg = F.in[11] + l * 512 + 8 * F.lane; const float* lb = F.in[12] + l * 512 + 8 * F.lane;
      const f32x4 g0 = *(const f32x4*)lg, g1 = *(const GAS f32x4*)(lg + 4), b0 = *(const f32x4*)lb, b1 = *(const GAS f32x4*)(lb + 4);
#pragma unroll
      for (int i = 0; i < 4; ++i) { const int n = 4 * F.wave + i; f32x4 y0 = *(LAS f32x4*)(Y + n * 512 + 8 * F.lane), y1 = *(LAS f32x4*)(Y + n * 512 + 8 * F.lane + 4);
          const float mean = wave_sum((y0[0] + y0[1]) + (y0[2] + y0[3]) + (y1[0] + y1[1]) + (y1[2] + y1[3])) * (1.f / 512.f);
          y0 = y0 - mean; y1 = y1 - mean;
          const float var = wave_sum((y0[0] * y0[0] + y0[1] * y0[1]) + (y0[2] * y0[2] + y0[3] * y0[3]) + (y1[0] * y1[0] + y1[1] * y1[1]) + (y1[2] * y1[2] + y1[3] * y1[3])) * (1.f / 512.f);
          const float rstd = 1.f / sqrtf(var + LN_EPS);
          y0 = y0 * rstd * g0 + b0; y1 = y1 * rstd * g1 + b1;
          v4u w4; w4.x = cvtpk(silu_f(y0[0]), silu_f(y0[1])); w4.y = cvtpk(silu_f(y0[2]), silu_f(y0[3])); w4.z = cvtpk(silu_f(y1[0]), silu_f(y1[1])); w4.w = cvtpk(silu_f(y1[2]), silu_f(y1[3]));
          *(GAS v4u*)(MIX + (size_t)(row0 + n) * MIXP + 1024 + 8 * F.lane) = w4; } }
    __syncthreads();
}
constexpr int HP = DM + 8;
template <bool XBF> __device__ __forceinline__ void ph_ln_router(Frame& F, int l, const void* xcv, const void* xlv) {
    const float* MOD = (const float*)(F.ws + WS_MOD) + (size_t)l * 2 * NMODV; bf16* T = (bf16*)(F.ws + WS_T); bf16* XN = (bf16*)(F.ws + WS_XN); const bf16* DMX = (const bf16*)(F.ws + WS_DMIX);
    const float* ga = F.in[20] + (size_t)l * DM; const float* ba = F.in[21] + (size_t)l * DM;
    const v4u* WRT = (const v4u*)(F.ws + WS_WRT) + (size_t)l * 24576;
    int* LIST = (int*)(F.ws + WS_LIST) + (size_t)l * NE * LCAP; float* WTOK = (float*)(F.ws + WS_WTOK) + (size_t)l * 2 * ROWS;
    LAS bf16* HHI = (LAS bf16*)(F.lds + RING_OFF); LAS bf16* HLO = HHI + 16 * HP;
    LAS float* PART = (LAS float*)(F.lds + RING_OFF);
    LAS float* LOGI = (LAS float*)(F.lds + RING_OFF + 32768);
    const int fr = F.lane & 15, fq = F.lane >> 4;
    const int blk0 = (l + 1 < DEPTH) ? 0 : CTXL / 16;
    for (int blk = blk0 + F.vcu; blk < ROWS / 16; blk += F.G) {
        RowV vv[2];
#pragma unroll
        for (int i = 0; i < 2; ++i) { const int r = blk * 16 + 2 * F.wave + i;
            if (XBF) row_load_bf16(vv[i], r < CTXL ? (const bf16*)xcv + (size_t)r * DM : (const bf16*)xlv + (size_t)(r - CTXL) * DM, F.lane);
            else row_load(vv[i], r < CTXL ? (const float*)xcv + (size_t)r * DM : (const float*)xlv + (size_t)(r - CTXL) * DM, F.lane);
#pragma unroll
            for (int j = 0; j < 4; ++j) { const v4u d = *(const GAS v4u*)(DMX + (size_t)r * DM + 512 * j + 8 * F.lane);
                vv[i].v[2 * j] = vv[i].v[2 * j] * ALPHA + (f32x4){__uint_as_float(d.x << 16), __uint_as_float(d.x & 0xffff0000u), __uint_as_float(d.y << 16), __uint_as_float(d.y & 0xffff0000u)};
                vv[i].v[2 * j + 1] = vv[i].v[2 * j + 1] * ALPHA + (f32x4){__uint_as_float(d.z << 16), __uint_as_float(d.z & 0xffff0000u), __uint_as_float(d.w << 16), __uint_as_float(d.w & 0xffff0000u)}; } }
#pragma unroll
        for (int i = 0; i < 2; ++i) { const int rl = 2 * F.wave + i, r = blk * 16 + rl; const float* mp = MOD + (r < CTXL ? NMODV : 0);
            RowV& v = vv[i]; row_norm(v); row_affine(v, ga, 0.f, ba, F.lane); row_store_bf16(v, T + (size_t)r * DM, F.lane);
            row_norm(v); row_affine(v, mp + 4 * DM, 1.f, mp + 3 * DM, F.lane);
#pragma unroll
            for (int j = 0; j < 4; ++j) { unsigned hw[4], lw[4];
#pragma unroll
                for (int q = 0; q < 4; ++q) { const float a = v.v[2 * j + (q >> 1)][(q & 1) * 2], b = v.v[2 * j + (q >> 1)][(q & 1) * 2 + 1];
                    const unsigned h = cvtpk(a, b); hw[q] = h; lw[q] = cvtpk(a - __uint_as_float(h << 16), b - __uint_as_float(h & 0xffff0000u)); }
                const v4u h4 = (v4u){hw[0], hw[1], hw[2], hw[3]}, l4 = (v4u){lw[0], lw[1], lw[2], lw[3]};
                *(GAS v4u*)(XN + (size_t)r * DM + 512 * j + 8 * F.lane) = h4;
                *(LAS v4u*)(HHI + rl * HP + 512 * j + 8 * F.lane) = h4; *(LAS v4u*)(HLO + rl * HP + 512 * j + 8 * F.lane) = l4; } }
        __syncthreads();
        f32x4 acc[3];
#pragma unroll
        for (int n = 0; n < 3; ++n) acc[n] = (f32x4){0.f, 0.f, 0.f, 0.f};
#pragma unroll 2
        for (int s = 0; s < 8; ++s) { const int ks = 8 * F.wave + s;
            const bf16x8 xh = *(const LAS bf16x8*)(HHI + fr * HP + ks * 32 + fq * 8), xl = *(const LAS bf16x8*)(HLO + fr * HP + ks * 32 + fq * 8);
#pragma unroll
            for (int n = 0; n < 3; ++n) { const v4u wh4 = ((const GAS v4u*)WRT)[((size_t)(0 * 64 + ks) * 3 + n) * 64 + F.lane], wl4 = ((const GAS v4u*)WRT)[((size_t)(1 * 64 + ks) * 3 + n) * 64 + F.lane];
                const bf16x8 wh = __builtin_bit_cast(bf16x8, wh4), wl = __builtin_bit_cast(bf16x8, wl4);
                acc[n] = __builtin_amdgcn_mfma_f32_16x16x32_bf16(wh, xh, acc[n], 0, 0, 0);
                acc[n] = __builtin_amdgcn_mfma_f32_16x16x32_bf16(wh, xl, acc[n], 0, 0, 0);
                acc[n] = __builtin_amdgcn_mfma_f32_16x16x32_bf16(wl, xh, acc[n], 0, 0, 0); } }
        __syncthreads();
#pragma unroll
        for (int n = 0; n < 3; ++n)
#pragma unroll
            for (int i = 0; i < 4; ++i) PART[(F.wave * 16 + fr) * 48 + 16 * n + 4 * fq + i] = acc[n][i];
        __syncthreads();
        for (int t = F.tid; t < 16 * 36; t += NWAVES * 64) { const int m = t / 36, n = t % 36; float s = n < 4 ? F.in[23][l * 4 + n] : F.in[25][l * 32 + (n - 4)];
#pragma unroll
            for (int w = 0; w < 8; ++w) s += PART[(w * 16 + m) * 48 + n];
            LOGI[m * 36 + n] = s; }
        __syncthreads();
        if (F.tid < 16) { const int r = blk * 16 + F.tid; const LAS float* lg = LOGI + F.tid * 36;
            int gi = 0; float gm = lg[0];
#pragma unroll
            for (int j = 1; j < 4; ++j) if (lg[j] > gm) { gm = lg[j]; gi = j; }
            float gs = 0.f;
#pragma unroll
            for (int j = 0; j < 4; ++j) gs += __expf(lg[j] - gm);
            const float wg = 1.f / gs;
            const LAS float* le = lg + 4 + gi * 8; int i1 = 0; float m1 = le[0];
#pragma unroll
            for (int j = 1; j < 8; ++j) if (le[j] > m1) { m1 = le[j]; i1 = j; }
            int i2 = -1; float m2 = -3.0e38f;
#pragma unroll
            for (int j = 0; j < 8; ++j) if (j != i1 && le[j] > m2) { m2 = le[j]; i2 = j; }
            const float e2 = __expf(m2 - m1), w1 = wg / (1.f + e2), w2 = wg * e2 / (1.f + e2);
            const int ea = gi * 8 + i1, eb = gi * 8 + i2;
            const int sa = (int)__hip_atomic_fetch_add(F.ctl + CW_CNT + (l * NE + ea) * 64, 1u, RLX_AGENT), sb = (int)__hip_atomic_fetch_add(F.ctl + CW_CNT + (l * NE + eb) * 64, 1u, RLX_AGENT);
            ((GAS int*)LIST)[ea * LCAP + sa] = r * 2; ((GAS int*)LIST)[eb * LCAP + sb] = r * 2 + 1; ((GAS float*)WTOK)[r * 2] = w1; ((GAS float*)WTOK)[r * 2 + 1] = w2; }
        __syncthreads();
    }
}
__device__ __forceinline__ void moe_setup(Frame& F, int l, LAS int* tstart, LAS int* cnt) {
    if (F.tid < NE) cnt[F.tid] = (int)__hip_atomic_load(F.ctl + CW_CNT + (l * NE + F.tid) * 64, RLX_AGENT);
    __syncthreads();
    if (F.tid == 0) { int s = 0; for (int e = 0; e < NE; ++e) { tstart[e] = s; s += (cnt[e] + 255) >> 8; } tstart[NE] = s; }
    __syncthreads();
}
template <bool FUSE_NEXT> __device__ __forceinline__ void ph_ln_final(Frame& F, int l, void* outcv, void* outlv) {
    const int gw = F.vcu * NWAVES + F.wave, NGW = F.G * NWAVES;
    const float* MOD = (const float*)(F.ws + WS_MOD) + (size_t)l * 2 * NMODV; const bf16* X1 = (const bf16*)(F.ws + WS_T); const bf16* YK = (const bf16*)(F.ws + WS_YK);
    const float* gf = F.in[29] + (size_t)l * DM; const float* bfp = F.in[30] + (size_t)l * DM;
    for (int r = gw; r < ROWS; r += NGW) { if (r < CTXL && outcv == nullptr) continue;
        const float* mp = MOD + (r < CTXL ? NMODV : 0) + 5 * DM;
        RowV v; row_load_bf16(v, X1 + (size_t)r * DM, F.lane);
#pragma unroll
        for (int j = 0; j < 4; ++j) { const v4u a = *(const GAS v4u*)(YK + (size_t)(2 * r) * DM + 512 * j + 8 * F.lane), b = *(const GAS v4u*)(YK + (size_t)(2 * r + 1) * DM + 512 * j + 8 * F.lane);
            const f32x4 g0 = *(const GAS f32x4*)(mp + 512 * j + 8 * F.lane), g1 = *(const GAS f32x4*)(mp + 512 * j + 8 * F.lane + 4);
            const f32x4 y0 = (f32x4){__uint_as_float(a.x << 16) + __uint_as_float(b.x << 16), __uint_as_float(a.x & 0xffff0000u) + __uint_as_float(b.x & 0xffff0000u),
                                     __uint_as_float(a.y << 16) + __uint_as_float(b.y << 16), __uint_as_float(a.y & 0xffff0000u) + __uint_as_float(b.y & 0xffff0000u)};
            const f32x4 y1 = (f32x4){__uint_as_float(a.z << 16) + __uint_as_float(b.z << 16), __uint_as_float(a.z & 0xffff0000u) + __uint_as_float(b.z & 0xffff0000u),
                                     __uint_as_float(a.w << 16) + __uint_as_float(b.w << 16), __uint_as_float(a.w & 0xffff0000u) + __uint_as_float(b.w & 0xffff0000u)};
            v.v[2 * j] = v.v[2 * j] * ALPHA + g0 * y0; v.v[2 * j + 1] = v.v[2 * j + 1] * ALPHA + g1 * y1; }
        row_norm(v); row_affine(v, gf, 0.f, bfp, F.lane);
#ifdef TPROBE
        if (!FUSE_NEXT) { const float tsc_ = 1.f + *(const volatile float*)&g_tprobe;
#pragma unroll
            for (int q = 0; q < 8; ++q) v.v[q] = v.v[q] * tsc_; }
#endif
        if (FUSE_NEXT) row_store_bf16(v, r < CTXL ? (bf16*)outcv + (size_t)r * DM : (bf16*)outlv + (size_t)(r - CTXL) * DM, F.lane);
        else row_store(v, r < CTXL ? (float*)outcv + (size_t)r * DM : (float*)outlv + (size_t)(r - CTXL) * DM, F.lane);
        if (FUSE_NEXT) { const float* mn = (const float*)(F.ws + WS_MOD) + (size_t)(l + 1) * 2 * NMODV + (r < CTXL ? NMODV : 0);
            row_norm(v); row_affine(v, mn + DM, 1.f, mn, F.lane); row_store_bf16(v, (bf16*)(F.ws + WS_XN) + (size_t)r * DM, F.lane); } }
}

#ifndef MK_ONE_LAUNCH
#define MK_ONE_LAUNCH 0
#endif
struct Args { const float* in[NIN]; float* out; unsigned char* ws; int ph_lo, ph_hi, pad0, pad1; };
__global__ void __launch_bounds__(NWAVES * 64, 2) mk_fwd(Args args) {
    extern __shared__ __attribute__((aligned(16))) unsigned char lds[];
    Frame F;
    F.lds = (LAS unsigned char*)lds;
    F.MISC = (volatile LAS unsigned*)(F.lds + MISC_OFF);
    F.tid = threadIdx.x; F.lane = F.tid & 63; F.wave = __builtin_amdgcn_readfirstlane(F.tid >> 6);
    F.G = gridDim.x; { const int bx = blockIdx.x; F.vcu = (F.G % 8 == 0) ? (bx % 8) * (F.G / 8) + bx / 8 : bx; }
    F.ws = args.ws; F.out = args.out; F.ctl = (gu32*)(args.ws + WS_CTL);
    F.in = args.in;
    for (int u = F.tid; u < (LDS_BYTES - LDSCTL_OFF) / 4; u += NWAVES * 64) ((LAS unsigned*)(F.lds + LDSCTL_OFF))[u] = 0u;
    __syncthreads();
#if MK_ONE_LAUNCH
    XcdBarrier bar = xcd_barrier_post((unsigned*)(F.ctl + CW_BAR), F.MISC + 8);
#define GRID_BAR() xcd_barrier(bar)
#else
#define GRID_BAR() do { } while (0)
#endif
    const int lo = args.ph_lo, hi = args.ph_hi;
#ifdef ONLY_REL
#define IN(k) (lo <= (k) && (k) < hi && ((k) < 2 ? (k) == ONLY_REL - 100 : ((k) - 2) % 9 == ONLY_REL))
#else
#define IN(k) (lo <= (k) && (k) < hi)
#endif
#ifndef REPEAT_REL
#define REPEAT_REL -1
#endif
#ifndef REPEAT_N
#define REPEAT_N 2
#endif
#ifndef REPEAT_MASK
#define REPEAT_MASK 0
#endif
#define REP(r) for (int rep_ = 0; rep_ < (((r) == REPEAT_REL || ((r) < 32 && ((REPEAT_MASK >> (r)) & 1))) ? REPEAT_N : 1); ++rep_)
#ifdef PROBE_PHASE
#ifndef PROBE_MULT
#define PROBE_MULT 3
#endif
    unsigned long long tprev_ = __builtin_amdgcn_s_memrealtime();
#define SEAM(k) do { if (IN(k) && IN((k) + 1)) { GRID_BAR(); const unsigned long long tn_ = __builtin_amdgcn_s_memrealtime(); \
        if ((k) == PROBE_PHASE) { const unsigned long long until_ = tn_ + PROBE_MULT * (tn_ - tprev_); while (__builtin_amdgcn_s_memrealtime() < until_) __builtin_amdgcn_s_sleep(8); } \
        tprev_ = __builtin_amdgcn_s_memrealtime(); } } while (0)
#else
#define SEAM(k) do { if (IN(k) && IN((k) + 1)) GRID_BAR(); } while (0)
#endif
#define PHASE_BEGIN() do { unsigned char* w_ = args.ws; float* o_ = args.out; asm volatile("" : "+s"(w_), "+s"(o_)); F.ws = w_; F.out = o_; F.ctl = (gu32*)(w_ + WS_CTL); \
        int t_ = threadIdx.x; asm volatile("" : "+v"(t_)); F.tid = t_; F.lane = t_ & 63; F.wave = __builtin_amdgcn_readfirstlane(t_ >> 6); } while (0)
    LAS int* tstart = (LAS int*)(F.lds + LDSCTL_OFF); LAS int* ecnt = (LAS int*)(F.lds + LDSCTL_OFF + 136);
    char* ldsg = (char*)lds + RING_OFF;

    if (IN(0)) REP(100) { PHASE_BEGIN(); ph_prologue_a(F); } SEAM(0);
    if (IN(1)) REP(101) { PHASE_BEGIN(); ph_prologue_b(F); } SEAM(1);
#pragma unroll 1
    for (int l = 0; l < DEPTH; ++l) {
        const int P = 2 + 9 * l;
        const float* xc = F.in[2]; const float* xl = F.in[0];
        const float* MODL = (const float*)(F.ws + WS_MOD) + (size_t)l * 2 * NMODV;
        if (l == 0) { if (IN(P + 0)) REP(0) { PHASE_BEGIN(); ph_ln1(F, l, xc, xl); } SEAM(P + 0); }
        if (IN(P + 1)) REP(1) { PHASE_BEGIN();
            pg8::Gemm g{(const bf16*)(F.ws + WS_XN), (const bf16*)(F.ws + WS_WIN) + (size_t)l * DIN * DM, DM, DM};
            SchedWin S; S.go.init(NMT, DIN / 256, F.G, (int)blockIdx.x);
            EpiWin E{(bf16*)(F.ws + WS_UF), (bf16*)(F.ws + WS_UFC), (bf16*)(F.ws + WS_AG), (bf16*)(F.ws + WS_Q), (bf16*)(F.ws + WS_K), (bf16*)(F.ws + WS_V),
                     (const float*)(F.ws + WS_BINP) + l * DIN, (const f32x2v*)(F.ws + WS_ROPE)};
            pg8::gemm_phase<EpiWin, SchedWin>(F.lds + RING_OFF, g, S, E);
        } SEAM(P + 1);
        if (IN(P + 2)) REP(2) { PHASE_BEGIN();
            attn::Tensors AT{(const bf16*)(F.ws + WS_Q), (const bf16*)(F.ws + WS_K), (const bf16*)(F.ws + WS_V), (bf16*)(F.ws + WS_MIX),
                             (float*)(F.ws + WS_O2N) + (size_t)blockIdx.x * 64 * 512, F.in[18] + l * 128, ((const float*)(F.ws + WS_LAMV))[l], 1.f - (0.8f - 0.6f * expf(-0.3f * (float)l))};
#ifndef NO_ATT
#ifndef REPEAT_ATT_N
#define REPEAT_ATT_N 1
#endif
            for (int u = F.vcu; u < 512 * REPEAT_ATT_N; u += F.G) attn::attn_unit<true>((u & 511) >> 6, 256 * (1 + (u & 63)), ROWS / 64, AT, ldsg);
            for (int u = F.vcu; u < 8; u += F.G) attn::attn_unit<false>(u, 0, CTXL / 64, AT, ldsg);
#endif
#ifndef NO_FA
            { pg8::Gemm g{(const bf16*)(F.ws + WS_UF), (const bf16*)(F.ws + WS_BTA), 128, 128};
#ifndef REPEAT_FA_N
#define REPEAT_FA_N 1
#endif
              SchedFA S; S.go.init(256 * REPEAT_FA_N, 1, F.G, (int)blockIdx.x); EpiFA E{(bf16*)(F.ws + WS_PF2)};
#ifndef REPEAT_FA_N
#define REPEAT_FA_N 1
#endif
              pg8::gemm_phase<EpiFA, SchedFA>(F.lds + RING_OFF, g, S, E); }
#endif
#ifndef NO_CTXF
            { pg8::Gemm g{(const bf16*)(F.ws + WS_F256), (const bf16*)(F.ws + WS_UFC), 256, 256};
              SchedNat S; S.go.init(2, 2, F.G, (int)((blockIdx.x + 128) % F.G)); S.pmoff = 0; EpiCtxF E{(bf16*)(F.ws + WS_MIX)};
              pg8::gemm_phase<EpiCtxF, SchedNat>(F.lds + RING_OFF, g, S, E); }
#endif
#ifndef NO_CONV
            { volatile LAS int* qslot = (volatile LAS int*)(F.lds + LDSCTL_OFF + 3072);
              for (;;) { __syncthreads(); if (F.tid == 0) *qslot = (int)__hip_atomic_fetch_add(F.ctl + CW_CONVQ + l * 64, 1u, RLX_AGENT);
                  __syncthreads(); const int u = *qslot; if (u >= ROWS / 32) break; conv_unit(F, l, u); } }
#endif
        } SEAM(P + 2);
        if (IN(P + 3)) REP(3) { PHASE_BEGIN();
            pg8::Gemm g{(const bf16*)(F.ws + WS_PF2), (const bf16*)(F.ws + WS_BTB), 256, 256};
            SchedFB S; S.go.init(256, 1, F.G, (int)blockIdx.x); EpiFB E{(bf16*)(F.ws + WS_MIX)};
            pg8::gemm_phase<EpiFB, SchedFB>(F.lds + RING_OFF, g, S, E);
            if (l + 1 < DEPTH) {
                pg8::Gemm g2{(const bf16*)(F.ws + WS_MIX), (const bf16*)(F.ws + WS_WCAT) + (size_t)l * DM * MIXP, MIXP, MIXP};
                SchedNatHalf S2; S2.go.init(1, 2 * (DM / 256), F.G, (int)((blockIdx.x + 96) % F.G)); EpiWout E2{MODL, (bf16*)(F.ws + WS_DMIX)};
                pg8::gemm_phase<EpiWout, SchedNatHalf>(F.lds + RING_OFF, g2, S2, E2); }
        } SEAM(P + 3);
        if (IN(P + 4)) REP(4) { PHASE_BEGIN();
            pg8::Gemm g{(const bf16*)(F.ws + WS_MIX), (const bf16*)(F.ws + WS_WCAT) + (size_t)l * DM * MIXP, MIXP, MIXP};
            SchedNat S; S.go.init(NMT - 1, DM / 256, F.G, (int)blockIdx.x); S.pmoff = 1; EpiWout E{MODL, (bf16*)(F.ws + WS_DMIX)};
            pg8::gemm_phase<EpiWout, SchedNat>(F.lds + RING_OFF, g, S, E);
        } SEAM(P + 4);
        if (IN(P + 5)) REP(5) { PHASE_BEGIN(); if (l == 0) ph_ln_router<false>(F, l, xc, xl); else ph_ln_router<true>(F, l, F.ws + WS_X2, (bf16*)(F.ws + WS_X2) + (size_t)CTXL * DM); } SEAM(P + 5);
        if (IN(P + 6)) REP(6) { PHASE_BEGIN();
            moe_setup(F, l, tstart, ecnt);
            pg8::Gemm g{(const bf16*)(F.ws + WS_XN), (const bf16*)(F.ws + WS_WGU), DM, DM};
            SchedMoe<1> S{tstart, ecnt, (const int*)(F.ws + WS_LIST) + (size_t)l * NE * LCAP, F.G, (int)F.vcu}; EpiMoe1 E{(bf16*)(F.ws + WS_ACT)};
            pg8::gemm_phase<EpiMoe1, SchedMoe<1>>(F.lds + RING_OFF, g, S, E);
        } SEAM(P + 6);
        if (IN(P + 7)) REP(7) { PHASE_BEGIN();
            moe_setup(F, l, tstart, ecnt);
            pg8::Gemm g{(const bf16*)(F.ws + WS_ACT), (const bf16*)(F.ws + WS_WD), DE, DE};
            SchedMoe<2> S{tstart, ecnt, (const int*)(F.ws + WS_LIST) + (size_t)l * NE * LCAP, F.G, (int)F.vcu};
            EpiMoe2 E{ecnt, (const int*)(F.ws + WS_LIST) + (size_t)l * NE * LCAP, (const float*)(F.ws + WS_WTOK) + (size_t)l * 2 * ROWS, (bf16*)(F.ws + WS_YK)};
            pg8::gemm_phase<EpiMoe2, SchedMoe<2>>(F.lds + RING_OFF, g, S, E);
        } SEAM(P + 7);
        if (IN(P + 8)) REP(8) { PHASE_BEGIN();
            if (l == 0) { ph_ln_final<true>(F, l, F.ws + WS_X2, (bf16*)(F.ws + WS_X2) + (size_t)CTXL * DM);
                          convert_experts(F, 1, (LAS float*)(F.lds + RING_OFF + F.wave * 16896)); }
            else ph_ln_final<false>(F, l, nullptr, F.out);
        }
        if (l + 1 < DEPTH) SEAM(P + 8);
    }
#undef IN
#undef SEAM
}

extern "C" void kernel_launch(void* const* d_in, const int* in_sizes, int n_in, void* d_out, int out_size, void* d_ws, size_t ws_size, hipStream_t stream) {
    static int grid = 0;
    if (grid == 0) {
        if (n_in != NIN || in_sizes[0] != SEQ * DM || out_size != SEQ * DM || ws_size < WS_END) { fprintf(stderr, "kernel_launch: shape mismatch (n_in %d, in0 %d, out %d, ws %zu < %zu?)\n", n_in, n_in > 0 ? in_sizes[0] : -1, out_size, ws_size, (size_t)WS_END); grid = -1; return; }
        int dev = 0, cus = 0, per_cu = 0;
        if (hipGetDevice(&dev) != hipSuccess || hipDeviceGetAttribute(&cus, hipDeviceAttributeMultiprocessorCount, dev) != hipSuccess) { grid = -1; return; }
        if (hipFuncSetAttribute((const void*)mk_fwd, hipFuncAttributeMaxDynamicSharedMemorySize, LDS_BYTES) != hipSuccess) { fprintf(stderr, "kernel_launch: hipFuncSetAttribute failed\n"); grid = -1; return; }
        if (hipOccupancyMaxActiveBlocksPerMultiprocessor(&per_cu, (const void*)mk_fwd, NWAVES * 64, LDS_BYTES) != hipSuccess || per_cu < 1)
            fprintf(stderr, "kernel_launch: note: occupancy query reports %d workgroups per CU\n", per_cu);
        (void)hipGetLastError();
        grid = cus;
        if (grid > 256) grid = 256;
    }
    if (grid < 0) return;
    if (hipMemsetAsync((char*)d_ws + WS_CTL, 0, CTL_ZERO_BYTES, stream) != hipSuccess) { fprintf(stderr, "kernel_launch: memset failed\n"); return; }
    Args a{};
    for (int i = 0; i < NIN; ++i) a.in[i] = (const float*)d_in[i];
    a.out = (float*)d_out; a.ws = (unsigned char*)d_ws;
#if MK_ONE_LAUNCH
    a.ph_lo = 0; a.ph_hi = NPH;
    hipLaunchKernelGGL(mk_fwd, dim3(grid), dim3(NWAVES * 64), LDS_BYTES, stream, a);
#else
    for (int p = 0; p < NPH; ++p) { a.ph_lo = p; a.ph_hi = p + 1; hipLaunchKernelGGL(mk_fwd, dim3(grid), dim3(NWAVES * 64), LDS_BYTES, stream, a); }
#endif
    const hipError_t le = hipPeekAtLastError();
    if (le != hipSuccess) fprintf(stderr, "kernel_launch: launch failed: %s\n", hipGetErrorName(le));
}
```
